# Optimizing an MI355X kernel written in HIP

```python
import jax, jax.numpy as jnp
from jax import lax
import numpy as np

D_MODEL = 1024
BATCH = 32
SEQ = 256
DEPTH = 1
DEC_BATCH = 4
DEC_SEQ = 4096
PAST_LEN = 256

GRID_W = 64
CONV_WIDTH = D_MODEL // 2
MLSTM_HEADS = 4
MLSTM_DH = (D_MODEL // 2) // MLSTM_HEADS
MLSTM_W = MLSTM_HEADS * MLSTM_DH
MLSTM_CHUNK = 64
N_DIRS = 2
IN_COLS = 3 * CONV_WIDTH + 4 * MLSTM_W + 2 * N_DIRS * MLSTM_HEADS
PEER_HEADS = 8
PEER_DQ = 256
PEER_NKEYS = 128
PEER_N = PEER_NKEYS * PEER_NKEYS
PEER_TOPK = 16
PEER_BLOCK = 128
EPS = 1e-6

kernel_name = 'hymba_shortconv_bimlstm_peer_dit_step'


def rms_norm(x, g):
    xf = x.astype(jnp.float32)
    y = xf * lax.rsqrt(jnp.mean(xf * xf, axis=-1, keepdims=True) + EPS)
    return (y * g.astype(jnp.float32)).astype(x.dtype)


def ada_mod(cvec, w_ada, b_ada):
    m = jax.nn.silu(cvec) @ w_ada + b_ada
    return jnp.split(m[:, None, :], 6, axis=-1)


def conv3(u, w, b):
    up = jnp.pad(u, ((0, 0), (1, 1), (0, 0)))
    return up[:, :-2] * w[0] + up[:, 1:-1] * w[1] + up[:, 2:] * w[2] + b


def short_conv_group(bg, cg, xg, conv_w, conv_b, on_grid):
    u = cg * xg
    if on_grid:
        n, L, ch = u.shape
        rows = L // GRID_W
        y = conv3(u.reshape(n * rows, GRID_W, ch), conv_w, conv_b).reshape(n, L, ch)
    else:
        y = conv3(u, conv_w, conv_b)
    return bg * y


def mlstm_chunkwise(q, k, v, ig, lf, C0, n0, m0):
    Bn, H, L, Dh = q.shape
    T = MLSTM_CHUNK
    nc = L // T
    tril = jnp.tril(jnp.ones((T, T), dtype=bool))

    def to_chunks(a):
        return jnp.moveaxis(a.reshape((Bn, H, nc, T) + a.shape[3:]), 2, 0)

    def step(carry, inp):
        C, n, m = carry
        qc, kc, vc, ic, fc = inp
        b = jnp.cumsum(fc, axis=-1)
        dmat = jnp.where(tril, b[..., :, None] - b[..., None, :] + ic[..., None, :], -jnp.inf)
        inter = b + m[..., None]
        m_t = jnp.maximum(inter, jnp.max(dmat, axis=-1))
        s = jnp.einsum('bhtd,bhsd->bhts', qc, kc) * jnp.exp(dmat - m_t[..., None])
        a = jnp.exp(inter - m_t)
        num = a[..., None] * jnp.einsum('bhtk,bhkv->bhtv', qc, C) + jnp.einsum('bhts,bhsv->bhtv', s, vc)
        den = a * jnp.einsum('bhtk,bhk->bht', qc, n) + jnp.sum(s, axis=-1)
        h = num / jnp.maximum(jnp.abs(den), jnp.exp(-m_t))[..., None]
        m_new = m_t[..., -1]
        w_s = jnp.exp(b[..., -1:] - b + ic - m_new[..., None])
        decay = jnp.exp(b[..., -1] + m - m_new)
        C_new = decay[..., None, None] * C + jnp.einsum('bhs,bhsk,bhsv->bhkv', w_s, kc, vc)
        n_new = decay[..., None] * n + jnp.einsum('bhs,bhsk->bhk', w_s, kc)
        return (C_new, n_new, m_new), h

    xs = (to_chunks(q), to_chunks(k), to_chunks(v), to_chunks(ig), to_chunks(lf))
    (C, n, m), h = lax.scan(step, (C0, n0, m0), xs)
    h = jnp.moveaxis(h, 0, 2).reshape(Bn, H, L, Dh)
    return h, C, n, m


def mlstm_group(qg, kg, vg, og, igr, fgr, b_igate, b_fgate, g_head, C0, n0, m0):
    Bn, L, _ = qg.shape
    f32 = jnp.float32

    def heads(a):
        return a.reshape(Bn, L, MLSTM_HEADS, MLSTM_DH).transpose(0, 2, 1, 3).astype(f32)

    q = heads(qg) * (MLSTM_DH ** -0.5)
    k = heads(kg)
    v = heads(vg)
    ig = (igr.reshape(Bn, L, N_DIRS, MLSTM_HEADS).astype(f32) + b_igate.astype(f32)).transpose(2, 0, 3, 1)
    lf = jax.nn.log_sigmoid(fgr.reshape(Bn, L, N_DIRS, MLSTM_HEADS).astype(f32) + b_fgate.astype(f32)).transpose(2, 0, 3, 1)
    C0 = C0.astype(f32); n0 = n0.astype(f32); m0 = m0.astype(f32)

    def flip(a):
        return jnp.flip(a, axis=2)

    h_f, Cf, nf, mf = mlstm_chunkwise(q, k, v, ig[0], lf[0], C0[:, 0], n0[:, 0], m0[:, 0])
    h_b, Cb, nb, mb = mlstm_chunkwise(flip(q), flip(k), flip(v), flip(ig[1]), flip(lf[1]),
                                      C0[:, 1], n0[:, 1], m0[:, 1])
    h = h_f + flip(h_b)
    h = h * lax.rsqrt(jnp.mean(h * h, axis=-1, keepdims=True) + EPS) * g_head.astype(f32)[None, :, None, :]
    h = h.transpose(0, 2, 1, 3).reshape(Bn, L, MLSTM_W).astype(qg.dtype) * jax.nn.sigmoid(og)
    return h, jnp.stack([Cf, Cb], axis=1), jnp.stack([nf, nb], axis=1), jnp.stack([mf, mb], axis=1)


def token_mixers(h, w_in, b_igate, b_fgate, conv_w, conv_b, g_mlstm, w_out, C0, n0, m0, on_grid):
    proj = h @ w_in
    cw, mw, g = CONV_WIDTH, MLSTM_W, N_DIRS * MLSTM_HEADS
    cuts = [cw, 2 * cw, 3 * cw, 3 * cw + mw, 3 * cw + 2 * mw, 3 * cw + 3 * mw, 3 * cw + 4 * mw, 3 * cw + 4 * mw + g]
    bg, cg, xg, qg, kg, vg, og, igr, fgr = jnp.split(proj, cuts, axis=-1)
    conv_out = short_conv_group(bg, cg, xg, conv_w, conv_b, on_grid)
    ml_out, Cn, nn_, mn = mlstm_group(qg, kg, vg, og, igr, fgr, b_igate, b_fgate, g_mlstm, C0, n0, m0)
    out = jnp.concatenate([conv_out, ml_out], axis=-1) @ w_out
    return out, Cn, nn_, mn


def peer(h, wq, k1, k2, u_tab, v_tab):
    Bn, L, D = h.shape
    half = PEER_DQ // 2
    toks = h.reshape(-1, PEER_BLOCK, D)

    def block(xb):
        T = xb.shape[0]
        q = (xb @ wq).reshape(T, PEER_HEADS, PEER_DQ)
        s1 = jnp.einsum('thd,kd->thk', q[..., :half], k1).astype(jnp.float32)
        s2 = jnp.einsum('thd,kd->thk', q[..., half:], k2).astype(jnp.float32)
        v1, i1 = lax.top_k(s1, PEER_TOPK)
        v2, i2 = lax.top_k(s2, PEER_TOPK)
        cand = (v1[..., :, None] + v2[..., None, :]).reshape(T, PEER_HEADS, PEER_TOPK * PEER_TOPK)
        vs, flat = lax.top_k(cand, PEER_TOPK)
        e = (jnp.take_along_axis(i1, flat // PEER_TOPK, axis=-1) * PEER_NKEYS
             + jnp.take_along_axis(i2, flat % PEER_TOPK, axis=-1))
        gate = jax.nn.softmax(vs, axis=-1)
        a = jnp.einsum('td,thkd->thk', xb, u_tab[e]).astype(jnp.float32)
        w = (gate * jax.nn.gelu(a, approximate=False)).astype(xb.dtype)
        return jnp.einsum('thk,thkd->td', w, v_tab[e])

    return lax.map(block, toks).reshape(Bn, L, D)


def trunk_layer(x, cvec, w_ada, b_ada, g_norm1, w_in, b_igate, b_fgate, conv_w, conv_b, g_mlstm, w_out,
                g_norm2, peer_wq, peer_k1, peer_k2, peer_u, peer_v, C0, n0, m0, on_grid):
    sh1, sc1, ga1, sh2, sc2, ga2 = ada_mod(cvec, w_ada, b_ada)
    h = rms_norm(x, g_norm1) * (1 + sc1) + sh1
    mix, Cn, nn_, mn = token_mixers(h, w_in, b_igate, b_fgate, conv_w, conv_b, g_mlstm, w_out, C0, n0, m0, on_grid)
    x = x + ga1 * mix
    h = rms_norm(x, g_norm2) * (1 + sc2) + sh2
    x = x + ga2 * peer(h, peer_wq, peer_k1, peer_k2, peer_u, peer_v)
    return x, Cn, nn_, mn


def setup_inputs(seed: int = 0) -> dict:
    key = jax.random.key(seed)
    ks = jax.random.split(key, 24)
    nrm = jax.random.normal
    D = D_MODEL
    f = jnp.float32
    return {
        'x_prompt': nrm(ks[0], (BATCH, SEQ, D), f),
        'x_sample': nrm(ks[1], (DEC_BATCH, DEC_SEQ, D), f),
        'state_C': 0.5 * nrm(ks[2], (DEC_BATCH, DEPTH, N_DIRS, MLSTM_HEADS, MLSTM_DH, MLSTM_DH), f),
        'state_n': 0.5 * nrm(ks[3], (DEC_BATCH, DEPTH, N_DIRS, MLSTM_HEADS, MLSTM_DH), f),
        'state_m': nrm(ks[4], (DEC_BATCH, DEPTH, N_DIRS, MLSTM_HEADS), f),
        'c': nrm(ks[5], (DEC_BATCH, D), f),
        'c_ctx': nrm(ks[6], (D,), f),
        'w_ada': 0.5 * D ** -0.5 * nrm(ks[7], (DEPTH, D, 6 * D), f),
        'b_ada': 0.01 * nrm(ks[8], (DEPTH, 6 * D), f),
        'g_norm1': 1.0 + 0.01 * nrm(ks[9], (DEPTH, D), f),
        'w_in': D ** -0.5 * nrm(ks[10], (DEPTH, D, IN_COLS), f),
        'b_igate': 0.1 * nrm(ks[11], (DEPTH, N_DIRS, MLSTM_HEADS), f),
        'b_fgate': 3.0 + 0.1 * nrm(ks[12], (DEPTH, N_DIRS, MLSTM_HEADS), f),
        'conv_w': 3.0 ** -0.5 * nrm(ks[13], (DEPTH, 3, CONV_WIDTH), f),
        'conv_b': 0.01 * nrm(ks[14], (DEPTH, CONV_WIDTH), f),
        'g_mlstm': 1.0 + 0.01 * nrm(ks[15], (DEPTH, MLSTM_HEADS, MLSTM_DH), f),
        'w_out': D ** -0.5 * nrm(ks[16], (DEPTH, D, D), f),
        'g_norm2': 1.0 + 0.01 * nrm(ks[17], (DEPTH, D), f),
        'peer_wq': D ** -0.5 * nrm(ks[18], (DEPTH, D, PEER_HEADS * PEER_DQ), f),
        'peer_k1': (PEER_DQ // 2) ** -0.5 * nrm(ks[19], (DEPTH, PEER_NKEYS, PEER_DQ // 2), f),
        'peer_k2': (PEER_DQ // 2) ** -0.5 * nrm(ks[20], (DEPTH, PEER_NKEYS, PEER_DQ // 2), f),
        'peer_u': D ** -0.5 * nrm(ks[21], (DEPTH, PEER_N, D), f),
        'peer_v': 0.3 * nrm(ks[22], (DEPTH, PEER_N, D), f),
        'g_final': 1.0 + 0.01 * nrm(ks[23], (D,), f),
    }


def reference(x_prompt, x_sample, state_C, state_n, state_m, c, c_ctx, w_ada, b_ada, g_norm1, w_in,
              b_igate, b_fgate, conv_w, conv_b, g_mlstm, w_out, g_norm2, peer_wq, peer_k1, peer_k2,
              peer_u, peer_v, g_final):
    f32 = jnp.float32
    B = x_prompt.shape[0]
    zC = jnp.zeros((B, N_DIRS, MLSTM_HEADS, MLSTM_DH, MLSTM_DH), f32)
    zn = jnp.zeros((B, N_DIRS, MLSTM_HEADS, MLSTM_DH), f32)
    zm = jnp.zeros((B, N_DIRS, MLSTM_HEADS), f32)
    cctx = c_ctx[None, :]
    xp, xs = x_prompt, x_sample
    Cs, ns, ms = [], [], []
    for l in range(DEPTH):
        lw = (w_ada[l], b_ada[l], g_norm1[l], w_in[l], b_igate[l], b_fgate[l], conv_w[l], conv_b[l],
              g_mlstm[l], w_out[l], g_norm2[l], peer_wq[l], peer_k1[l], peer_k2[l], peer_u[l], peer_v[l])
        xp, Cn, nn_, mn = trunk_layer(xp, cctx, *lw, zC, zn, zm, False)
        Cs.append(Cn); ns.append(nn_); ms.append(mn)
        xs, _, _, _ = trunk_layer(xs, c, *lw, state_C[:, l], state_n[:, l], state_m[:, l], True)
    y_prompt = rms_norm(xp, g_final)
    y_sample = rms_norm(xs, g_final)
    new_C = jnp.stack(Cs, axis=1)
    new_n = jnp.stack(ns, axis=1)
    new_m = jnp.stack(ms, axis=1)
    return (y_prompt, y_sample, new_C, new_n, new_m)
```

```cpp
#include <hip/hip_runtime.h>
#include <hip/hip_cooperative_groups.h>
#include <cstdio>
#include <cstdint>
namespace cg = cooperative_groups;

#ifndef MULTI_LAUNCH
#define MULTI_LAUNCH 0
#endif

typedef unsigned short u16;
typedef __attribute__((ext_vector_type(8))) short bf16x8;
typedef __attribute__((ext_vector_type(4))) float f32x4;
typedef __attribute__((ext_vector_type(2))) __bf16 bf2_t;

constexpr int NT = 512;
constexpr int D = 1024;
constexpr int TCTX = 8192;
constexpr int TLAT = 16384;
constexpr int T = TCTX + TLAT;
constexpr int NPROJ = 3584;
constexpr int NPAD = 3712;
constexpr int LDS_BYTES = 256 * 129 * 4 + 256 * 16 * 4 + 256 * 16;
constexpr float EPS = 1e-6f;
constexpr int NPHASE = 9;

struct P {
  const float *x_prompt, *x_sample, *state_C, *state_n, *state_m, *c, *c_ctx, *w_ada, *b_ada, *g_norm1, *w_in,
      *b_igate, *b_fgate, *conv_w, *conv_b, *g_mlstm, *w_out, *g_norm2, *wq, *k1, *k2, *u, *v, *g_final;
  float* out;
  float* mod;
  u16* w_in_t;
  u16* w_out_t;
  u16* wq_t;
  u16* kb;
  float* gates;
  u16* hbuf;
  u16* proj;
  u16* qp;
  u16* ub;
  u16* vb;
};

__device__ __forceinline__ u16 f2bf(float f) {
  unsigned u = __float_as_uint(f);
  u += 0x7fffu + ((u >> 16) & 1u);
  return (u16)(u >> 16);
}
__device__ __forceinline__ float bf2f(u16 h) { return __uint_as_float(((unsigned)h) << 16); }
__device__ __forceinline__ unsigned pack2(float a, float b) { return (unsigned)f2bf(a) | ((unsigned)f2bf(b) << 16); }
__device__ __forceinline__ float lo_f(unsigned w) { return __uint_as_float(w << 16); }
__device__ __forceinline__ float hi_f(unsigned w) { return __uint_as_float(w & 0xffff0000u); }
__device__ __forceinline__ float wave_sum(float v) {
#pragma unroll
  for (int o = 32; o > 0; o >>= 1) v += __shfl_xor(v, o);
  return v;
}
__device__ __forceinline__ float dot2(unsigned a, unsigned b, float c) {
  return __builtin_amdgcn_fdot2_f32_bf16(__builtin_bit_cast(bf2_t, a), __builtin_bit_cast(bf2_t, b), c, false);
}
__device__ __forceinline__ float dot8(uint4 a, uint4 b, float c) {
  c = dot2(a.x, b.x, c); c = dot2(a.y, b.y, c); c = dot2(a.z, b.z, c); c = dot2(a.w, b.w, c);
  return c;
}
__device__ __forceinline__ f32x4 mfma16(bf16x8 a, bf16x8 b, f32x4 c) {
  return __builtin_amdgcn_mfma_f32_16x16x32_bf16(a, b, c, 0, 0, 0);
}

__device__ __forceinline__ void transpose_tile(const float* __restrict__ W, int Nreal, u16* __restrict__ Wt, int k0, int n0, float* tile) {
  const int tid = threadIdx.x;
#pragma unroll
  for (int i = 0; i < 8; ++i) {
    int idx = i * NT + tid;
    int kk = idx >> 6, nn = idx & 63;
    float v = (n0 + nn < Nreal) ? W[(size_t)(k0 + kk) * Nreal + n0 + nn] : 0.f;
    tile[kk * 65 + nn] = v;
  }
  __syncthreads();
#pragma unroll
  for (int i = 0; i < 8; ++i) {
    int idx = i * NT + tid;
    int nn = idx >> 6, kk = idx & 63;
    Wt[(size_t)(n0 + nn) * 1024 + k0 + kk] = f2bf(tile[kk * 65 + nn]);
  }
}

__device__ __forceinline__ void phase_prep(const P& p, char* smem) {
  const int tid = threadIdx.x;
  float* sf = (float*)smem;
  const int n_gemv = 96, n_tin = 16 * 58, n_tout = 16 * 16, n_tq = 16 * 32, n_k = 2;
  const int total = n_gemv + n_tin + n_tout + n_tq + n_k;
  for (int it = blockIdx.x; it < total; it += gridDim.x) {
    __syncthreads();
    if (it < n_gemv) {
      for (int i = tid; i < 5 * 1024; i += NT) {
        int ci = i >> 10, k = i & 1023;
        float cv = (ci == 0) ? p.c_ctx[k] : p.c[(ci - 1) * 1024 + k];
        sf[i] = cv / (1.f + expf(-cv));
      }
      __syncthreads();
      const int cl = tid & 15, kg = tid >> 4;
      const int col = it * 64 + cl * 4;
      float acc[5][4];
#pragma unroll
      for (int ci = 0; ci < 5; ++ci)
#pragma unroll
        for (int j = 0; j < 4; ++j) acc[ci][j] = 0.f;
      for (int kk = 0; kk < 32; ++kk) {
        int k = kg * 32 + kk;
        float4 w = *(const float4*)&p.w_ada[(size_t)k * 6144 + col];
#pragma unroll
        for (int ci = 0; ci < 5; ++ci) {
          float s = sf[ci * 1024 + k];
          acc[ci][0] += s * w.x; acc[ci][1] += s * w.y; acc[ci][2] += s * w.z; acc[ci][3] += s * w.w;
        }
      }
      float* red = sf + 5 * 1024;
#pragma unroll
      for (int ci = 0; ci < 5; ++ci)
#pragma unroll
        for (int j = 0; j < 4; ++j) red[(kg * 16 + cl) * 20 + ci * 4 + j] = acc[ci][j];
      __syncthreads();
      if (tid < 320) {
        int ci = tid >> 6, cc = tid & 63;
        int cl2 = cc >> 2, j = cc & 3;
        float s = 0.f;
        for (int g = 0; g < 32; ++g) s += red[(g * 16 + cl2) * 20 + ci * 4 + j];
        int col2 = it * 64 + cc;
        p.mod[ci * 6144 + col2] = s + p.b_ada[col2];
      }
    } else if (it < n_gemv + n_tin) {
      int j = it - n_gemv;
      transpose_tile(p.w_in, 3600, p.w_in_t, (j / 58) * 64, (j % 58) * 64, sf);
    } else if (it < n_gemv + n_tin + n_tout) {
      int j = it - n_gemv - n_tin;
      transpose_tile(p.w_out, 1024, p.w_out_t, (j / 16) * 64, (j % 16) * 64, sf);
    } else if (it < n_gemv + n_tin + n_tout + n_tq) {
      int j = it - n_gemv - n_tin - n_tout;
      transpose_tile(p.wq, 2048, p.wq_t, (j / 32) * 64, (j % 32) * 64, sf);
    } else {
      int j = it - n_gemv - n_tin - n_tout - n_tq;
      const float* src = j ? p.k2 : p.k1;
      u16* dst = p.kb + j * 16384;
      for (int i = tid; i < 16384; i += NT) dst[i] = f2bf(src[i]);
    }
  }
}

__device__ __forceinline__ void phase_norm(const P& p, int which) {
  const int wave = threadIdx.x >> 6, lane = threadIdx.x & 63;
  for (int t = blockIdx.x * 8 + wave; t < T; t += gridDim.x * 8) {
    const float* xr = which ? (p.out + (size_t)t * D)
                            : (t < TCTX ? p.x_prompt + (size_t)t * D : p.x_sample + (size_t)(t - TCTX) * D);
    const int ci = t < TCTX ? 0 : 1 + ((t - TCTX) >> 12);
    const float* md = p.mod + ci * 6144 + (which ? 3 * 1024 : 0);
    const float* g = which ? p.g_norm2 : p.g_norm1;
    float4 xv[4];
    float ss = 0.f;
#pragma unroll
    for (int i = 0; i < 4; ++i) {
      xv[i] = *(const float4*)&xr[i * 256 + lane * 4];
      ss += xv[i].x * xv[i].x + xv[i].y * xv[i].y + xv[i].z * xv[i].z + xv[i].w * xv[i].w;
    }
    ss = wave_sum(ss);
    const float rstd = rsqrtf(ss * (1.f / 1024.f) + EPS);
#pragma unroll
    for (int i = 0; i < 4; ++i) {
      int col = i * 256 + lane * 4;
      float4 g4 = *(const float4*)&g[col];
      float4 sh = *(const float4*)&md[col];
      float4 sc = *(const float4*)&md[1024 + col];
      float h0 = xv[i].x * rstd * g4.x * (1.f + sc.x) + sh.x;
      float h1 = xv[i].y * rstd * g4.y * (1.f + sc.y) + sh.y;
      float h2 = xv[i].z * rstd * g4.z * (1.f + sc.z) + sh.z;
      float h3 = xv[i].w * rstd * g4.w * (1.f + sc.w) + sh.w;
      uint2 o; o.x = pack2(h0, h1); o.y = pack2(h2, h3);
      *(uint2*)&p.hbuf[(size_t)t * D + col] = o;
    }
  }
}

__device__ __forceinline__ void convert_tables(const P& p) {
  const size_t n4 = (size_t)16384 * 1024 / 4;
  const size_t stride = (size_t)gridDim.x * NT;
  for (size_t i = (size_t)blockIdx.x * NT + threadIdx.x; i < 2 * n4; i += stride) {
    const float* src = i < n4 ? p.u : p.v;
    u16* dst = i < n4 ? p.ub : p.vb;
    size_t j = i < n4 ? i : i - n4;
    float4 f = *(const float4*)&src[j * 4];
    uint2 o; o.x = pack2(f.x, f.y); o.y = pack2(f.z, f.w);
    *(uint2*)&dst[j * 4] = o;
  }
}

template <int MODE>
__device__ __forceinline__ void gemm_phase(const P& p, const u16* __restrict__ A, const u16* __restrict__ Bt, int ntn, char* smem) {
  const int tid = threadIdx.x, lane = tid & 63, wave = tid >> 6;
  const int wm = wave >> 1, wn = wave & 1, l15 = lane & 15, quad = lane >> 4;
  u16* sA = (u16*)smem;
  u16* sB = sA + 2 * 256 * 72;
  const int ntiles = (T / 256) * ntn;
  for (int tile = blockIdx.x; tile < ntiles; tile += gridDim.x) {
    const int mt = tile / ntn, nt = tile % ntn;
    const int m0 = mt * 256, n0 = nt * 128;
    f32x4 acc[4][4];
#pragma unroll
    for (int i = 0; i < 4; ++i)
#pragma unroll
      for (int j = 0; j < 4; ++j) acc[i][j] = (f32x4){0.f, 0.f, 0.f, 0.f};
    uint4 ra[4], rb[2];
    const int lrow = tid >> 3, lch = tid & 7;
#pragma unroll
    for (int i = 0; i < 4; ++i) ra[i] = *(const uint4*)&A[(size_t)(m0 + i * 64 + lrow) * 1024 + lch * 8];
#pragma unroll
    for (int i = 0; i < 2; ++i) rb[i] = *(const uint4*)&Bt[(size_t)(n0 + i * 64 + lrow) * 1024 + lch * 8];
#pragma unroll
    for (int i = 0; i < 4; ++i) *(uint4*)&sA[(i * 64 + lrow) * 72 + lch * 8] = ra[i];
#pragma unroll
    for (int i = 0; i < 2; ++i) *(uint4*)&sB[(i * 64 + lrow) * 72 + lch * 8] = rb[i];
    __syncthreads();
    for (int kt = 0; kt < 16; ++kt) {
      if (kt + 1 < 16) {
#pragma unroll
        for (int i = 0; i < 4; ++i) ra[i] = *(const uint4*)&A[(size_t)(m0 + i * 64 + lrow) * 1024 + (kt + 1) * 64 + lch * 8];
#pragma unroll
        for (int i = 0; i < 2; ++i) rb[i] = *(const uint4*)&Bt[(size_t)(n0 + i * 64 + lrow) * 1024 + (kt + 1) * 64 + lch * 8];
      }
      const u16* a_s = sA + (kt & 1) * 256 * 72;
      const u16* b_s = sB + (kt & 1) * 128 * 72;
#pragma unroll
      for (int ks = 0; ks < 2; ++ks) {
        bf16x8 bfr[4], afr[4];
#pragma unroll
        for (int ni = 0; ni < 4; ++ni) bfr[ni] = *(const bf16x8*)&b_s[(wn * 64 + ni * 16 + l15) * 72 + ks * 32 + quad * 8];
#pragma unroll
        for (int mi = 0; mi < 4; ++mi) afr[mi] = *(const bf16x8*)&a_s[(wm * 64 + mi * 16 + l15) * 72 + ks * 32 + quad * 8];
#pragma unroll
        for (int ni = 0; ni < 4; ++ni)
#pragma unroll
          for (int mi = 0; mi < 4; ++mi) acc[ni][mi] = mfma16(bfr[ni], afr[mi], acc[ni][mi]);
      }
      if (kt + 1 < 16) {
        u16* a_w = sA + ((kt + 1) & 1) * 256 * 72;
        u16* b_w = sB + ((kt + 1) & 1) * 128 * 72;
#pragma unroll
        for (int i = 0; i < 4; ++i) *(uint4*)&a_w[(i * 64 + lrow) * 72 + lch * 8] = ra[i];
#pragma unroll
        for (int i = 0; i < 2; ++i) *(uint4*)&b_w[(i * 64 + lrow) * 72 + lch * 8] = rb[i];
      }
      __syncthreads();
    }
#pragma unroll
    for (int mi = 0; mi < 4; ++mi) {
      const int m = m0 + wm * 64 + mi * 16 + l15;
#pragma unroll
      for (int ni = 0; ni < 4; ++ni) {
        const int n = n0 + wn * 64 + ni * 16 + quad * 4;
        f32x4 a = acc[ni][mi];
        if (MODE == 0) {
          if (n < NPROJ) {
            uint2 o; o.x = pack2(a[0], a[1]); o.y = pack2(a[2], a[3]);
            *(uint2*)&p.proj[(size_t)m * NPROJ + n] = o;
          } else if (n < 3600) {
            *(float4*)&p.gates[(size_t)m * 16 + (n - NPROJ)] = make_float4(a[0], a[1], a[2], a[3]);
          }
        } else if (MODE == 1) {
          const float* xr = m < TCTX ? p.x_prompt + (size_t)m * D : p.x_sample + (size_t)(m - TCTX) * D;
          const int ci = m < TCTX ? 0 : 1 + ((m - TCTX) >> 12);
          float4 xv = *(const float4*)&xr[n];
          float4 ga = *(const float4*)&p.mod[ci * 6144 + 2 * 1024 + n];
          float4 o = make_float4(xv.x + ga.x * a[0], xv.y + ga.y * a[1], xv.z + ga.z * a[2], xv.w + ga.w * a[3]);
          *(float4*)&p.out[(size_t)m * D + n] = o;
        } else {
          uint2 o; o.x = pack2(a[0], a[1]); o.y = pack2(a[2], a[3]);
          *(uint2*)&p.qp[(size_t)m * 2048 + n] = o;
        }
      }
    }
  }
}

__device__ __forceinline__ void mlstm_task(const P& p, int task, char* smem) {
  const int tid = threadIdx.x, lane = tid & 63, wave = tid >> 6, l15 = lane & 15, quad = lane >> 4;
  const bool lat = task < 128;
  const int id = lat ? task : task - 128;
  const int slice = id & 3, dir = (id >> 2) & 1, head = (id >> 3) & 3, bat = id >> 5;
  const int tb = lat ? TCTX + bat * 4096 : bat * 256;
  const int L = lat ? 4096 : 256;
  const int nch = L >> 6;
  const int gcol = dir * 4 + head;
  const float big = p.b_igate[gcol], bfg = p.b_fgate[gcol];
  const float scale = 0.08838834764831845f;

  u16* sQ = (u16*)smem;
  u16* sK = sQ + 64 * 136;
  u16* sKt = sK + 64 * 136;
  u16* sVt = sKt + 128 * 72;
  u16* sS = sVt + 32 * 72;
  u16* sCt = sS + 64 * 72;
  float* sg = (float*)(sCt + 32 * 136);
  float* smm = sg + 64;
  float* sa = smm + 64;
  float* semt = sa + 64;
  float* sden = semt + 64;
  float* sqn = sden + 64;
  float* sN = sqn + 64;

  const int sbase = (bat * 2 + dir) * 4 + head;
  f32x4 C[2];
  float m;
  __syncthreads();
  if (lat) {
#pragma unroll
    for (int tj = 0; tj < 2; ++tj)
#pragma unroll
      for (int r = 0; r < 4; ++r)
        C[tj][r] = p.state_C[(size_t)sbase * 16384 + (wave * 16 + quad * 4 + r) * 128 + slice * 32 + tj * 16 + l15];
    m = p.state_m[sbase];
    if (tid < 128) sN[tid] = p.state_n[sbase * 128 + tid];
  } else {
    C[0] = (f32x4){0.f, 0.f, 0.f, 0.f};
    C[1] = (f32x4){0.f, 0.f, 0.f, 0.f};
    m = 0.f;
    if (tid < 128) sN[tid] = 0.f;
  }
#pragma unroll
  for (int tj = 0; tj < 2; ++tj) {
    uint2 o; o.x = pack2(C[tj][0], C[tj][1]); o.y = pack2(C[tj][2], C[tj][3]);
    *(uint2*)&sCt[(tj * 16 + l15) * 136 + wave * 16 + quad * 4] = o;
  }
  __syncthreads();

  float* hout = p.out + (size_t)dir * T * 512;
  const int s = tid >> 3, part = tid & 7;

  for (int c = 0; c < nch; ++c) {
    const int posl = c * 64 + lane;
    const int tl = tb + (dir ? (L - 1 - posl) : posl);
    const float ig = p.gates[(size_t)tl * 16 + gcol] + big;
    const float fr = p.gates[(size_t)tl * 16 + 8 + gcol] + bfg;
    const float lf = fminf(fr, 0.f) - log1pf(expf(-fabsf(fr)));
    float b = lf;
#pragma unroll
    for (int off = 1; off < 64; off <<= 1) { float v = __shfl_up(b, off); if (lane >= off) b += v; }
    const float g = ig - b;
    float G = g;
#pragma unroll
    for (int off = 1; off < 64; off <<= 1) { float v = __shfl_up(G, off); if (lane >= off) G = fmaxf(G, v); }
    const float mm = fmaxf(m, G);
    const float mmT = __shfl(mm, 63), bT = __shfl(b, 63);
    const float wgt = expf(g - mmT);
    const float decay = expf(m - mmT);
    const float m_new = bT + mmT;
    if (wave == 0) {
      sg[lane] = g; smm[lane] = mm; sa[lane] = expf(m - mm); semt[lane] = expf(-(b + mm)); sden[lane] = 0.f;
    }
    const int poss = c * 64 + s;
    const int ts = tb + (dir ? (L - 1 - poss) : poss);
    const u16* prow = p.proj + (size_t)ts * NPROJ;
    const uint4 q0 = *(const uint4*)&prow[1536 + head * 128 + part * 16];
    const uint4 q1 = *(const uint4*)&prow[1536 + head * 128 + part * 16 + 8];
    const uint4 k0 = *(const uint4*)&prow[2048 + head * 128 + part * 16];
    const uint4 k1 = *(const uint4*)&prow[2048 + head * 128 + part * 16 + 8];
    const uint2 vv = *(const uint2*)&prow[2560 + head * 128 + slice * 32 + part * 4];
    const float ws_ = __shfl(wgt, s);
    *(uint4*)&sQ[s * 136 + part * 16] = q0;
    *(uint4*)&sQ[s * 136 + part * 16 + 8] = q1;
    *(uint4*)&sK[s * 136 + part * 16] = k0;
    *(uint4*)&sK[s * 136 + part * 16 + 8] = k1;
    {
      const unsigned qw[8] = {q0.x, q0.y, q0.z, q0.w, q1.x, q1.y, q1.z, q1.w};
      float qn = 0.f;
#pragma unroll
      for (int j = 0; j < 8; ++j) {
        qn += lo_f(qw[j]) * sN[part * 16 + 2 * j] + hi_f(qw[j]) * sN[part * 16 + 2 * j + 1];
      }
      qn += __shfl_xor(qn, 1); qn += __shfl_xor(qn, 2); qn += __shfl_xor(qn, 4);
      if (part == 0) sqn[s] = qn * scale;
      const unsigned kw[8] = {k0.x, k0.y, k0.z, k0.w, k1.x, k1.y, k1.z, k1.w};
      const int pc = ((s >> 3) ^ part) * 8 + (s & 7);
#pragma unroll
      for (int j = 0; j < 8; ++j) {
        sKt[(part * 16 + 2 * j) * 72 + pc] = f2bf(lo_f(kw[j]) * ws_);
        sKt[(part * 16 + 2 * j + 1) * 72 + pc] = f2bf(hi_f(kw[j]) * ws_);
      }
      sVt[(part * 4 + 0) * 72 + pc] = (u16)(vv.x & 0xffffu);
      sVt[(part * 4 + 1) * 72 + pc] = (u16)(vv.x >> 16);
      sVt[(part * 4 + 2) * 72 + pc] = (u16)(vv.y & 0xffffu);
      sVt[(part * 4 + 3) * 72 + pc] = (u16)(vv.y >> 16);
    }
    __syncthreads();

    const int tj = wave >> 1, ti = wave & 1;
    const int trow = tj * 16 + l15;
    {
      const float mmt = smm[trow];
      float psum = 0.f;
#pragma unroll
      for (int tt = 0; tt < 2; ++tt) {
        const int si = (wave & 1) * 2 + tt;
        f32x4 acc = (f32x4){0.f, 0.f, 0.f, 0.f};
#pragma unroll
        for (int ks = 0; ks < 4; ++ks) {
          bf16x8 afr = *(const bf16x8*)&sK[(si * 16 + l15) * 136 + ks * 32 + quad * 8];
          bf16x8 bfr = *(const bf16x8*)&sQ[trow * 136 + ks * 32 + quad * 8];
          acc = mfma16(afr, bfr, acc);
        }
        const int s0 = si * 16 + quad * 4;
        float vals[4];
#pragma unroll
        for (int r = 0; r < 4; ++r) {
          const int sidx = s0 + r;
          const float e = expf(fminf(sg[sidx] - mmt, 0.f));
          const float val = (sidx <= trow) ? acc[r] * scale * e : 0.f;
          vals[r] = val;
          psum += val;
        }
        uint2 o; o.x = pack2(vals[0], vals[1]); o.y = pack2(vals[2], vals[3]);
        *(uint2*)&sS[trow * 72 + s0] = o;
      }
      psum += __shfl_xor(psum, 16);
      psum += __shfl_xor(psum, 32);
      if (quad == 0) atomicAdd(&sden[trow], psum);
    }
    f32x4 aqc = (f32x4){0.f, 0.f, 0.f, 0.f};
#pragma unroll
    for (int ks = 0; ks < 4; ++ks) {
      bf16x8 afr = *(const bf16x8*)&sCt[(ti * 16 + l15) * 136 + ks * 32 + quad * 8];
      bf16x8 bfr = *(const bf16x8*)&sQ[trow * 136 + ks * 32 + quad * 8];
      aqc = mfma16(afr, bfr, aqc);
    }
    __syncthreads();
    {
      f32x4 asv = (f32x4){0.f, 0.f, 0.f, 0.f};
      const int vrow = ti * 16 + l15;
      const int vkey = (vrow >> 2) & 7;
#pragma unroll
      for (int ks = 0; ks < 2; ++ks) {
        bf16x8 afr = *(const bf16x8*)&sVt[vrow * 72 + (((ks * 4 + quad) ^ vkey) * 8)];
        bf16x8 bfr = *(const bf16x8*)&sS[trow * 72 + ks * 32 + quad * 8];
        asv = mfma16(afr, bfr, asv);
      }
      const float a_t = sa[trow];
      const float den = a_t * sqn[trow] + sden[trow];
      const float inv = 1.f / fmaxf(fabsf(den), semt[trow]);
      const float as = a_t * scale;
      float4 h = make_float4((as * aqc[0] + asv[0]) * inv, (as * aqc[1] + asv[1]) * inv,
                             (as * aqc[2] + asv[2]) * inv, (as * aqc[3] + asv[3]) * inv);
      const int post = c * 64 + trow;
      const int tt = tb + (dir ? (L - 1 - post) : post);
      *(float4*)&hout[(size_t)tt * 512 + head * 128 + slice * 32 + ti * 16 + quad * 4] = h;
    }
#pragma unroll
    for (int t2 = 0; t2 < 2; ++t2) {
      C[t2][0] *= decay; C[t2][1] *= decay; C[t2][2] *= decay; C[t2][3] *= decay;
      const int krow = wave * 16 + l15;
      const int kkey = wave & 7;
      const int vrow = t2 * 16 + l15;
      const int vkey = (vrow >> 2) & 7;
#pragma unroll
      for (int ks = 0; ks < 2; ++ks) {
        bf16x8 afr = *(const bf16x8*)&sKt[krow * 72 + (((ks * 4 + quad) ^ kkey) * 8)];
        bf16x8 bfr = *(const bf16x8*)&sVt[vrow * 72 + (((ks * 4 + quad) ^ vkey) * 8)];
        C[t2] = mfma16(afr, bfr, C[t2]);
      }
    }
    if (tid < 128) {
      float sum = 0.f;
#pragma unroll
      for (int j = 0; j < 8; ++j) {
        uint4 w = *(const uint4*)&sKt[tid * 72 + j * 8];
        sum += lo_f(w.x) + hi_f(w.x) + lo_f(w.y) + hi_f(w.y) + lo_f(w.z) + hi_f(w.z) + lo_f(w.w) + hi_f(w.w);
      }
      sN[tid] = decay * sN[tid] + sum;
    }
#pragma unroll
    for (int t2 = 0; t2 < 2; ++t2) {
      uint2 o; o.x = pack2(C[t2][0], C[t2][1]); o.y = pack2(C[t2][2], C[t2][3]);
      *(uint2*)&sCt[(t2 * 16 + l15) * 136 + wave * 16 + quad * 4] = o;
    }
    m = m_new;
    __syncthreads();
  }
  if (!lat) {
    float* newC = p.out + (size_t)T * D;
    float* newn = newC + (size_t)32 * 2 * 4 * 128 * 128;
    float* newm = newn + 32 * 2 * 4 * 128;
#pragma unroll
    for (int t2 = 0; t2 < 2; ++t2)
#pragma unroll
      for (int r = 0; r < 4; ++r)
        newC[(size_t)sbase * 16384 + (wave * 16 + quad * 4 + r) * 128 + slice * 32 + t2 * 16 + l15] = C[t2][r];
    if (slice == 0) {
      if (tid < 128) newn[sbase * 128 + tid] = sN[tid];
      if (tid == 0) newm[sbase] = m;
    }
  }
}

__device__ __forceinline__ void phase_mlstm(const P& p, char* smem) {
  const int G = gridDim.x, b = blockIdx.x;
  if (G >= 256) {
    if (b < 128) mlstm_task(p, b, smem);
    else for (int task = b; task < 1152; task += G - 128) mlstm_task(p, task, smem);
  } else {
    for (int task = b; task < 1152; task += G) mlstm_task(p, task, smem);
  }
}

__device__ __forceinline__ void phase_mix(const P& p) {
  const int wave = threadIdx.x >> 6, lane = threadIdx.x & 63;
  for (int t = blockIdx.x * 8 + wave; t < T; t += gridDim.x * 8) {
    const u16* pr = p.proj + (size_t)t * NPROJ;
    const int seg = t < TCTX ? 256 : 64;
    const int pos = (t < TCTX ? t : t - TCTX) & (seg - 1);
    const bool hasL = pos > 0, hasR = pos < seg - 1;
    const int c0 = lane * 8;
    const uint4 zero4 = make_uint4(0u, 0u, 0u, 0u);
    const uint4 bg = *(const uint4*)&pr[c0];
    const uint4 cgC = *(const uint4*)&pr[512 + c0];
    const uint4 xgC = *(const uint4*)&pr[1024 + c0];
    const uint4 cgL = hasL ? *(const uint4*)&pr[-NPROJ + 512 + c0] : zero4;
    const uint4 xgL = hasL ? *(const uint4*)&pr[-NPROJ + 1024 + c0] : zero4;
    const uint4 cgR = hasR ? *(const uint4*)&pr[NPROJ + 512 + c0] : zero4;
    const uint4 xgR = hasR ? *(const uint4*)&pr[NPROJ + 1024 + c0] : zero4;
    const unsigned bgw[4] = {bg.x, bg.y, bg.z, bg.w};
    const unsigned cC[4] = {cgC.x, cgC.y, cgC.z, cgC.w}, xC[4] = {xgC.x, xgC.y, xgC.z, xgC.w};
    const unsigned cL[4] = {cgL.x, cgL.y, cgL.z, cgL.w}, xL[4] = {xgL.x, xgL.y, xgL.z, xgL.w};
    const unsigned cR[4] = {cgR.x, cgR.y, cgR.z, cgR.w}, xR[4] = {xgR.x, xgR.y, xgR.z, xgR.w};
    unsigned ow[4];
#pragma unroll
    for (int j = 0; j < 4; ++j) {
      const int ch = c0 + 2 * j;
      float w0a = p.conv_w[ch], w1a = p.conv_w[512 + ch], w2a = p.conv_w[1024 + ch], ba = p.conv_b[ch];
      float w0b = p.conv_w[ch + 1], w1b = p.conv_w[512 + ch + 1], w2b = p.conv_w[1024 + ch + 1], bb = p.conv_b[ch + 1];
      float ya = w0a * (lo_f(cL[j]) * lo_f(xL[j])) + w1a * (lo_f(cC[j]) * lo_f(xC[j])) + w2a * (lo_f(cR[j]) * lo_f(xR[j])) + ba;
      float yb = w0b * (hi_f(cL[j]) * hi_f(xL[j])) + w1b * (hi_f(cC[j]) * hi_f(xC[j])) + w2b * (hi_f(cR[j]) * hi_f(xR[j])) + bb;
      ow[j] = pack2(lo_f(bgw[j]) * ya, hi_f(bgw[j]) * yb);
    }
    *(uint4*)&p.hbuf[(size_t)t * D + c0] = make_uint4(ow[0], ow[1], ow[2], ow[3]);
    const float* hf = p.out + (size_t)t * 512 + c0;
    const float* hb = p.out + (size_t)T * 512 + (size_t)t * 512 + c0;
    const float4 f0 = *(const float4*)&hf[0], f1 = *(const float4*)&hf[4];
    const float4 b0 = *(const float4*)&hb[0], b1 = *(const float4*)&hb[4];
    float h[8] = {f0.x + b0.x, f0.y + b0.y, f0.z + b0.z, f0.w + b0.w, f1.x + b1.x, f1.y + b1.y, f1.z + b1.z, f1.w + b1.w};
    float ss = 0.f;
#pragma unroll
    for (int j = 0; j < 8; ++j) ss += h[j] * h[j];
    ss += __shfl_xor(ss, 1); ss += __shfl_xor(ss, 2); ss += __shfl_xor(ss, 4); ss += __shfl_xor(ss, 8);
    const float r = rsqrtf(ss * (1.f / 128.f) + EPS);
    const uint4 og = *(const uint4*)&pr[3072 + c0];
    const unsigned ogw[4] = {og.x, og.y, og.z, og.w};
    unsigned mw[4];
#pragma unroll
    for (int j = 0; j < 4; ++j) {
      float ga = p.g_mlstm[c0 + 2 * j], gb = p.g_mlstm[c0 + 2 * j + 1];
      float oa = lo_f(ogw[j]), ob = hi_f(ogw[j]);
      float sa_ = 1.f / (1.f + expf(-oa)), sb_ = 1.f / (1.f + expf(-ob));
      mw[j] = pack2(h[2 * j] * r * ga * sa_, h[2 * j + 1] * r * gb * sb_);
    }
    *(uint4*)&p.hbuf[(size_t)t * D + 512 + c0] = make_uint4(mw[0], mw[1], mw[2], mw[3]);
  }
}

__device__ __forceinline__ void phase_peer(const P& p, char* smem) {
  const int tid = threadIdx.x, lane = tid & 63, wave = tid >> 6, l15 = lane & 15, quad = lane >> 4;
  float* sc = (float*)smem;
  float* sval = sc + 256 * 129;
  unsigned char* sidx = (unsigned char*)(sval + 256 * 16);
  const float INF = __builtin_huge_valf();
  for (int it = blockIdx.x; it < T / 16; it += gridDim.x) {
    const int t0 = it * 16;
    __syncthreads();
    {
      const int half = wave >> 2;
      const u16* kb = p.kb + half * 16384;
#pragma unroll 1
      for (int hh = 0; hh < 2; ++hh) {
        const int head = (wave & 3) * 2 + hh;
        bf16x8 qf[4];
#pragma unroll
        for (int ks = 0; ks < 4; ++ks)
          qf[ks] = *(const bf16x8*)&p.qp[(size_t)(t0 + l15) * 2048 + head * 256 + half * 128 + ks * 32 + quad * 8];
        const int row = (head * 2 + half) * 16 + l15;
#pragma unroll 1
        for (int nt = 0; nt < 8; ++nt) {
          f32x4 acc = (f32x4){0.f, 0.f, 0.f, 0.f};
#pragma unroll
          for (int ks = 0; ks < 4; ++ks) {
            bf16x8 kf = *(const bf16x8*)&kb[(nt * 16 + l15) * 128 + ks * 32 + quad * 8];
            acc = mfma16(kf, qf[ks], acc);
          }
          const int key = nt * 16 + quad * 4;
#pragma unroll
          for (int r = 0; r < 4; ++r) sc[row * 129 + key + r] = acc[r];
        }
      }
    }
    __syncthreads();
    if (tid < 256) {
      const float* row = sc + tid * 129;
      float pv = INF; int pi = -1;
#pragma unroll 1
      for (int q = 0; q < 16; ++q) {
        float bv = -INF; int bi = 0;
#pragma unroll 8
        for (int k = 0; k < 128; ++k) {
          const float v = row[k];
          const bool valid = (v < pv) || (v == pv && k > pi);
          if (valid && v > bv) { bv = v; bi = k; }
        }
        sval[tid * 16 + q] = bv; sidx[tid * 16 + q] = (unsigned char)bi; pv = bv; pi = bi;
      }
    }
    __syncthreads();
    if (tid < 128) {
      const int tok = tid & 15, head = tid >> 4;
      const int ra = (head * 2) * 16 + tok, rb = (head * 2 + 1) * 16 + tok;
      const float* v1 = sval + ra * 16;
      const float* v2 = sval + rb * 16;
      float* r1 = sc + ra * 129;
      float pv = INF; int pf = -1;
      float vmax = 0.f, se = 0.f;
#pragma unroll 1
      for (int q = 0; q < 16; ++q) {
        float bv = -INF; int bf = 0;
#pragma unroll 1
        for (int a = 0; a < 16; ++a) {
          const float va = v1[a];
          const int nb = 16 / (a + 1);
          for (int b = 0; b < nb; ++b) {
            const float sum = va + v2[b];
            const int f = a * 16 + b;
            const bool valid = (sum < pv) || (sum == pv && f > pf);
            if (valid && sum > bv) { bv = sum; bf = f; }
          }
        }
        if (q == 0) vmax = bv;
        const float ex = expf(bv - vmax);
        se += ex;
        const int e = (int)sidx[ra * 16 + (bf >> 4)] * 128 + (int)sidx[rb * 16 + (bf & 15)];
        r1[32 + q] = __int_as_float(e);
        r1[48 + q] = ex;
        pv = bv; pf = bf;
      }
      const float inv = 1.f / se;
      for (int q = 0; q < 16; ++q) r1[48 + q] *= inv;
    }
    __syncthreads();
#pragma unroll 1
    for (int tk = 0; tk < 2; ++tk) {
      const int tok = wave * 2 + tk;
      const int t = t0 + tok;
      const u16* h2r = p.hbuf + (size_t)t * D;
      const uint4 hx0 = *(const uint4*)&h2r[lane * 8];
      const uint4 hx1 = *(const uint4*)&h2r[512 + lane * 8];
      float o[16];
#pragma unroll
      for (int j = 0; j < 16; ++j) o[j] = 0.f;
#pragma unroll 1
      for (int head = 0; head < 8; ++head) {
        const float* r1 = sc + ((head * 2) * 16 + tok) * 129;
        const int myid = __float_as_int(r1[32 + l15]);
        const float gate = r1[48 + l15];
        float pa[16];
#pragma unroll
        for (int grp = 0; grp < 2; ++grp) {
          uint4 ua[8], ub[8];
#pragma unroll
          for (int i = 0; i < 8; ++i) {
            const int e = __builtin_amdgcn_readlane(myid, grp * 8 + i);
            const u16* ur = p.ub + (size_t)e * D;
            ua[i] = *(const uint4*)&ur[lane * 8];
            ub[i] = *(const uint4*)&ur[512 + lane * 8];
          }
#pragma unroll
          for (int i = 0; i < 8; ++i) pa[grp * 8 + i] = dot8(hx1, ub[i], dot8(hx0, ua[i], 0.f));
          __builtin_amdgcn_sched_barrier(0);
        }
        float q8[8], q4[4], q2[2], q1;
        {
          const bool b3 = (lane & 8) != 0;
#pragma unroll
          for (int i = 0; i < 8; ++i) {
            const float keep = b3 ? pa[i + 8] : pa[i];
            const float send = b3 ? pa[i] : pa[i + 8];
            q8[i] = keep + __shfl_xor(send, 8);
          }
          const bool b2 = (lane & 4) != 0;
#pragma unroll
          for (int i = 0; i < 4; ++i) {
            const float keep = b2 ? q8[i + 4] : q8[i];
            const float send = b2 ? q8[i] : q8[i + 4];
            q4[i] = keep + __shfl_xor(send, 4);
          }
          const bool b1 = (lane & 2) != 0;
#pragma unroll
          for (int i = 0; i < 2; ++i) {
            const float keep = b1 ? q4[i + 2] : q4[i];
            const float send = b1 ? q4[i] : q4[i + 2];
            q2[i] = keep + __shfl_xor(send, 2);
          }
          const bool b0 = (lane & 1) != 0;
          {
            const float keep = b0 ? q2[1] : q2[0];
            const float send = b0 ? q2[0] : q2[1];
            q1 = keep + __shfl_xor(send, 1);
          }
          q1 += __shfl_xor(q1, 16);
          q1 += __shfl_xor(q1, 32);
        }
        const float ge = 0.5f * q1 * (1.f + erff(q1 * 0.7071067811865476f));
        const float w = gate * ge;
        const int wbits = __float_as_int(w);
        __builtin_amdgcn_sched_barrier(0);
#pragma unroll
        for (int grp = 0; grp < 2; ++grp) {
          uint4 va[8], vb[8];
#pragma unroll
          for (int i = 0; i < 8; ++i) {
            const int e = __builtin_amdgcn_readlane(myid, grp * 8 + i);
            const u16* vr = p.vb + (size_t)e * D;
            va[i] = *(const uint4*)&vr[lane * 8];
            vb[i] = *(const uint4*)&vr[512 + lane * 8];
          }
#pragma unroll
          for (int i = 0; i < 8; ++i) {
            const float wi = __int_as_float(__builtin_amdgcn_readlane(wbits, grp * 8 + i));
            o[0] += wi * lo_f(va[i].x); o[1] += wi * hi_f(va[i].x);
            o[2] += wi * lo_f(va[i].y); o[3] += wi * hi_f(va[i].y);
            o[4] += wi * lo_f(va[i].z); o[5] += wi * hi_f(va[i].z);
            o[6] += wi * lo_f(va[i].w); o[7] += wi * hi_f(va[i].w);
            o[8] += wi * lo_f(vb[i].x); o[9] += wi * hi_f(vb[i].x);
            o[10] += wi * lo_f(vb[i].y); o[11] += wi * hi_f(vb[i].y);
            o[12] += wi * lo_f(vb[i].z); o[13] += wi * hi_f(vb[i].z);
            o[14] += wi * lo_f(vb[i].w); o[15] += wi * hi_f(vb[i].w);
          }
          __builtin_amdgcn_sched_barrier(0);
        }
      }
      const int ci = t < TCTX ? 0 : 1 + ((t - TCTX) >> 12);
      const float* ga2 = p.mod + ci * 6144 + 5 * 1024;
      float* xr = p.out + (size_t)t * D;
      float x2[16];
      float ss = 0.f;
#pragma unroll
      for (int hlf = 0; hlf < 2; ++hlf) {
        const int col = hlf * 512 + lane * 8;
        const float4 xa = *(const float4*)&xr[col], xb = *(const float4*)&xr[col + 4];
        const float4 ga = *(const float4*)&ga2[col], gb = *(const float4*)&ga2[col + 4];
        x2[hlf * 8 + 0] = xa.x + ga.x * o[hlf * 8 + 0];
        x2[hlf * 8 + 1] = xa.y + ga.y * o[hlf * 8 + 1];
        x2[hlf * 8 + 2] = xa.z + ga.z * o[hlf * 8 + 2];
        x2[hlf * 8 + 3] = xa.w + ga.w * o[hlf * 8 + 3];
        x2[hlf * 8 + 4] = xb.x + gb.x * o[hlf * 8 + 4];
        x2[hlf * 8 + 5] = xb.y + gb.y * o[hlf * 8 + 5];
        x2[hlf * 8 + 6] = xb.z + gb.z * o[hlf * 8 + 6];
        x2[hlf * 8 + 7] = xb.w + gb.w * o[hlf * 8 + 7];
      }
#pragma unroll
      for (int j = 0; j < 16; ++j) ss += x2[j] * x2[j];
      ss = wave_sum(ss);
      const float rstd = rsqrtf(ss * (1.f / 1024.f) + EPS);
#pragma unroll
      for (int hlf = 0; hlf < 2; ++hlf) {
        const int col = hlf * 512 + lane * 8;
        const float4 g0 = *(const float4*)&p.g_final[col], g1 = *(const float4*)&p.g_final[col + 4];
        *(float4*)&xr[col] = make_float4(x2[hlf * 8 + 0] * rstd * g0.x, x2[hlf * 8 + 1] * rstd * g0.y,
                                         x2[hlf * 8 + 2] * rstd * g0.z, x2[hlf * 8 + 3] * rstd * g0.w);
        *(float4*)&xr[col + 4] = make_float4(x2[hlf * 8 + 4] * rstd * g1.x, x2[hlf * 8 + 5] * rstd * g1.y,
                                             x2[hlf * 8 + 6] * rstd * g1.z, x2[hlf * 8 + 7] * rstd * g1.w);
      }
    }
  }
}

__global__ void __launch_bounds__(NT) mega(P p, int ph_lo, int ph_hi) {
  extern __shared__ __attribute__((aligned(16))) char smem[];
  cg::grid_group grid = cg::this_grid();
#define RUN_PHASE(k, call)                              \
  if (ph_lo <= (k) && (k) < ph_hi) {                    \
    call;                                               \
    if ((k) + 1 < ph_hi) grid.sync();                   \
  }
  RUN_PHASE(0, phase_prep(p, smem))
  RUN_PHASE(1, phase_norm(p, 0))
  RUN_PHASE(2, gemm_phase<0>(p, p.hbuf, p.w_in_t, NPAD / 128, smem))
  RUN_PHASE(3, phase_mlstm(p, smem))
  RUN_PHASE(4, phase_mix(p))
  RUN_PHASE(5, gemm_phase<1>(p, p.hbuf, p.w_out_t, 1024 / 128, smem))
  RUN_PHASE(6, (phase_norm(p, 1), convert_tables(p)))
  RUN_PHASE(7, gemm_phase<2>(p, p.hbuf, p.wq_t, 2048 / 128, smem))
  RUN_PHASE(8, phase_peer(p, smem))
}

extern "C" void kernel_launch(void* const* d_in, const int* in_sizes, int n_in, void* d_out, int out_size,
                              void* d_ws, size_t ws_size, hipStream_t stream) {
  P p{};
  const float* const* in = (const float* const*)d_in;
  p.x_prompt = in[0]; p.x_sample = in[1]; p.state_C = in[2]; p.state_n = in[3]; p.state_m = in[4];
  p.c = in[5]; p.c_ctx = in[6]; p.w_ada = in[7]; p.b_ada = in[8]; p.g_norm1 = in[9]; p.w_in = in[10];
  p.b_igate = in[11]; p.b_fgate = in[12]; p.conv_w = in[13]; p.conv_b = in[14]; p.g_mlstm = in[15];
  p.w_out = in[16]; p.g_norm2 = in[17]; p.wq = in[18]; p.k1 = in[19]; p.k2 = in[20]; p.u = in[21]; p.v = in[22];
  p.g_final = in[23];
  p.out = (float*)d_out;
  char* ws = (char*)d_ws;
  size_t off = 0;
  auto take = [&](size_t bytes) { char* r = ws + off; off += (bytes + 255) & ~(size_t)255; return r; };
  p.mod = (float*)take(5 * 6144 * 4);
  p.w_in_t = (u16*)take((size_t)NPAD * 1024 * 2);
  p.w_out_t = (u16*)take((size_t)1024 * 1024 * 2);
  p.wq_t = (u16*)take((size_t)2048 * 1024 * 2);
  p.kb = (u16*)take(2 * 16384 * 2);
  p.gates = (float*)take((size_t)T * 16 * 4);
  p.hbuf = (u16*)take((size_t)T * D * 2);
  p.proj = (u16*)take((size_t)T * NPROJ * 2);
  p.qp = p.proj;
  p.ub = p.proj + (size_t)T * 2048;
  p.vb = p.ub + (size_t)16384 * 1024;

  hipFuncSetAttribute((const void*)mega, hipFuncAttributeMaxDynamicSharedMemorySize, LDS_BYTES);
  int dev = 0, cus = 0, per = 0;
  hipGetDevice(&dev);
  hipDeviceGetAttribute(&cus, hipDeviceAttributeMultiprocessorCount, dev);
  hipOccupancyMaxActiveBlocksPerMultiprocessor(&per, (const void*)mega, NT, LDS_BYTES);
  if (per < 1) per = 1;
  const int grid = cus;
#if MULTI_LAUNCH
  for (int ph = 0; ph < NPHASE; ++ph) {
    hipLaunchKernelGGL(mega, dim3(grid), dim3(NT), LDS_BYTES, stream, p, ph, ph + 1);
  }
#else
  int lo = 0, hi = NPHASE;
  void* args[] = {&p, &lo, &hi};
  hipError_t e = hipLaunchCooperativeKernel((const void*)mega, dim3(grid), dim3(NT), args, LDS_BYTES, stream);
  if (e != hipSuccess) fprintf(stderr, "cooperative launch failed: %s (grid %d)\n", hipGetErrorString(e), grid);
#endif
}
```

```cpp
#include <hip/hip_runtime.h>
#include <hip/hip_cooperative_groups.h>
#include <cstdio>
#include <cstdint>
namespace cg = cooperative_groups;

#ifndef MULTI_LAUNCH
#define MULTI_LAUNCH 0
#endif

typedef unsigned short u16;
typedef __attribute__((ext_vector_type(8))) short bf16x8;
typedef __attribute__((ext_vector_type(4))) float f32x4;
typedef __attribute__((ext_vector_type(2))) __bf16 bf2_t;

constexpr int NT = 512;
constexpr int D = 1024;
constexpr int TCTX = 8192;
constexpr int TLAT = 16384;
constexpr int T = TCTX + TLAT;
constexpr int NPROJ = 3584;
constexpr int NPAD = 3712;
constexpr int LDS_BYTES = 256 * 130 * 4 + 256 * 16 * 4;
constexpr float EPS = 1e-6f;
constexpr int NPHASE = 9;

struct P {
  const float *x_prompt, *x_sample, *state_C, *state_n, *state_m, *c, *c_ctx, *w_ada, *b_ada, *g_norm1, *w_in,
      *b_igate, *b_fgate, *conv_w, *conv_b, *g_mlstm, *w_out, *g_norm2, *wq, *k1, *k2, *u, *v, *g_final;
  float* out;
  float* mod;
  u16* w_in_t;
  u16* w_out_t;
  u16* wq_t;
  u16* kb;
  float* gates;
  u16* hbuf;
  u16* proj;
  u16* qp;
  u16* ub;
  u16* vb;
};

__device__ __forceinline__ u16 f2bf(float f) {
  unsigned u = __float_as_uint(f);
  u += 0x7fffu + ((u >> 16) & 1u);
  return (u16)(u >> 16);
}
__device__ __forceinline__ float bf2f(u16 h) { return __uint_as_float(((unsigned)h) << 16); }
__device__ __forceinline__ unsigned pack2(float a, float b) { return (unsigned)f2bf(a) | ((unsigned)f2bf(b) << 16); }
__device__ __forceinline__ float lo_f(unsigned w) { return __uint_as_float(w << 16); }
__device__ __forceinline__ float hi_f(unsigned w) { return __uint_as_float(w & 0xffff0000u); }
__device__ __forceinline__ float wave_sum(float v) {
#pragma unroll
  for (int o = 32; o > 0; o >>= 1) v += __shfl_xor(v, o);
  return v;
}
__device__ __forceinline__ float dot2(unsigned a, unsigned b, float c) {
  return __builtin_amdgcn_fdot2_f32_bf16(__builtin_bit_cast(bf2_t, a), __builtin_bit_cast(bf2_t, b), c, false);
}
__device__ __forceinline__ float dot8(uint4 a, uint4 b, float c) {
  c = dot2(a.x, b.x, c); c = dot2(a.y, b.y, c); c = dot2(a.z, b.z, c); c = dot2(a.w, b.w, c);
  return c;
}
__device__ __forceinline__ f32x4 mfma16(bf16x8 a, bf16x8 b, f32x4 c) {
  return __builtin_amdgcn_mfma_f32_16x16x32_bf16(a, b, c, 0, 0, 0);
}

__device__ __forceinline__ void transpose_tile(const float* __restrict__ W, int Nreal, u16* __restrict__ Wt, int k0, int n0, float* tile) {
  const int tid = threadIdx.x;
#pragma unroll
  for (int i = 0; i < 8; ++i) {
    int idx = i * NT + tid;
    int kk = idx >> 6, nn = idx & 63;
    float v = (n0 + nn < Nreal) ? W[(size_t)(k0 + kk) * Nreal + n0 + nn] : 0.f;
    tile[kk * 65 + nn] = v;
  }
  __syncthreads();
#pragma unroll
  for (int i = 0; i < 8; ++i) {
    int idx = i * NT + tid;
    int nn = idx >> 6, kk = idx & 63;
    Wt[(size_t)(n0 + nn) * 1024 + k0 + kk] = f2bf(tile[kk * 65 + nn]);
  }
}

__device__ __forceinline__ void phase_prep(const P& p, char* smem) {
  const int tid = threadIdx.x;
  float* sf = (float*)smem;
  const int n_gemv = 96, n_tin = 16 * 58, n_tout = 16 * 16, n_tq = 16 * 32, n_k = 2;
  const int total = n_gemv + n_tin + n_tout + n_tq + n_k;
  for (int it = blockIdx.x; it < total; it += gridDim.x) {
    __syncthreads();
    if (it < n_gemv) {
      for (int i = tid; i < 5 * 1024; i += NT) {
        int ci = i >> 10, k = i & 1023;
        float cv = (ci == 0) ? p.c_ctx[k] : p.c[(ci - 1) * 1024 + k];
        sf[i] = cv / (1.f + expf(-cv));
      }
      __syncthreads();
      const int cl = tid & 15, kg = tid >> 4;
      const int col = it * 64 + cl * 4;
      float acc[5][4];
#pragma unroll
      for (int ci = 0; ci < 5; ++ci)
#pragma unroll
        for (int j = 0; j < 4; ++j) acc[ci][j] = 0.f;
      for (int kk = 0; kk < 32; ++kk) {
        int k = kg * 32 + kk;
        float4 w = *(const float4*)&p.w_ada[(size_t)k * 6144 + col];
#pragma unroll
        for (int ci = 0; ci < 5; ++ci) {
          float s = sf[ci * 1024 + k];
          acc[ci][0] += s * w.x; acc[ci][1] += s * w.y; acc[ci][2] += s * w.z; acc[ci][3] += s * w.w;
        }
      }
      float* red = sf + 5 * 1024;
#pragma unroll
      for (int ci = 0; ci < 5; ++ci)
#pragma unroll
        for (int j = 0; j < 4; ++j) red[(kg * 16 + cl) * 20 + ci * 4 + j] = acc[ci][j];
      __syncthreads();
      if (tid < 320) {
        int ci = tid >> 6, cc = tid & 63;
        int cl2 = cc >> 2, j = cc & 3;
        float s = 0.f;
        for (int g = 0; g < 32; ++g) s += red[(g * 16 + cl2) * 20 + ci * 4 + j];
        int col2 = it * 64 + cc;
        p.mod[ci * 6144 + col2] = s + p.b_ada[col2];
      }
    } else if (it < n_gemv + n_tin) {
      int j = it - n_gemv;
      transpose_tile(p.w_in, 3600, p.w_in_t, (j / 58) * 64, (j % 58) * 64, sf);
    } else if (it < n_gemv + n_tin + n_tout) {
      int j = it - n_gemv - n_tin;
      transpose_tile(p.w_out, 1024, p.w_out_t, (j / 16) * 64, (j % 16) * 64, sf);
    } else if (it < n_gemv + n_tin + n_tout + n_tq) {
      int j = it - n_gemv - n_tin - n_tout;
      transpose_tile(p.wq, 2048, p.wq_t, (j / 32) * 64, (j % 32) * 64, sf);
    } else {
      int j = it - n_gemv - n_tin - n_tout - n_tq;
      const float* src = j ? p.k2 : p.k1;
      u16* dst = p.kb + j * 16384;
      for (int i = tid; i < 16384; i += NT) dst[i] = f2bf(src[i]);
    }
  }
}

__device__ __forceinline__ void phase_norm(const P& p, int which) {
  const int wave = threadIdx.x >> 6, lane = threadIdx.x & 63;
  for (int t = blockIdx.x * 8 + wave; t < T; t += gridDim.x * 8) {
    const float* xr = which ? (p.out + (size_t)t * D)
                            : (t < TCTX ? p.x_prompt + (size_t)t * D : p.x_sample + (size_t)(t - TCTX) * D);
    const int ci = t < TCTX ? 0 : 1 + ((t - TCTX) >> 12);
    const float* md = p.mod + ci * 6144 + (which ? 3 * 1024 : 0);
    const float* g = which ? p.g_norm2 : p.g_norm1;
    float4 xv[4];
    float ss = 0.f;
#pragma unroll
    for (int i = 0; i < 4; ++i) {
      xv[i] = *(const float4*)&xr[i * 256 + lane * 4];
      ss += xv[i].x * xv[i].x + xv[i].y * xv[i].y + xv[i].z * xv[i].z + xv[i].w * xv[i].w;
    }
    ss = wave_sum(ss);
    const float rstd = rsqrtf(ss * (1.f / 1024.f) + EPS);
#pragma unroll
    for (int i = 0; i < 4; ++i) {
      int col = i * 256 + lane * 4;
      float4 g4 = *(const float4*)&g[col];
      float4 sh = *(const float4*)&md[col];
      float4 sc = *(const float4*)&md[1024 + col];
      float h0 = xv[i].x * rstd * g4.x * (1.f + sc.x) + sh.x;
      float h1 = xv[i].y * rstd * g4.y * (1.f + sc.y) + sh.y;
      float h2 = xv[i].z * rstd * g4.z * (1.f + sc.z) + sh.z;
      float h3 = xv[i].w * rstd * g4.w * (1.f + sc.w) + sh.w;
      uint2 o; o.x = pack2(h0, h1); o.y = pack2(h2, h3);
      *(uint2*)&p.hbuf[(size_t)t * D + col] = o;
    }
  }
}

__device__ __forceinline__ void convert_tables(const P& p) {
  const size_t n4 = (size_t)16384 * 1024 / 4;
  const size_t stride = (size_t)gridDim.x * NT;
  for (size_t i = (size_t)blockIdx.x * NT + threadIdx.x; i < 2 * n4; i += stride) {
    const float* src = i < n4 ? p.u : p.v;
    u16* dst = i < n4 ? p.ub : p.vb;
    size_t j = i < n4 ? i : i - n4;
    float4 f = *(const float4*)&src[j * 4];
    uint2 o; o.x = pack2(f.x, f.y); o.y = pack2(f.z, f.w);
    *(uint2*)&dst[j * 4] = o;
  }
}

template <int MODE>
__device__ __forceinline__ void gemm_phase(const P& p, const u16* __restrict__ A, const u16* __restrict__ Bt, int ntn, char* smem) {
  const int tid = threadIdx.x, lane = tid & 63, wave = tid >> 6;
  const int wm = wave >> 1, wn = wave & 1, l15 = lane & 15, quad = lane >> 4;
  u16* sA = (u16*)smem;
  u16* sB = sA + 2 * 256 * 72;
  const int ntiles = (T / 256) * ntn;
  for (int tile = blockIdx.x; tile < ntiles; tile += gridDim.x) {
    const int mt = tile / ntn, nt = tile % ntn;
    const int m0 = mt * 256, n0 = nt * 128;
    f32x4 acc[4][4];
#pragma unroll
    for (int i = 0; i < 4; ++i)
#pragma unroll
      for (int j = 0; j < 4; ++j) acc[i][j] = (f32x4){0.f, 0.f, 0.f, 0.f};
    uint4 ra[4], rb[2];
    const int lrow = tid >> 3, lch = tid & 7;
#pragma unroll
    for (int i = 0; i < 4; ++i) ra[i] = *(const uint4*)&A[(size_t)(m0 + i * 64 + lrow) * 1024 + lch * 8];
#pragma unroll
    for (int i = 0; i < 2; ++i) rb[i] = *(const uint4*)&Bt[(size_t)(n0 + i * 64 + lrow) * 1024 + lch * 8];
#pragma unroll
    for (int i = 0; i < 4; ++i) *(uint4*)&sA[(i * 64 + lrow) * 72 + lch * 8] = ra[i];
#pragma unroll
    for (int i = 0; i < 2; ++i) *(uint4*)&sB[(i * 64 + lrow) * 72 + lch * 8] = rb[i];
    __syncthreads();
    for (int kt = 0; kt < 16; ++kt) {
      if (kt + 1 < 16) {
#pragma unroll
        for (int i = 0; i < 4; ++i) ra[i] = *(const uint4*)&A[(size_t)(m0 + i * 64 + lrow) * 1024 + (kt + 1) * 64 + lch * 8];
#pragma unroll
        for (int i = 0; i < 2; ++i) rb[i] = *(const uint4*)&Bt[(size_t)(n0 + i * 64 + lrow) * 1024 + (kt + 1) * 64 + lch * 8];
      }
      const u16* a_s = sA + (kt & 1) * 256 * 72;
      const u16* b_s = sB + (kt & 1) * 128 * 72;
#pragma unroll
      for (int ks = 0; ks < 2; ++ks) {
        bf16x8 bfr[4], afr[4];
#pragma unroll
        for (int ni = 0; ni < 4; ++ni) bfr[ni] = *(const bf16x8*)&b_s[(wn * 64 + ni * 16 + l15) * 72 + ks * 32 + quad * 8];
#pragma unroll
        for (int mi = 0; mi < 4; ++mi) afr[mi] = *(const bf16x8*)&a_s[(wm * 64 + mi * 16 + l15) * 72 + ks * 32 + quad * 8];
#pragma unroll
        for (int ni = 0; ni < 4; ++ni)
#pragma unroll
          for (int mi = 0; mi < 4; ++mi) acc[ni][mi] = mfma16(bfr[ni], afr[mi], acc[ni][mi]);
      }
      if (kt + 1 < 16) {
        u16* a_w = sA + ((kt + 1) & 1) * 256 * 72;
        u16* b_w = sB + ((kt + 1) & 1) * 128 * 72;
#pragma unroll
        for (int i = 0; i < 4; ++i) *(uint4*)&a_w[(i * 64 + lrow) * 72 + lch * 8] = ra[i];
#pragma unroll
        for (int i = 0; i < 2; ++i) *(uint4*)&b_w[(i * 64 + lrow) * 72 + lch * 8] = rb[i];
      }
      __syncthreads();
    }
#pragma unroll
    for (int mi = 0; mi < 4; ++mi) {
      const int m = m0 + wm * 64 + mi * 16 + l15;
#pragma unroll
      for (int ni = 0; ni < 4; ++ni) {
        const int n = n0 + wn * 64 + ni * 16 + quad * 4;
        f32x4 a = acc[ni][mi];
        if (MODE == 0) {
          if (n < NPROJ) {
            uint2 o; o.x = pack2(a[0], a[1]); o.y = pack2(a[2], a[3]);
            *(uint2*)&p.proj[(size_t)m * NPROJ + n] = o;
          } else if (n < 3600) {
            *(float4*)&p.gates[(size_t)m * 16 + (n - NPROJ)] = make_float4(a[0], a[1], a[2], a[3]);
          }
        } else if (MODE == 1) {
          const float* xr = m < TCTX ? p.x_prompt + (size_t)m * D : p.x_sample + (size_t)(m - TCTX) * D;
          const int ci = m < TCTX ? 0 : 1 + ((m - TCTX) >> 12);
          float4 xv = *(const float4*)&xr[n];
          float4 ga = *(const float4*)&p.mod[ci * 6144 + 2 * 1024 + n];
          float4 o = make_float4(xv.x + ga.x * a[0], xv.y + ga.y * a[1], xv.z + ga.z * a[2], xv.w + ga.w * a[3]);
          *(float4*)&p.out[(size_t)m * D + n] = o;
        } else {
          uint2 o; o.x = pack2(a[0], a[1]); o.y = pack2(a[2], a[3]);
          *(uint2*)&p.qp[(size_t)m * 2048 + n] = o;
        }
      }
    }
  }
}

__device__ __forceinline__ void mlstm_task(const P& p, int task, char* smem) {
  const int tid = threadIdx.x, lane = tid & 63, wave = tid >> 6, l15 = lane & 15, quad = lane >> 4;
  const bool lat = task < 128;
  const int id = lat ? task : task - 128;
  const int slice = id & 3, dir = (id >> 2) & 1, head = (id >> 3) & 3, bat = id >> 5;
  const int tb = lat ? TCTX + bat * 4096 : bat * 256;
  const int L = lat ? 4096 : 256;
  const int nch = L >> 6;
  const int gcol = dir * 4 + head;
  const float big = p.b_igate[gcol], bfg = p.b_fgate[gcol];
  const float scale = 0.08838834764831845f;

  u16* sQ = (u16*)smem;
  u16* sK = sQ + 64 * 136;
  u16* sKt = sK + 64 * 136;
  u16* sVt = sKt + 128 * 72;
  u16* sS = sVt + 32 * 72;
  u16* sCt = sS + 64 * 72;
  float* sg = (float*)(sCt + 32 * 136);
  float* smm = sg + 64;
  float* sa = smm + 64;
  float* semt = sa + 64;
  float* sden = semt + 64;
  float* sqn = sden + 64;
  float* sN = sqn + 64;

  const int sbase = (bat * 2 + dir) * 4 + head;
  f32x4 C[2];
  float m;
  __syncthreads();
  if (lat) {
#pragma unroll
    for (int tj = 0; tj < 2; ++tj)
#pragma unroll
      for (int r = 0; r < 4; ++r)
        C[tj][r] = p.state_C[(size_t)sbase * 16384 + (wave * 16 + quad * 4 + r) * 128 + slice * 32 + tj * 16 + l15];
    m = p.state_m[sbase];
    if (tid < 128) sN[tid] = p.state_n[sbase * 128 + tid];
  } else {
    C[0] = (f32x4){0.f, 0.f, 0.f, 0.f};
    C[1] = (f32x4){0.f, 0.f, 0.f, 0.f};
    m = 0.f;
    if (tid < 128) sN[tid] = 0.f;
  }
#pragma unroll
  for (int tj = 0; tj < 2; ++tj) {
    uint2 o; o.x = pack2(C[tj][0], C[tj][1]); o.y = pack2(C[tj][2], C[tj][3]);
    *(uint2*)&sCt[(tj * 16 + l15) * 136 + wave * 16 + quad * 4] = o;
  }
  __syncthreads();

  float* hout = p.out + (size_t)dir * T * 512;
  const int s = tid >> 3, part = tid & 7;

  for (int c = 0; c < nch; ++c) {
    const int posl = c * 64 + lane;
    const int tl = tb + (dir ? (L - 1 - posl) : posl);
    const float ig = p.gates[(size_t)tl * 16 + gcol] + big;
    const float fr = p.gates[(size_t)tl * 16 + 8 + gcol] + bfg;
    const float lf = fminf(fr, 0.f) - log1pf(expf(-fabsf(fr)));
    float b = lf;
#pragma unroll
    for (int off = 1; off < 64; off <<= 1) { float v = __shfl_up(b, off); if (lane >= off) b += v; }
    const float g = ig - b;
    float G = g;
#pragma unroll
    for (int off = 1; off < 64; off <<= 1) { float v = __shfl_up(G, off); if (lane >= off) G = fmaxf(G, v); }
    const float mm = fmaxf(m, G);
    const float mmT = __shfl(mm, 63), bT = __shfl(b, 63);
    const float wgt = expf(g - mmT);
    const float decay = expf(m - mmT);
    const float m_new = bT + mmT;
    if (wave == 0) {
      sg[lane] = g; smm[lane] = mm; sa[lane] = expf(m - mm); semt[lane] = expf(-(b + mm)); sden[lane] = 0.f;
    }
    const int poss = c * 64 + s;
    const int ts = tb + (dir ? (L - 1 - poss) : poss);
    const u16* prow = p.proj + (size_t)ts * NPROJ;
    const uint4 q0 = *(const uint4*)&prow[1536 + head * 128 + part * 16];
    const uint4 q1 = *(const uint4*)&prow[1536 + head * 128 + part * 16 + 8];
    const uint4 k0 = *(const uint4*)&prow[2048 + head * 128 + part * 16];
    const uint4 k1 = *(const uint4*)&prow[2048 + head * 128 + part * 16 + 8];
    const uint2 vv = *(const uint2*)&prow[2560 + head * 128 + slice * 32 + part * 4];
    const float ws_ = __shfl(wgt, s);
    *(uint4*)&sQ[s * 136 + part * 16] = q0;
    *(uint4*)&sQ[s * 136 + part * 16 + 8] = q1;
    *(uint4*)&sK[s * 136 + part * 16] = k0;
    *(uint4*)&sK[s * 136 + part * 16 + 8] = k1;
    {
      const unsigned qw[8] = {q0.x, q0.y, q0.z, q0.w, q1.x, q1.y, q1.z, q1.w};
      float qn = 0.f;
#pragma unroll
      for (int j = 0; j < 8; ++j) {
        qn += lo_f(qw[j]) * sN[part * 16 + 2 * j] + hi_f(qw[j]) * sN[part * 16 + 2 * j + 1];
      }
      qn += __shfl_xor(qn, 1); qn += __shfl_xor(qn, 2); qn += __shfl_xor(qn, 4);
      if (part == 0) sqn[s] = qn * scale;
      const unsigned kw[8] = {k0.x, k0.y, k0.z, k0.w, k1.x, k1.y, k1.z, k1.w};
      const int pc = ((s >> 3) ^ part) * 8 + (s & 7);
#pragma unroll
      for (int j = 0; j < 8; ++j) {
        sKt[(part * 16 + 2 * j) * 72 + pc] = f2bf(lo_f(kw[j]) * ws_);
        sKt[(part * 16 + 2 * j + 1) * 72 + pc] = f2bf(hi_f(kw[j]) * ws_);
      }
      sVt[(part * 4 + 0) * 72 + pc] = (u16)(vv.x & 0xffffu);
      sVt[(part * 4 + 1) * 72 + pc] = (u16)(vv.x >> 16);
      sVt[(part * 4 + 2) * 72 + pc] = (u16)(vv.y & 0xffffu);
      sVt[(part * 4 + 3) * 72 + pc] = (u16)(vv.y >> 16);
    }
    __syncthreads();

    const int tj = wave >> 1, ti = wave & 1;
    const int trow = tj * 16 + l15;
    {
      const float mmt = smm[trow];
      float psum = 0.f;
#pragma unroll
      for (int tt = 0; tt < 2; ++tt) {
        const int si = (wave & 1) * 2 + tt;
        f32x4 acc = (f32x4){0.f, 0.f, 0.f, 0.f};
#pragma unroll
        for (int ks = 0; ks < 4; ++ks) {
          bf16x8 afr = *(const bf16x8*)&sK[(si * 16 + l15) * 136 + ks * 32 + quad * 8];
          bf16x8 bfr = *(const bf16x8*)&sQ[trow * 136 + ks * 32 + quad * 8];
          acc = mfma16(afr, bfr, acc);
        }
        const int s0 = si * 16 + quad * 4;
        float vals[4];
#pragma unroll
        for (int r = 0; r < 4; ++r) {
          const int sidx = s0 + r;
          const float e = expf(fminf(sg[sidx] - mmt, 0.f));
          const float val = (sidx <= trow) ? acc[r] * scale * e : 0.f;
          vals[r] = val;
          psum += val;
        }
        uint2 o; o.x = pack2(vals[0], vals[1]); o.y = pack2(vals[2], vals[3]);
        *(uint2*)&sS[trow * 72 + s0] = o;
      }
      psum += __shfl_xor(psum, 16);
      psum += __shfl_xor(psum, 32);
      if (quad == 0) atomicAdd(&sden[trow], psum);
    }
    f32x4 aqc = (f32x4){0.f, 0.f, 0.f, 0.f};
#pragma unroll
    for (int ks = 0; ks < 4; ++ks) {
      bf16x8 afr = *(const bf16x8*)&sCt[(ti * 16 + l15) * 136 + ks * 32 + quad * 8];
      bf16x8 bfr = *(const bf16x8*)&sQ[trow * 136 + ks * 32 + quad * 8];
      aqc = mfma16(afr, bfr, aqc);
    }
    __syncthreads();
    {
      f32x4 asv = (f32x4){0.f, 0.f, 0.f, 0.f};
      const int vrow = ti * 16 + l15;
      const int vkey = (vrow >> 2) & 7;
#pragma unroll
      for (int ks = 0; ks < 2; ++ks) {
        bf16x8 afr = *(const bf16x8*)&sVt[vrow * 72 + (((ks * 4 + quad) ^ vkey) * 8)];
        bf16x8 bfr = *(const bf16x8*)&sS[trow * 72 + ks * 32 + quad * 8];
        asv = mfma16(afr, bfr, asv);
      }
      const float a_t = sa[trow];
      const float den = a_t * sqn[trow] + sden[trow];
      const float inv = 1.f / fmaxf(fabsf(den), semt[trow]);
      const float as = a_t * scale;
      float4 h = make_float4((as * aqc[0] + asv[0]) * inv, (as * aqc[1] + asv[1]) * inv,
                             (as * aqc[2] + asv[2]) * inv, (as * aqc[3] + asv[3]) * inv);
      const int post = c * 64 + trow;
      const int tt = tb + (dir ? (L - 1 - post) : post);
      *(float4*)&hout[(size_t)tt * 512 + head * 128 + slice * 32 + ti * 16 + quad * 4] = h;
    }
#pragma unroll
    for (int t2 = 0; t2 < 2; ++t2) {
      C[t2][0] *= decay; C[t2][1] *= decay; C[t2][2] *= decay; C[t2][3] *= decay;
      const int krow = wave * 16 + l15;
      const int kkey = wave & 7;
      const int vrow = t2 * 16 + l15;
      const int vkey = (vrow >> 2) & 7;
#pragma unroll
      for (int ks = 0; ks < 2; ++ks) {
        bf16x8 afr = *(const bf16x8*)&sKt[krow * 72 + (((ks * 4 + quad) ^ kkey) * 8)];
        bf16x8 bfr = *(const bf16x8*)&sVt[vrow * 72 + (((ks * 4 + quad) ^ vkey) * 8)];
        C[t2] = mfma16(afr, bfr, C[t2]);
      }
    }
    if (tid < 128) {
      float sum = 0.f;
#pragma unroll
      for (int j = 0; j < 8; ++j) {
        uint4 w = *(const uint4*)&sKt[tid * 72 + j * 8];
        sum += lo_f(w.x) + hi_f(w.x) + lo_f(w.y) + hi_f(w.y) + lo_f(w.z) + hi_f(w.z) + lo_f(w.w) + hi_f(w.w);
      }
      sN[tid] = decay * sN[tid] + sum;
    }
#pragma unroll
    for (int t2 = 0; t2 < 2; ++t2) {
      uint2 o; o.x = pack2(C[t2][0], C[t2][1]); o.y = pack2(C[t2][2], C[t2][3]);
      *(uint2*)&sCt[(t2 * 16 + l15) * 136 + wave * 16 + quad * 4] = o;
    }
    m = m_new;
    __syncthreads();
  }
  if (!lat) {
    float* newC = p.out + (size_t)T * D;
    float* newn = newC + (size_t)32 * 2 * 4 * 128 * 128;
    float* newm = newn + 32 * 2 * 4 * 128;
#pragma unroll
    for (int t2 = 0; t2 < 2; ++t2)
#pragma unroll
      for (int r = 0; r < 4; ++r)
        newC[(size_t)sbase * 16384 + (wave * 16 + quad * 4 + r) * 128 + slice * 32 + t2 * 16 + l15] = C[t2][r];
    if (slice == 0) {
      if (tid < 128) newn[sbase * 128 + tid] = sN[tid];
      if (tid == 0) newm[sbase] = m;
    }
  }
}

__device__ __forceinline__ void phase_mlstm(const P& p, char* smem) {
  const int G = gridDim.x, b = blockIdx.x;
  if (G >= 256) {
    if (b < 128) mlstm_task(p, b, smem);
    else for (int task = b; task < 1152; task += G - 128) mlstm_task(p, task, smem);
  } else {
    for (int task = b; task < 1152; task += G) mlstm_task(p, task, smem);
  }
}

__device__ __forceinline__ void phase_mix(const P& p) {
  const int wave = threadIdx.x >> 6, lane = threadIdx.x & 63;
  for (int t = blockIdx.x * 8 + wave; t < T; t += gridDim.x * 8) {
    const u16* pr = p.proj + (size_t)t * NPROJ;
    const int seg = t < TCTX ? 256 : 64;
    const int pos = (t < TCTX ? t : t - TCTX) & (seg - 1);
    const bool hasL = pos > 0, hasR = pos < seg - 1;
    const int c0 = lane * 8;
    const uint4 zero4 = make_uint4(0u, 0u, 0u, 0u);
    const uint4 bg = *(const uint4*)&pr[c0];
    const uint4 cgC = *(const uint4*)&pr[512 + c0];
    const uint4 xgC = *(const uint4*)&pr[1024 + c0];
    const uint4 cgL = hasL ? *(const uint4*)&pr[-NPROJ + 512 + c0] : zero4;
    const uint4 xgL = hasL ? *(const uint4*)&pr[-NPROJ + 1024 + c0] : zero4;
    const uint4 cgR = hasR ? *(const uint4*)&pr[NPROJ + 512 + c0] : zero4;
    const uint4 xgR = hasR ? *(const uint4*)&pr[NPROJ + 1024 + c0] : zero4;
    const unsigned bgw[4] = {bg.x, bg.y, bg.z, bg.w};
    const unsigned cC[4] = {cgC.x, cgC.y, cgC.z, cgC.w}, xC[4] = {xgC.x, xgC.y, xgC.z, xgC.w};
    const unsigned cL[4] = {cgL.x, cgL.y, cgL.z, cgL.w}, xL[4] = {xgL.x, xgL.y, xgL.z, xgL.w};
    const unsigned cR[4] = {cgR.x, cgR.y, cgR.z, cgR.w}, xR[4] = {xgR.x, xgR.y, xgR.z, xgR.w};
    unsigned ow[4];
#pragma unroll
    for (int j = 0; j < 4; ++j) {
      const int ch = c0 + 2 * j;
      float w0a = p.conv_w[ch], w1a = p.conv_w[512 + ch], w2a = p.conv_w[1024 + ch], ba = p.conv_b[ch];
      float w0b = p.conv_w[ch + 1], w1b = p.conv_w[512 + ch + 1], w2b = p.conv_w[1024 + ch + 1], bb = p.conv_b[ch + 1];
      float ya = w0a * (lo_f(cL[j]) * lo_f(xL[j])) + w1a * (lo_f(cC[j]) * lo_f(xC[j])) + w2a * (lo_f(cR[j]) * lo_f(xR[j])) + ba;
      float yb = w0b * (hi_f(cL[j]) * hi_f(xL[j])) + w1b * (hi_f(cC[j]) * hi_f(xC[j])) + w2b * (hi_f(cR[j]) * hi_f(xR[j])) + bb;
      ow[j] = pack2(lo_f(bgw[j]) * ya, hi_f(bgw[j]) * yb);
    }
    *(uint4*)&p.hbuf[(size_t)t * D + c0] = make_uint4(ow[0], ow[1], ow[2], ow[3]);
    const float* hf = p.out + (size_t)t * 512 + c0;
    const float* hb = p.out + (size_t)T * 512 + (size_t)t * 512 + c0;
    const float4 f0 = *(const float4*)&hf[0], f1 = *(const float4*)&hf[4];
    const float4 b0 = *(const float4*)&hb[0], b1 = *(const float4*)&hb[4];
    float h[8] = {f0.x + b0.x, f0.y + b0.y, f0.z + b0.z, f0.w + b0.w, f1.x + b1.x, f1.y + b1.y, f1.z + b1.z, f1.w + b1.w};
    float ss = 0.f;
#pragma unroll
    for (int j = 0; j < 8; ++j) ss += h[j] * h[j];
    ss += __shfl_xor(ss, 1); ss += __shfl_xor(ss, 2); ss += __shfl_xor(ss, 4); ss += __shfl_xor(ss, 8);
    const float r = rsqrtf(ss * (1.f / 128.f) + EPS);
    const uint4 og = *(const uint4*)&pr[3072 + c0];
    const unsigned ogw[4] = {og.x, og.y, og.z, og.w};
    unsigned mw[4];
#pragma unroll
    for (int j = 0; j < 4; ++j) {
      float ga = p.g_mlstm[c0 + 2 * j], gb = p.g_mlstm[c0 + 2 * j + 1];
      float oa = lo_f(ogw[j]), ob = hi_f(ogw[j]);
      float sa_ = 1.f / (1.f + expf(-oa)), sb_ = 1.f / (1.f + expf(-ob));
      mw[j] = pack2(h[2 * j] * r * ga * sa_, h[2 * j + 1] * r * gb * sb_);
    }
    *(uint4*)&p.hbuf[(size_t)t * D + 512 + c0] = make_uint4(mw[0], mw[1], mw[2], mw[3]);
  }
}

__device__ __forceinline__ unsigned f2key(float f) {
  const unsigned u = __float_as_uint(f);
  return (u & 0x80000000u) ? ~u : (u | 0x80000000u);
}
__device__ __forceinline__ float key2f(unsigned k, unsigned mask) {
  const unsigned m = k & ~mask;
  const unsigned u = (m & 0x80000000u) ? (m & 0x7fffffffu) : ~m;
  return __uint_as_float(u);
}
#define KINSERT(LIST, KEY)                                   \
  {                                                          \
    unsigned kk_ = (KEY);                                    \
    _Pragma("unroll") for (int j_ = 0; j_ < 16; ++j_) {      \
      const unsigned hi_ = max(LIST[j_], kk_);               \
      kk_ = min(LIST[j_], kk_);                              \
      LIST[j_] = hi_;                                        \
    }                                                        \
  }
#define SBAR __builtin_amdgcn_sched_barrier(0)
__device__ __forceinline__ int launder(int v) { asm volatile("" : "+v"(v)); return v; }
#define G_ISSUE(B0, B1, TAB, IDS, G)                                           \
  _Pragma("unroll") for (int i_ = 0; i_ < 8; ++i_) {                           \
    const int e_ = __builtin_amdgcn_readlane(IDS, (G) * 8 + i_);               \
    const u16* r_ = (TAB) + (size_t)e_ * D;                                    \
    B0[i_] = *(const uint4*)&r_[lane * 8];                                     \
    B1[i_] = *(const uint4*)&r_[512 + lane * 8];                               \
  }
#define G_DOTU(B0, B1, G)                                                      \
  _Pragma("unroll") for (int i_ = 0; i_ < 8; ++i_) pa[(G) * 8 + i_] = dot8(hx1, B1[i_], dot8(hx0, B0[i_], 0.f));
#define V_ACC2(XA, XB, J, WP)                                                                  \
  o[J] = dot2(__builtin_amdgcn_perm(XB, XA, 0x05040100u), WP, o[J]);                           \
  o[(J) + 1] = dot2(__builtin_amdgcn_perm(XB, XA, 0x07060302u), WP, o[(J) + 1]);
#define G_ACCV(B0, B1, G)                                                                      \
  _Pragma("unroll") for (int i_ = 0; i_ < 8; i_ += 2) {                                        \
    const float wa_ = __int_as_float(__builtin_amdgcn_readlane(wbits, (G) * 8 + i_));          \
    const float wb_ = __int_as_float(__builtin_amdgcn_readlane(wbits, (G) * 8 + i_ + 1));      \
    const unsigned wp_ = pack2(wa_, wb_);                                                      \
    V_ACC2(B0[i_].x, B0[i_ + 1].x, 0, wp_) V_ACC2(B0[i_].y, B0[i_ + 1].y, 2, wp_)              \
    V_ACC2(B0[i_].z, B0[i_ + 1].z, 4, wp_) V_ACC2(B0[i_].w, B0[i_ + 1].w, 6, wp_)              \
    V_ACC2(B1[i_].x, B1[i_ + 1].x, 8, wp_) V_ACC2(B1[i_].y, B1[i_ + 1].y, 10, wp_)             \
    V_ACC2(B1[i_].z, B1[i_ + 1].z, 12, wp_) V_ACC2(B1[i_].w, B1[i_ + 1].w, 14, wp_)            \
  }

__device__ __forceinline__ void phase_peer(const P& p, char* smem) {
  unsigned* sc = (unsigned*)smem;
  unsigned* skey = sc + 256 * 130;
  int* sE = (int*)sc;
  float* sG = (float*)(sc + 2048);
  for (int it = blockIdx.x; it < T / 16; it += gridDim.x) {
    const int t0 = it * 16;
    __syncthreads();
    {
      const int tid = launder(threadIdx.x), lane = tid & 63, wave = tid >> 6, l15 = lane & 15, quad = lane >> 4;
      const int half = wave >> 2;
      const u16* kb = p.kb + half * 16384;
#pragma unroll 1
      for (int hh = 0; hh < 2; ++hh) {
        const int head = (wave & 3) * 2 + hh;
        bf16x8 qf[4];
#pragma unroll
        for (int ks = 0; ks < 4; ++ks)
          qf[ks] = *(const bf16x8*)&p.qp[(size_t)(t0 + l15) * 2048 + head * 256 + half * 128 + ks * 32 + quad * 8];
        const int row = (head * 2 + half) * 16 + l15;
#pragma unroll 1
        for (int nt = 0; nt < 8; ++nt) {
          f32x4 acc = (f32x4){0.f, 0.f, 0.f, 0.f};
#pragma unroll
          for (int ks = 0; ks < 4; ++ks) {
            bf16x8 kf = *(const bf16x8*)&kb[(nt * 16 + l15) * 128 + ks * 32 + quad * 8];
            acc = mfma16(kf, qf[ks], acc);
          }
          const int key = nt * 16 + quad * 4;
          const int pos = key + (key >= 64 ? 1 : 0);
#pragma unroll
          for (int r = 0; r < 4; ++r) sc[row * 130 + pos + r] = (f2key(acc[r]) & ~0x7Fu) | (unsigned)(127 - (key + r));
        }
      }
    }
    __syncthreads();
    {
      const int tid = launder(threadIdx.x);
      const int row = tid >> 1, hs = tid & 1;
      const unsigned* src = sc + row * 130 + hs * 65;
      unsigned list[16];
#pragma unroll
      for (int j = 0; j < 16; ++j) list[j] = 0u;
#pragma unroll 1
      for (int k0 = 0; k0 < 64; k0 += 8) {
#pragma unroll
        for (int k = 0; k < 8; ++k) KINSERT(list, src[k0 + k])
      }
      unsigned other[16];
#pragma unroll
      for (int j = 0; j < 16; ++j) other[j] = __shfl_xor(list[j], 1);
#pragma unroll
      for (int j = 0; j < 16; ++j) KINSERT(list, other[j])
      if (hs == 0) {
#pragma unroll
        for (int j = 0; j < 16; ++j) skey[row * 16 + j] = list[j];
      }
    }
    __syncthreads();
    if (threadIdx.x < 128) {
      const int tid = launder(threadIdx.x);
      const int tok = tid & 15, head = tid >> 4;
      const int ra = (head * 2) * 16 + tok, rb = ra + 16;
      float v1[16], v2[16];
#pragma unroll
      for (int a = 0; a < 16; ++a) { v1[a] = key2f(skey[ra * 16 + a], 0x7Fu); v2[a] = key2f(skey[rb * 16 + a], 0x7Fu); }
      unsigned list[16];
#pragma unroll
      for (int j = 0; j < 16; ++j) list[j] = 0u;
#pragma unroll
      for (int a = 0; a < 16; ++a) {
#pragma unroll
        for (int b = 0; b < 16; ++b) {
          if ((a + 1) * (b + 1) <= 16) {
            const unsigned key = (f2key(v1[a] + v2[b]) & ~0xFFu) | (unsigned)(255 - (a * 16 + b));
            KINSERT(list, key)
          }
        }
      }
      const float smax = key2f(list[0], 0xFFu);
      float ex[16];
      float se = 0.f;
#pragma unroll
      for (int q = 0; q < 16; ++q) { ex[q] = expf(key2f(list[q], 0xFFu) - smax); se += ex[q]; }
      const float inv = 1.f / se;
#pragma unroll
      for (int q = 0; q < 16; ++q) {
        const int flat = 255 - (int)(list[q] & 0xFFu);
        const int i1 = 127 - (int)(skey[ra * 16 + (flat >> 4)] & 0x7Fu);
        const int i2 = 127 - (int)(skey[rb * 16 + (flat & 15)] & 0x7Fu);
        sE[(tok * 8 + head) * 16 + q] = i1 * 128 + i2;
        sG[(tok * 8 + head) * 16 + q] = ex[q] * inv;
      }
    }
    __syncthreads();
#pragma unroll 1
    for (int tk = 0; tk < 2; ++tk) {
      const int tid = launder(threadIdx.x), lane = tid & 63, wave = tid >> 6, l15 = lane & 15;
      const int tok = wave * 2 + tk;
      const int t = t0 + tok;
      const u16* h2r = p.hbuf + (size_t)t * D;
      const uint4 hx0 = *(const uint4*)&h2r[lane * 8];
      const uint4 hx1 = *(const uint4*)&h2r[512 + lane * 8];
      float o[16];
#pragma unroll
      for (int j = 0; j < 16; ++j) o[j] = 0.f;
      uint4 A0[8], A1[8], B0[8], B1[8];
      int ids = sE[(tok * 8) * 16 + l15];
      G_ISSUE(A0, A1, p.ub, ids, 0)
      SBAR;
#pragma unroll 1
      for (int head = 0; head < 8; ++head) {
        const float gate = sG[(tok * 8 + head) * 16 + l15];
        const int ids_n = sE[(tok * 8 + ((head + 1) & 7)) * 16 + l15];
        float pa[16];
        G_ISSUE(B0, B1, p.ub, ids, 1)
        SBAR;
        G_DOTU(A0, A1, 0)
        SBAR;
        G_ISSUE(A0, A1, p.vb, ids, 0)
        SBAR;
        G_DOTU(B0, B1, 1)
        float q8[8], q4[4], q2[2], q1;
        {
          const bool b3 = (lane & 8) != 0;
#pragma unroll
          for (int i = 0; i < 8; ++i) {
            const float keep = b3 ? pa[i + 8] : pa[i];
            const float send = b3 ? pa[i] : pa[i + 8];
            q8[i] = keep + __shfl_xor(send, 8);
          }
          const bool b2 = (lane & 4) != 0;
#pragma unroll
          for (int i = 0; i < 4; ++i) {
            const float keep = b2 ? q8[i + 4] : q8[i];
            const float send = b2 ? q8[i] : q8[i + 4];
            q4[i] = keep + __shfl_xor(send, 4);
          }
          const bool b1 = (lane & 2) != 0;
#pragma unroll
          for (int i = 0; i < 2; ++i) {
            const float keep = b1 ? q4[i + 2] : q4[i];
            const float send = b1 ? q4[i] : q4[i + 2];
            q2[i] = keep + __shfl_xor(send, 2);
          }
          const bool b0 = (lane & 1) != 0;
          {
            const float keep = b0 ? q2[1] : q2[0];
            const float send = b0 ? q2[0] : q2[1];
            q1 = keep + __shfl_xor(send, 1);
          }
          q1 += __shfl_xor(q1, 16);
          q1 += __shfl_xor(q1, 32);
        }
        const float ge = 0.5f * q1 * (1.f + erff(q1 * 0.7071067811865476f));
        const int wbits = __float_as_int(gate * ge);
        SBAR;
        G_ISSUE(B0, B1, p.vb, ids, 1)
        SBAR;
        G_ACCV(A0, A1, 0)
        SBAR;
        if (head < 7) { G_ISSUE(A0, A1, p.ub, ids_n, 0) }
        SBAR;
        G_ACCV(B0, B1, 1)
        SBAR;
        ids = ids_n;
      }
      const int ci = t < TCTX ? 0 : 1 + ((t - TCTX) >> 12);
      const float* ga2 = p.mod + ci * 6144 + 5 * 1024;
      float* xr = p.out + (size_t)t * D;
      float x2[16];
      float ss = 0.f;
#pragma unroll
      for (int hlf = 0; hlf < 2; ++hlf) {
        const int col = hlf * 512 + lane * 8;
        const float4 xa = *(const float4*)&xr[col], xb = *(const float4*)&xr[col + 4];
        const float4 ga = *(const float4*)&ga2[col], gb = *(const float4*)&ga2[col + 4];
        x2[hlf * 8 + 0] = xa.x + ga.x * o[hlf * 8 + 0];
        x2[hlf * 8 + 1] = xa.y + ga.y * o[hlf * 8 + 1];
        x2[hlf * 8 + 2] = xa.z + ga.z * o[hlf * 8 + 2];
        x2[hlf * 8 + 3] = xa.w + ga.w * o[hlf * 8 + 3];
        x2[hlf * 8 + 4] = xb.x + gb.x * o[hlf * 8 + 4];
        x2[hlf * 8 + 5] = xb.y + gb.y * o[hlf * 8 + 5];
        x2[hlf * 8 + 6] = xb.z + gb.z * o[hlf * 8 + 6];
        x2[hlf * 8 + 7] = xb.w + gb.w * o[hlf * 8 + 7];
      }
#pragma unroll
      for (int j = 0; j < 16; ++j) ss += x2[j] * x2[j];
      ss = wave_sum(ss);
      const float rstd = rsqrtf(ss * (1.f / 1024.f) + EPS);
#pragma unroll
      for (int hlf = 0; hlf < 2; ++hlf) {
        const int col = hlf * 512 + lane * 8;
        const float4 g0 = *(const float4*)&p.g_final[col], g1 = *(const float4*)&p.g_final[col + 4];
        *(float4*)&xr[col] = make_float4(x2[hlf * 8 + 0] * rstd * g0.x, x2[hlf * 8 + 1] * rstd * g0.y,
                                         x2[hlf * 8 + 2] * rstd * g0.z, x2[hlf * 8 + 3] * rstd * g0.w);
        *(float4*)&xr[col + 4] = make_float4(x2[hlf * 8 + 4] * rstd * g1.x, x2[hlf * 8 + 5] * rstd * g1.y,
                                             x2[hlf * 8 + 6] * rstd * g1.z, x2[hlf * 8 + 7] * rstd * g1.w);
      }
    }
  }
}

__global__ void __launch_bounds__(NT) mega(P p, int ph_lo, int ph_hi) {
  extern __shared__ __attribute__((aligned(16))) char smem[];
  cg::grid_group grid = cg::this_grid();
#define RUN_PHASE(k, call)                              \
  if (ph_lo <= (k) && (k) < ph_hi) {                    \
    call;                                               \
    if ((k) + 1 < ph_hi) grid.sync();                   \
  }
#ifdef PROBE_DOUBLE
  {
    phase_prep(p, smem); grid.sync();
    phase_norm(p, 0); grid.sync();
    gemm_phase<0>(p, p.hbuf, p.w_in_t, NPAD / 128, smem); grid.sync();
    phase_mlstm(p, smem); grid.sync();
    phase_mix(p); grid.sync();
    gemm_phase<1>(p, p.hbuf, p.w_out_t, 1024 / 128, smem); grid.sync();
    phase_norm(p, 1); convert_tables(p); grid.sync();
    gemm_phase<2>(p, p.hbuf, p.wq_t, 2048 / 128, smem); grid.sync();
  }
#endif
  RUN_PHASE(0, phase_prep(p, smem))
  RUN_PHASE(1, phase_norm(p, 0))
  RUN_PHASE(2, gemm_phase<0>(p, p.hbuf, p.w_in_t, NPAD / 128, smem))
  RUN_PHASE(3, phase_mlstm(p, smem))
  RUN_PHASE(4, phase_mix(p))
  RUN_PHASE(5, gemm_phase<1>(p, p.hbuf, p.w_out_t, 1024 / 128, smem))
  RUN_PHASE(6, (phase_norm(p, 1), convert_tables(p)))
  RUN_PHASE(7, gemm_phase<2>(p, p.hbuf, p.wq_t, 2048 / 128, smem))
  RUN_PHASE(8, phase_peer(p, smem))
}

extern "C" void kernel_launch(void* const* d_in, const int* in_sizes, int n_in, void* d_out, int out_size,
                              void* d_ws, size_t ws_size, hipStream_t stream) {
  P p{};
  const float* const* in = (const float* const*)d_in;
  p.x_prompt = in[0]; p.x_sample = in[1]; p.state_C = in[2]; p.state_n = in[3]; p.state_m = in[4];
  p.c = in[5]; p.c_ctx = in[6]; p.w_ada = in[7]; p.b_ada = in[8]; p.g_norm1 = in[9]; p.w_in = in[10];
  p.b_igate = in[11]; p.b_fgate = in[12]; p.conv_w = in[13]; p.conv_b = in[14]; p.g_mlstm = in[15];
  p.w_out = in[16]; p.g_norm2 = in[17]; p.wq = in[18]; p.k1 = in[19]; p.k2 = in[20]; p.u = in[21]; p.v = in[22];
  p.g_final = in[23];
  p.out = (float*)d_out;
  char* ws = (char*)d_ws;
  size_t off = 0;
  auto take = [&](size_t bytes) { char* r = ws + off; off += (bytes + 255) & ~(size_t)255; return r; };
  p.mod = (float*)take(5 * 6144 * 4);
  p.w_in_t = (u16*)take((size_t)NPAD * 1024 * 2);
  p.w_out_t = (u16*)take((size_t)1024 * 1024 * 2);
  p.wq_t = (u16*)take((size_t)2048 * 1024 * 2);
  p.kb = (u16*)take(2 * 16384 * 2);
  p.gates = (float*)take((size_t)T * 16 * 4);
  p.hbuf = (u16*)take((size_t)T * D * 2);
  p.proj = (u16*)take((size_t)T * NPROJ * 2);
  p.qp = p.proj;
  p.ub = p.proj + (size_t)T * 2048;
  p.vb = p.ub + (size_t)16384 * 1024;

  hipFuncSetAttribute((const void*)mega, hipFuncAttributeMaxDynamicSharedMemorySize, LDS_BYTES);
  int dev = 0, cus = 0, per = 0;
  hipGetDevice(&dev);
  hipDeviceGetAttribute(&cus, hipDeviceAttributeMultiprocessorCount, dev);
  hipOccupancyMaxActiveBlocksPerMultiprocessor(&per, (const void*)mega, NT, LDS_BYTES);
  if (per < 1) per = 1;
  const int grid = cus;
#if MULTI_LAUNCH
  for (int ph = 0; ph < NPHASE; ++ph) {
    hipLaunchKernelGGL(mega, dim3(grid), dim3(NT), LDS_BYTES, stream, p, ph, ph + 1);
  }
#else
  int lo = 0, hi = NPHASE;
  void* args[] = {&p, &lo, &hi};
  hipError_t e = hipLaunchCooperativeKernel((const void*)mega, dim3(grid), dim3(NT), args, LDS_BYTES, stream);
  if (e != hipSuccess) fprintf(stderr, "cooperative launch failed: %s (grid %d)\n", hipGetErrorString(e), grid);
#endif
}
```

```cpp
#include <hip/hip_runtime.h>
#include <hip/hip_cooperative_groups.h>
#include <cstdio>
#include <cstdint>
namespace cg = cooperative_groups;

#ifndef MULTI_LAUNCH
#define MULTI_LAUNCH 0
#endif

typedef unsigned short u16;
typedef __attribute__((ext_vector_type(8))) short bf16x8;
typedef __attribute__((ext_vector_type(4))) float f32x4;
typedef __attribute__((ext_vector_type(2))) __bf16 bf2_t;
typedef __attribute__((ext_vector_type(2))) float f2v;

constexpr int NT = 512;
constexpr int D = 1024;
constexpr int TCTX = 8192;
constexpr int TLAT = 16384;
constexpr int T = TCTX + TLAT;
constexpr int NPROJ = 3584;
constexpr int NPAD = 3712;
constexpr int LDS_BYTES = 256 * 130 * 4 + 256 * 16 * 4;
constexpr float EPS = 1e-6f;
constexpr int NPHASE = 9;

struct P {
  const float *x_prompt, *x_sample, *state_C, *state_n, *state_m, *c, *c_ctx, *w_ada, *b_ada, *g_norm1, *w_in,
      *b_igate, *b_fgate, *conv_w, *conv_b, *g_mlstm, *w_out, *g_norm2, *wq, *k1, *k2, *u, *v, *g_final;
  float* out;
  float* mod;
  u16* w_in_t;
  u16* w_out_t;
  u16* wq_t;
  u16* kb;
  float* gates;
  u16* hbuf;
  u16* proj;
  u16* qp;
  unsigned char* ub8;
  unsigned char* vb8;
  float* sinv;
};

__device__ __forceinline__ u16 f2bf(float f) {
  unsigned u = __float_as_uint(f);
  u += 0x7fffu + ((u >> 16) & 1u);
  return (u16)(u >> 16);
}
__device__ __forceinline__ float bf2f(u16 h) { return __uint_as_float(((unsigned)h) << 16); }
__device__ __forceinline__ unsigned pack2(float a, float b) { return (unsigned)f2bf(a) | ((unsigned)f2bf(b) << 16); }
__device__ __forceinline__ float lo_f(unsigned w) { return __uint_as_float(w << 16); }
__device__ __forceinline__ float hi_f(unsigned w) { return __uint_as_float(w & 0xffff0000u); }
__device__ __forceinline__ float wave_sum(float v) {
#pragma unroll
  for (int o = 32; o > 0; o >>= 1) v += __shfl_xor(v, o);
  return v;
}
__device__ __forceinline__ float dot2(unsigned a, unsigned b, float c) {
  return __builtin_amdgcn_fdot2_f32_bf16(__builtin_bit_cast(bf2_t, a), __builtin_bit_cast(bf2_t, b), c, false);
}
__device__ __forceinline__ float dot8(uint4 a, uint4 b, float c) {
  c = dot2(a.x, b.x, c); c = dot2(a.y, b.y, c); c = dot2(a.z, b.z, c); c = dot2(a.w, b.w, c);
  return c;
}
__device__ __forceinline__ f32x4 mfma16(bf16x8 a, bf16x8 b, f32x4 c) {
  return __builtin_amdgcn_mfma_f32_16x16x32_bf16(a, b, c, 0, 0, 0);
}

__device__ __forceinline__ void transpose_tile(const float* __restrict__ W, int Nreal, u16* __restrict__ Wt, int k0, int n0, float* tile) {
  const int tid = threadIdx.x;
#pragma unroll
  for (int i = 0; i < 8; ++i) {
    int idx = i * NT + tid;
    int kk = idx >> 6, nn = idx & 63;
    float v = (n0 + nn < Nreal) ? W[(size_t)(k0 + kk) * Nreal + n0 + nn] : 0.f;
    tile[kk * 65 + nn] = v;
  }
  __syncthreads();
#pragma unroll
  for (int i = 0; i < 8; ++i) {
    int idx = i * NT + tid;
    int nn = idx >> 6, kk = idx & 63;
    Wt[(size_t)(n0 + nn) * 1024 + k0 + kk] = f2bf(tile[kk * 65 + nn]);
  }
}

__device__ __forceinline__ void phase_prep(const P& p, char* smem) {
  const int tid = threadIdx.x;
  float* sf = (float*)smem;
  const int n_gemv = 96, n_tin = 16 * 58, n_tout = 16 * 16, n_tq = 16 * 32, n_k = 2;
  const int total = n_gemv + n_tin + n_tout + n_tq + n_k;
  for (int it = blockIdx.x; it < total; it += gridDim.x) {
    __syncthreads();
    if (it < n_gemv) {
      for (int i = tid; i < 5 * 1024; i += NT) {
        int ci = i >> 10, k = i & 1023;
        float cv = (ci == 0) ? p.c_ctx[k] : p.c[(ci - 1) * 1024 + k];
        sf[i] = cv / (1.f + expf(-cv));
      }
      __syncthreads();
      const int cl = tid & 15, kg = tid >> 4;
      const int col = it * 64 + cl * 4;
      float acc[5][4];
#pragma unroll
      for (int ci = 0; ci < 5; ++ci)
#pragma unroll
        for (int j = 0; j < 4; ++j) acc[ci][j] = 0.f;
      for (int kk = 0; kk < 32; ++kk) {
        int k = kg * 32 + kk;
        float4 w = *(const float4*)&p.w_ada[(size_t)k * 6144 + col];
#pragma unroll
        for (int ci = 0; ci < 5; ++ci) {
          float s = sf[ci * 1024 + k];
          acc[ci][0] += s * w.x; acc[ci][1] += s * w.y; acc[ci][2] += s * w.z; acc[ci][3] += s * w.w;
        }
      }
      float* red = sf + 5 * 1024;
#pragma unroll
      for (int ci = 0; ci < 5; ++ci)
#pragma unroll
        for (int j = 0; j < 4; ++j) red[(kg * 16 + cl) * 20 + ci * 4 + j] = acc[ci][j];
      __syncthreads();
      if (tid < 320) {
        int ci = tid >> 6, cc = tid & 63;
        int cl2 = cc >> 2, j = cc & 3;
        float s = 0.f;
        for (int g = 0; g < 32; ++g) s += red[(g * 16 + cl2) * 20 + ci * 4 + j];
        int col2 = it * 64 + cc;
        p.mod[ci * 6144 + col2] = s + p.b_ada[col2];
      }
    } else if (it < n_gemv + n_tin) {
      int j = it - n_gemv;
      transpose_tile(p.w_in, 3600, p.w_in_t, (j / 58) * 64, (j % 58) * 64, sf);
    } else if (it < n_gemv + n_tin + n_tout) {
      int j = it - n_gemv - n_tin;
      transpose_tile(p.w_out, 1024, p.w_out_t, (j / 16) * 64, (j % 16) * 64, sf);
    } else if (it < n_gemv + n_tin + n_tout + n_tq) {
      int j = it - n_gemv - n_tin - n_tout;
      transpose_tile(p.wq, 2048, p.wq_t, (j / 32) * 64, (j % 32) * 64, sf);
    } else {
      int j = it - n_gemv - n_tin - n_tout - n_tq;
      const float* src = j ? p.k2 : p.k1;
      u16* dst = p.kb + j * 16384;
      for (int i = tid; i < 16384; i += NT) dst[i] = f2bf(src[i]);
    }
  }
}

__device__ __forceinline__ void phase_norm(const P& p, int which) {
  const int wave = threadIdx.x >> 6, lane = threadIdx.x & 63;
  for (int t = blockIdx.x * 8 + wave; t < T; t += gridDim.x * 8) {
    const float* xr = which ? (p.out + (size_t)t * D)
                            : (t < TCTX ? p.x_prompt + (size_t)t * D : p.x_sample + (size_t)(t - TCTX) * D);
    const int ci = t < TCTX ? 0 : 1 + ((t - TCTX) >> 12);
    const float* md = p.mod + ci * 6144 + (which ? 3 * 1024 : 0);
    const float* g = which ? p.g_norm2 : p.g_norm1;
    float4 xv[4];
    float ss = 0.f;
#pragma unroll
    for (int i = 0; i < 4; ++i) {
      xv[i] = *(const float4*)&xr[i * 256 + lane * 4];
      ss += xv[i].x * xv[i].x + xv[i].y * xv[i].y + xv[i].z * xv[i].z + xv[i].w * xv[i].w;
    }
    ss = wave_sum(ss);
    const float rstd = rsqrtf(ss * (1.f / 1024.f) + EPS);
#pragma unroll
    for (int i = 0; i < 4; ++i) {
      int col = i * 256 + lane * 4;
      float4 g4 = *(const float4*)&g[col];
      float4 sh = *(const float4*)&md[col];
      float4 sc = *(const float4*)&md[1024 + col];
      float h0 = xv[i].x * rstd * g4.x * (1.f + sc.x) + sh.x;
      float h1 = xv[i].y * rstd * g4.y * (1.f + sc.y) + sh.y;
      float h2 = xv[i].z * rstd * g4.z * (1.f + sc.z) + sh.z;
      float h3 = xv[i].w * rstd * g4.w * (1.f + sc.w) + sh.w;
      uint2 o; o.x = pack2(h0, h1); o.y = pack2(h2, h3);
      *(uint2*)&p.hbuf[(size_t)t * D + col] = o;
    }
  }
}

__device__ __forceinline__ void convert_tables(const P& p) {
  const int wave = threadIdx.x >> 6, lane = threadIdx.x & 63;
  for (int row = blockIdx.x * 8 + wave; row < 32768; row += gridDim.x * 8) {
    const float* src = row < 16384 ? p.u + (size_t)row * D : p.v + (size_t)(row - 16384) * D;
    unsigned char* dst = row < 16384 ? p.ub8 + (size_t)row * D : p.vb8 + (size_t)(row - 16384) * D;
    float4 f[4];
    float amax = 0.f;
#pragma unroll
    for (int i = 0; i < 4; ++i) {
      f[i] = *(const float4*)&src[lane * 16 + i * 4];
      amax = fmaxf(amax, fmaxf(fmaxf(fabsf(f[i].x), fabsf(f[i].y)), fmaxf(fabsf(f[i].z), fabsf(f[i].w))));
    }
#pragma unroll
    for (int o = 32; o > 0; o >>= 1) amax = fmaxf(amax, __shfl_xor(amax, o));
    const float sc = amax > 0.f ? 384.f / amax : 1.f;
    const float inv = amax > 0.f ? amax * (1.f / 384.f) : 1.f;
    unsigned w[4];
#pragma unroll
    for (int i = 0; i < 4; ++i) {
      unsigned pk = 0u;
      pk = __builtin_amdgcn_cvt_pk_fp8_f32(f[i].x * sc, f[i].y * sc, pk, false);
      pk = __builtin_amdgcn_cvt_pk_fp8_f32(f[i].z * sc, f[i].w * sc, pk, true);
      w[i] = pk;
    }
    *(uint4*)&dst[lane * 16] = make_uint4(w[0], w[1], w[2], w[3]);
    if (lane == 0) p.sinv[row] = inv;
  }
}

template <int MODE>
__device__ __forceinline__ void gemm_phase(const P& p, const u16* __restrict__ A, const u16* __restrict__ Bt, int ntn, char* smem) {
  const int tid = threadIdx.x, lane = tid & 63, wave = tid >> 6;
  const int wm = wave >> 1, wn = wave & 1, l15 = lane & 15, quad = lane >> 4;
  u16* sA = (u16*)smem;
  u16* sB = sA + 2 * 256 * 72;
  const int ntiles = (T / 256) * ntn;
  for (int tile = blockIdx.x; tile < ntiles; tile += gridDim.x) {
    const int mt = tile / ntn, nt = tile % ntn;
    const int m0 = mt * 256, n0 = nt * 128;
    f32x4 acc[4][4];
#pragma unroll
    for (int i = 0; i < 4; ++i)
#pragma unroll
      for (int j = 0; j < 4; ++j) acc[i][j] = (f32x4){0.f, 0.f, 0.f, 0.f};
    uint4 ra[4], rb[2];
    const int lrow = tid >> 3, lch = tid & 7;
#pragma unroll
    for (int i = 0; i < 4; ++i) ra[i] = *(const uint4*)&A[(size_t)(m0 + i * 64 + lrow) * 1024 + lch * 8];
#pragma unroll
    for (int i = 0; i < 2; ++i) rb[i] = *(const uint4*)&Bt[(size_t)(n0 + i * 64 + lrow) * 1024 + lch * 8];
#pragma unroll
    for (int i = 0; i < 4; ++i) *(uint4*)&sA[(i * 64 + lrow) * 72 + lch * 8] = ra[i];
#pragma unroll
    for (int i = 0; i < 2; ++i) *(uint4*)&sB[(i * 64 + lrow) * 72 + lch * 8] = rb[i];
    __syncthreads();
    for (int kt = 0; kt < 16; ++kt) {
      if (kt + 1 < 16) {
#pragma unroll
        for (int i = 0; i < 4; ++i) ra[i] = *(const uint4*)&A[(size_t)(m0 + i * 64 + lrow) * 1024 + (kt + 1) * 64 + lch * 8];
#pragma unroll
        for (int i = 0; i < 2; ++i) rb[i] = *(const uint4*)&Bt[(size_t)(n0 + i * 64 + lrow) * 1024 + (kt + 1) * 64 + lch * 8];
      }
      const u16* a_s = sA + (kt & 1) * 256 * 72;
      const u16* b_s = sB + (kt & 1) * 128 * 72;
#pragma unroll
      for (int ks = 0; ks < 2; ++ks) {
        bf16x8 bfr[4], afr[4];
#pragma unroll
        for (int ni = 0; ni < 4; ++ni) bfr[ni] = *(const bf16x8*)&b_s[(wn * 64 + ni * 16 + l15) * 72 + ks * 32 + quad * 8];
#pragma unroll
        for (int mi = 0; mi < 4; ++mi) afr[mi] = *(const bf16x8*)&a_s[(wm * 64 + mi * 16 + l15) * 72 + ks * 32 + quad * 8];
#pragma unroll
        for (int ni = 0; ni < 4; ++ni)
#pragma unroll
          for (int mi = 0; mi < 4; ++mi) acc[ni][mi] = mfma16(bfr[ni], afr[mi], acc[ni][mi]);
      }
      if (kt + 1 < 16) {
        u16* a_w = sA + ((kt + 1) & 1) * 256 * 72;
        u16* b_w = sB + ((kt + 1) & 1) * 128 * 72;
#pragma unroll
        for (int i = 0; i < 4; ++i) *(uint4*)&a_w[(i * 64 + lrow) * 72 + lch * 8] = ra[i];
#pragma unroll
        for (int i = 0; i < 2; ++i) *(uint4*)&b_w[(i * 64 + lrow) * 72 + lch * 8] = rb[i];
      }
      __syncthreads();
    }
#pragma unroll
    for (int mi = 0; mi < 4; ++mi) {
      const int m = m0 + wm * 64 + mi * 16 + l15;
#pragma unroll
      for (int ni = 0; ni < 4; ++ni) {
        const int n = n0 + wn * 64 + ni * 16 + quad * 4;
        f32x4 a = acc[ni][mi];
        if (MODE == 0) {
          if (n < NPROJ) {
            uint2 o; o.x = pack2(a[0], a[1]); o.y = pack2(a[2], a[3]);
            *(uint2*)&p.proj[(size_t)m * NPROJ + n] = o;
          } else if (n < 3600) {
            *(float4*)&p.gates[(size_t)m * 16 + (n - NPROJ)] = make_float4(a[0], a[1], a[2], a[3]);
          }
        } else if (MODE == 1) {
          const float* xr = m < TCTX ? p.x_prompt + (size_t)m * D : p.x_sample + (size_t)(m - TCTX) * D;
          const int ci = m < TCTX ? 0 : 1 + ((m - TCTX) >> 12);
          float4 xv = *(const float4*)&xr[n];
          float4 ga = *(const float4*)&p.mod[ci * 6144 + 2 * 1024 + n];
          float4 o = make_float4(xv.x + ga.x * a[0], xv.y + ga.y * a[1], xv.z + ga.z * a[2], xv.w + ga.w * a[3]);
          *(float4*)&p.out[(size_t)m * D + n] = o;
        } else {
          uint2 o; o.x = pack2(a[0], a[1]); o.y = pack2(a[2], a[3]);
          *(uint2*)&p.qp[(size_t)m * 2048 + n] = o;
        }
      }
    }
  }
}

__device__ __forceinline__ void mlstm_task(const P& p, int task, char* smem) {
  const int tid = threadIdx.x, lane = tid & 63, wave = tid >> 6, l15 = lane & 15, quad = lane >> 4;
  const bool lat = task < 128;
  const int id = lat ? task : task - 128;
  const int slice = id & 3, dir = (id >> 2) & 1, head = (id >> 3) & 3, bat = id >> 5;
  const int tb = lat ? TCTX + bat * 4096 : bat * 256;
  const int L = lat ? 4096 : 256;
  const int nch = L >> 6;
  const int gcol = dir * 4 + head;
  const float big = p.b_igate[gcol], bfg = p.b_fgate[gcol];
  const float scale = 0.08838834764831845f;

  u16* sQ = (u16*)smem;
  u16* sK = sQ + 64 * 136;
  u16* sKt = sK + 64 * 136;
  u16* sVt = sKt + 128 * 72;
  u16* sS = sVt + 32 * 72;
  u16* sCt = sS + 64 * 72;
  float* sg = (float*)(sCt + 32 * 136);
  float* smm = sg + 64;
  float* sa = smm + 64;
  float* semt = sa + 64;
  float* sden = semt + 64;
  float* sqn = sden + 64;
  float* sN = sqn + 64;

  const int sbase = (bat * 2 + dir) * 4 + head;
  f32x4 C[2];
  float m;
  __syncthreads();
  if (lat) {
#pragma unroll
    for (int tj = 0; tj < 2; ++tj)
#pragma unroll
      for (int r = 0; r < 4; ++r)
        C[tj][r] = p.state_C[(size_t)sbase * 16384 + (wave * 16 + quad * 4 + r) * 128 + slice * 32 + tj * 16 + l15];
    m = p.state_m[sbase];
    if (tid < 128) sN[tid] = p.state_n[sbase * 128 + tid];
  } else {
    C[0] = (f32x4){0.f, 0.f, 0.f, 0.f};
    C[1] = (f32x4){0.f, 0.f, 0.f, 0.f};
    m = 0.f;
    if (tid < 128) sN[tid] = 0.f;
  }
#pragma unroll
  for (int tj = 0; tj < 2; ++tj) {
    uint2 o; o.x = pack2(C[tj][0], C[tj][1]); o.y = pack2(C[tj][2], C[tj][3]);
    *(uint2*)&sCt[(tj * 16 + l15) * 136 + wave * 16 + quad * 4] = o;
  }
  __syncthreads();

  float* hout = p.out + (size_t)dir * T * 512;
  const int s = tid >> 3, part = tid & 7;

  for (int c = 0; c < nch; ++c) {
    const int posl = c * 64 + lane;
    const int tl = tb + (dir ? (L - 1 - posl) : posl);
    const float ig = p.gates[(size_t)tl * 16 + gcol] + big;
    const float fr = p.gates[(size_t)tl * 16 + 8 + gcol] + bfg;
    const float lf = fminf(fr, 0.f) - log1pf(expf(-fabsf(fr)));
    float b = lf;
#pragma unroll
    for (int off = 1; off < 64; off <<= 1) { float v = __shfl_up(b, off); if (lane >= off) b += v; }
    const float g = ig - b;
    float G = g;
#pragma unroll
    for (int off = 1; off < 64; off <<= 1) { float v = __shfl_up(G, off); if (lane >= off) G = fmaxf(G, v); }
    const float mm = fmaxf(m, G);
    const float mmT = __shfl(mm, 63), bT = __shfl(b, 63);
    const float wgt = expf(g - mmT);
    const float decay = expf(m - mmT);
    const float m_new = bT + mmT;
    if (wave == 0) {
      sg[lane] = g; smm[lane] = mm; sa[lane] = expf(m - mm); semt[lane] = expf(-(b + mm)); sden[lane] = 0.f;
    }
    const int poss = c * 64 + s;
    const int ts = tb + (dir ? (L - 1 - poss) : poss);
    const u16* prow = p.proj + (size_t)ts * NPROJ;
    const uint4 q0 = *(const uint4*)&prow[1536 + head * 128 + part * 16];
    const uint4 q1 = *(const uint4*)&prow[1536 + head * 128 + part * 16 + 8];
    const uint4 k0 = *(const uint4*)&prow[2048 + head * 128 + part * 16];
    const uint4 k1 = *(const uint4*)&prow[2048 + head * 128 + part * 16 + 8];
    const uint2 vv = *(const uint2*)&prow[2560 + head * 128 + slice * 32 + part * 4];
    const float ws_ = __shfl(wgt, s);
    *(uint4*)&sQ[s * 136 + part * 16] = q0;
    *(uint4*)&sQ[s * 136 + part * 16 + 8] = q1;
    *(uint4*)&sK[s * 136 + part * 16] = k0;
    *(uint4*)&sK[s * 136 + part * 16 + 8] = k1;
    {
      const unsigned qw[8] = {q0.x, q0.y, q0.z, q0.w, q1.x, q1.y, q1.z, q1.w};
      float qn = 0.f;
#pragma unroll
      for (int j = 0; j < 8; ++j) {
        qn += lo_f(qw[j]) * sN[part * 16 + 2 * j] + hi_f(qw[j]) * sN[part * 16 + 2 * j + 1];
      }
      qn += __shfl_xor(qn, 1); qn += __shfl_xor(qn, 2); qn += __shfl_xor(qn, 4);
      if (part == 0) sqn[s] = qn * scale;
      const unsigned kw[8] = {k0.x, k0.y, k0.z, k0.w, k1.x, k1.y, k1.z, k1.w};
      const int pc = ((s >> 3) ^ part) * 8 + (s & 7);
#pragma unroll
      for (int j = 0; j < 8; ++j) {
        sKt[(part * 16 + 2 * j) * 72 + pc] = f2bf(lo_f(kw[j]) * ws_);
        sKt[(part * 16 + 2 * j + 1) * 72 + pc] = f2bf(hi_f(kw[j]) * ws_);
      }
      sVt[(part * 4 + 0) * 72 + pc] = (u16)(vv.x & 0xffffu);
      sVt[(part * 4 + 1) * 72 + pc] = (u16)(vv.x >> 16);
      sVt[(part * 4 + 2) * 72 + pc] = (u16)(vv.y & 0xffffu);
      sVt[(part * 4 + 3) * 72 + pc] = (u16)(vv.y >> 16);
    }
    __syncthreads();

    const int tj = wave >> 1, ti = wave & 1;
    const int trow = tj * 16 + l15;
    {
      const float mmt = smm[trow];
      float psum = 0.f;
#pragma unroll
      for (int tt = 0; tt < 2; ++tt) {
        const int si = (wave & 1) * 2 + tt;
        f32x4 acc = (f32x4){0.f, 0.f, 0.f, 0.f};
#pragma unroll
        for (int ks = 0; ks < 4; ++ks) {
          bf16x8 afr = *(const bf16x8*)&sK[(si * 16 + l15) * 136 + ks * 32 + quad * 8];
          bf16x8 bfr = *(const bf16x8*)&sQ[trow * 136 + ks * 32 + quad * 8];
          acc = mfma16(afr, bfr, acc);
        }
        const int s0 = si * 16 + quad * 4;
        float vals[4];
#pragma unroll
        for (int r = 0; r < 4; ++r) {
          const int sidx = s0 + r;
          const float e = expf(fminf(sg[sidx] - mmt, 0.f));
          const float val = (sidx <= trow) ? acc[r] * scale * e : 0.f;
          vals[r] = val;
          psum += val;
        }
        uint2 o; o.x = pack2(vals[0], vals[1]); o.y = pack2(vals[2], vals[3]);
        *(uint2*)&sS[trow * 72 + s0] = o;
      }
      psum += __shfl_xor(psum, 16);
      psum += __shfl_xor(psum, 32);
      if (quad == 0) atomicAdd(&sden[trow], psum);
    }
    f32x4 aqc = (f32x4){0.f, 0.f, 0.f, 0.f};
#pragma unroll
    for (int ks = 0; ks < 4; ++ks) {
      bf16x8 afr = *(const bf16x8*)&sCt[(ti * 16 + l15) * 136 + ks * 32 + quad * 8];
      bf16x8 bfr = *(const bf16x8*)&sQ[trow * 136 + ks * 32 + quad * 8];
      aqc = mfma16(afr, bfr, aqc);
    }
    __syncthreads();
    {
      f32x4 asv = (f32x4){0.f, 0.f, 0.f, 0.f};
      const int vrow = ti * 16 + l15;
      const int vkey = (vrow >> 2) & 7;
#pragma unroll
      for (int ks = 0; ks < 2; ++ks) {
        bf16x8 afr = *(const bf16x8*)&sVt[vrow * 72 + (((ks * 4 + quad) ^ vkey) * 8)];
        bf16x8 bfr = *(const bf16x8*)&sS[trow * 72 + ks * 32 + quad * 8];
        asv = mfma16(afr, bfr, asv);
      }
      const float a_t = sa[trow];
      const float den = a_t * sqn[trow] + sden[trow];
      const float inv = 1.f / fmaxf(fabsf(den), semt[trow]);
      const float as = a_t * scale;
      float4 h = make_float4((as * aqc[0] + asv[0]) * inv, (as * aqc[1] + asv[1]) * inv,
                             (as * aqc[2] + asv[2]) * inv, (as * aqc[3] + asv[3]) * inv);
      const int post = c * 64 + trow;
      const int tt = tb + (dir ? (L - 1 - post) : post);
      *(float4*)&hout[(size_t)tt * 512 + head * 128 + slice * 32 + ti * 16 + quad * 4] = h;
    }
#pragma unroll
    for (int t2 = 0; t2 < 2; ++t2) {
      C[t2][0] *= decay; C[t2][1] *= decay; C[t2][2] *= decay; C[t2][3] *= decay;
      const int krow = wave * 16 + l15;
      const int kkey = wave & 7;
      const int vrow = t2 * 16 + l15;
      const int vkey = (vrow >> 2) & 7;
#pragma unroll
      for (int ks = 0; ks < 2; ++ks) {
        bf16x8 afr = *(const bf16x8*)&sKt[krow * 72 + (((ks * 4 + quad) ^ kkey) * 8)];
        bf16x8 bfr = *(const bf16x8*)&sVt[vrow * 72 + (((ks * 4 + quad) ^ vkey) * 8)];
        C[t2] = mfma16(afr, bfr, C[t2]);
      }
    }
    if (tid < 128) {
      float sum = 0.f;
#pragma unroll
      for (int j = 0; j < 8; ++j) {
        uint4 w = *(const uint4*)&sKt[tid * 72 + j * 8];
        sum += lo_f(w.x) + hi_f(w.x) + lo_f(w.y) + hi_f(w.y) + lo_f(w.z) + hi_f(w.z) + lo_f(w.w) + hi_f(w.w);
      }
      sN[tid] = decay * sN[tid] + sum;
    }
#pragma unroll
    for (int t2 = 0; t2 < 2; ++t2) {
      uint2 o; o.x = pack2(C[t2][0], C[t2][1]); o.y = pack2(C[t2][2], C[t2][3]);
      *(uint2*)&sCt[(t2 * 16 + l15) * 136 + wave * 16 + quad * 4] = o;
    }
    m = m_new;
    __syncthreads();
  }
  if (!lat) {
    float* newC = p.out + (size_t)T * D;
    float* newn = newC + (size_t)32 * 2 * 4 * 128 * 128;
    float* newm = newn + 32 * 2 * 4 * 128;
#pragma unroll
    for (int t2 = 0; t2 < 2; ++t2)
#pragma unroll
      for (int r = 0; r < 4; ++r)
        newC[(size_t)sbase * 16384 + (wave * 16 + quad * 4 + r) * 128 + slice * 32 + t2 * 16 + l15] = C[t2][r];
    if (slice == 0) {
      if (tid < 128) newn[sbase * 128 + tid] = sN[tid];
      if (tid == 0) newm[sbase] = m;
    }
  }
}

__device__ __forceinline__ void phase_mlstm(const P& p, char* smem) {
  const int G = gridDim.x, b = blockIdx.x;
  if (G >= 256) {
    if (b < 128) mlstm_task(p, b, smem);
    else for (int task = b; task < 1152; task += G - 128) mlstm_task(p, task, smem);
  } else {
    for (int task = b; task < 1152; task += G) mlstm_task(p, task, smem);
  }
}

__device__ __forceinline__ void phase_mix(const P& p) {
  const int wave = threadIdx.x >> 6, lane = threadIdx.x & 63;
  for (int t = blockIdx.x * 8 + wave; t < T; t += gridDim.x * 8) {
    const u16* pr = p.proj + (size_t)t * NPROJ;
    const int seg = t < TCTX ? 256 : 64;
    const int pos = (t < TCTX ? t : t - TCTX) & (seg - 1);
    const bool hasL = pos > 0, hasR = pos < seg - 1;
    const int c0 = lane * 8;
    const uint4 zero4 = make_uint4(0u, 0u, 0u, 0u);
    const uint4 bg = *(const uint4*)&pr[c0];
    const uint4 cgC = *(const uint4*)&pr[512 + c0];
    const uint4 xgC = *(const uint4*)&pr[1024 + c0];
    const uint4 cgL = hasL ? *(const uint4*)&pr[-NPROJ + 512 + c0] : zero4;
    const uint4 xgL = hasL ? *(const uint4*)&pr[-NPROJ + 1024 + c0] : zero4;
    const uint4 cgR = hasR ? *(const uint4*)&pr[NPROJ + 512 + c0] : zero4;
    const uint4 xgR = hasR ? *(const uint4*)&pr[NPROJ + 1024 + c0] : zero4;
    const unsigned bgw[4] = {bg.x, bg.y, bg.z, bg.w};
    const unsigned cC[4] = {cgC.x, cgC.y, cgC.z, cgC.w}, xC[4] = {xgC.x, xgC.y, xgC.z, xgC.w};
    const unsigned cL[4] = {cgL.x, cgL.y, cgL.z, cgL.w}, xL[4] = {xgL.x, xgL.y, xgL.z, xgL.w};
    const unsigned cR[4] = {cgR.x, cgR.y, cgR.z, cgR.w}, xR[4] = {xgR.x, xgR.y, xgR.z, xgR.w};
    unsigned ow[4];
#pragma unroll
    for (int j = 0; j < 4; ++j) {
      const int ch = c0 + 2 * j;
      float w0a = p.conv_w[ch], w1a = p.conv_w[512 + ch], w2a = p.conv_w[1024 + ch], ba = p.conv_b[ch];
      float w0b = p.conv_w[ch + 1], w1b = p.conv_w[512 + ch + 1], w2b = p.conv_w[1024 + ch + 1], bb = p.conv_b[ch + 1];
      float ya = w0a * (lo_f(cL[j]) * lo_f(xL[j])) + w1a * (lo_f(cC[j]) * lo_f(xC[j])) + w2a * (lo_f(cR[j]) * lo_f(xR[j])) + ba;
      float yb = w0b * (hi_f(cL[j]) * hi_f(xL[j])) + w1b * (hi_f(cC[j]) * hi_f(xC[j])) + w2b * (hi_f(cR[j]) * hi_f(xR[j])) + bb;
      ow[j] = pack2(lo_f(bgw[j]) * ya, hi_f(bgw[j]) * yb);
    }
    *(uint4*)&p.hbuf[(size_t)t * D + c0] = make_uint4(ow[0], ow[1], ow[2], ow[3]);
    const float* hf = p.out + (size_t)t * 512 + c0;
    const float* hb = p.out + (size_t)T * 512 + (size_t)t * 512 + c0;
    const float4 f0 = *(const float4*)&hf[0], f1 = *(const float4*)&hf[4];
    const float4 b0 = *(const float4*)&hb[0], b1 = *(const float4*)&hb[4];
    float h[8] = {f0.x + b0.x, f0.y + b0.y, f0.z + b0.z, f0.w + b0.w, f1.x + b1.x, f1.y + b1.y, f1.z + b1.z, f1.w + b1.w};
    float ss = 0.f;
#pragma unroll
    for (int j = 0; j < 8; ++j) ss += h[j] * h[j];
    ss += __shfl_xor(ss, 1); ss += __shfl_xor(ss, 2); ss += __shfl_xor(ss, 4); ss += __shfl_xor(ss, 8);
    const float r = rsqrtf(ss * (1.f / 128.f) + EPS);
    const uint4 og = *(const uint4*)&pr[3072 + c0];
    const unsigned ogw[4] = {og.x, og.y, og.z, og.w};
    unsigned mw[4];
#pragma unroll
    for (int j = 0; j < 4; ++j) {
      float ga = p.g_mlstm[c0 + 2 * j], gb = p.g_mlstm[c0 + 2 * j + 1];
      float oa = lo_f(ogw[j]), ob = hi_f(ogw[j]);
      float sa_ = 1.f / (1.f + expf(-oa)), sb_ = 1.f / (1.f + expf(-ob));
      mw[j] = pack2(h[2 * j] * r * ga * sa_, h[2 * j + 1] * r * gb * sb_);
    }
    *(uint4*)&p.hbuf[(size_t)t * D + 512 + c0] = make_uint4(mw[0], mw[1], mw[2], mw[3]);
  }
}

__device__ __forceinline__ unsigned f2key(float f) {
  const unsigned u = __float_as_uint(f);
  return (u & 0x80000000u) ? ~u : (u | 0x80000000u);
}
__device__ __forceinline__ float key2f(unsigned k, unsigned mask) {
  const unsigned m = k & ~mask;
  const unsigned u = (m & 0x80000000u) ? (m & 0x7fffffffu) : ~m;
  return __uint_as_float(u);
}
#define KINSERT(LIST, KEY)                                   \
  {                                                          \
    unsigned kk_ = (KEY);                                    \
    _Pragma("unroll") for (int j_ = 0; j_ < 16; ++j_) {      \
      const unsigned hi_ = max(LIST[j_], kk_);               \
      kk_ = min(LIST[j_], kk_);                              \
      LIST[j_] = hi_;                                        \
    }                                                        \
  }
#define SBAR __builtin_amdgcn_sched_barrier(0)
__device__ __forceinline__ int launder(int v) { asm volatile("" : "+v"(v)); return v; }
#define G_ISSUE(BUF, TAB, IDS)                                                 \
  _Pragma("unroll") for (int i_ = 0; i_ < 16; ++i_) {                          \
    const int e_ = __builtin_amdgcn_readlane(IDS, i_);                         \
    BUF[i_] = *(const uint4*)&(TAB)[(size_t)e_ * D + lane * 16];               \
  }
#define U_DW(DW, J)                                                                        \
  acc_ = __builtin_elementwise_fma(__builtin_amdgcn_cvt_pk_f32_fp8(DW, false), hp[2 * (J)], acc_);      \
  acc_ = __builtin_elementwise_fma(__builtin_amdgcn_cvt_pk_f32_fp8(DW, true), hp[2 * (J) + 1], acc_);
#define G_DOTU(BUF)                                                            \
  _Pragma("unroll") for (int i_ = 0; i_ < 16; ++i_) {                          \
    f2v acc_ = (f2v){0.f, 0.f};                                                \
    U_DW(BUF[i_].x, 0) U_DW(BUF[i_].y, 1) U_DW(BUF[i_].z, 2) U_DW(BUF[i_].w, 3) \
    pa[i_] = acc_.x + acc_.y;                                                  \
  }
#define V_DW(DW, J)                                                                        \
  o2[2 * (J)] = __builtin_elementwise_fma(__builtin_amdgcn_cvt_pk_f32_fp8(DW, false), wv_, o2[2 * (J)]);      \
  o2[2 * (J) + 1] = __builtin_elementwise_fma(__builtin_amdgcn_cvt_pk_f32_fp8(DW, true), wv_, o2[2 * (J) + 1]);
#define G_ACCV(BUF)                                                            \
  _Pragma("unroll") for (int i_ = 0; i_ < 16; ++i_) {                          \
    const float w_ = __int_as_float(__builtin_amdgcn_readlane(wbits, i_));     \
    const f2v wv_ = (f2v){w_, w_};                                             \
    V_DW(BUF[i_].x, 0) V_DW(BUF[i_].y, 1) V_DW(BUF[i_].z, 2) V_DW(BUF[i_].w, 3) \
  }

__device__ __forceinline__ void phase_peer(const P& p, char* smem) {
  unsigned* sc = (unsigned*)smem;
  unsigned* skey = sc + 256 * 130;
  int* sE = (int*)sc;
  float* sG = (float*)(sc + 2048);
  for (int it = blockIdx.x; it < T / 16; it += gridDim.x) {
    const int t0 = it * 16;
    __syncthreads();
    {
      const int tid = launder(threadIdx.x), lane = tid & 63, wave = tid >> 6, l15 = lane & 15, quad = lane >> 4;
      const int half = wave >> 2;
      const u16* kb = p.kb + half * 16384;
#pragma unroll 1
      for (int hh = 0; hh < 2; ++hh) {
        const int head = (wave & 3) * 2 + hh;
        bf16x8 qf[4];
#pragma unroll
        for (int ks = 0; ks < 4; ++ks)
          qf[ks] = *(const bf16x8*)&p.qp[(size_t)(t0 + l15) * 2048 + head * 256 + half * 128 + ks * 32 + quad * 8];
        const int row = (head * 2 + half) * 16 + l15;
#pragma unroll 1
        for (int nt = 0; nt < 8; ++nt) {
          f32x4 acc = (f32x4){0.f, 0.f, 0.f, 0.f};
#pragma unroll
          for (int ks = 0; ks < 4; ++ks) {
            bf16x8 kf = *(const bf16x8*)&kb[(nt * 16 + l15) * 128 + ks * 32 + quad * 8];
            acc = mfma16(kf, qf[ks], acc);
          }
          const int key = nt * 16 + quad * 4;
          const int pos = key + (key >= 64 ? 1 : 0);
#pragma unroll
          for (int r = 0; r < 4; ++r) sc[row * 130 + pos + r] = (f2key(acc[r]) & ~0x7Fu) | (unsigned)(127 - (key + r));
        }
      }
    }
    __syncthreads();
    {
      const int tid = launder(threadIdx.x);
      const int row = tid >> 1, hs = tid & 1;
      const unsigned* src = sc + row * 130 + hs * 65;
      unsigned list[16];
#pragma unroll
      for (int j = 0; j < 16; ++j) list[j] = 0u;
#pragma unroll 1
      for (int k0 = 0; k0 < 64; k0 += 8) {
#pragma unroll
        for (int k = 0; k < 8; ++k) KINSERT(list, src[k0 + k])
      }
      unsigned other[16];
#pragma unroll
      for (int j = 0; j < 16; ++j) other[j] = __shfl_xor(list[j], 1);
#pragma unroll
      for (int j = 0; j < 16; ++j) KINSERT(list, other[j])
      if (hs == 0) {
#pragma unroll
        for (int j = 0; j < 16; ++j) skey[row * 16 + j] = list[j];
      }
    }
    __syncthreads();
    if (threadIdx.x < 128) {
      const int tid = launder(threadIdx.x);
      const int tok = tid & 15, head = tid >> 4;
      const int ra = (head * 2) * 16 + tok, rb = ra + 16;
      float v1[16], v2[16];
#pragma unroll
      for (int a = 0; a < 16; ++a) { v1[a] = key2f(skey[ra * 16 + a], 0x7Fu); v2[a] = key2f(skey[rb * 16 + a], 0x7Fu); }
      unsigned list[16];
#pragma unroll
      for (int j = 0; j < 16; ++j) list[j] = 0u;
#pragma unroll
      for (int a = 0; a < 16; ++a) {
#pragma unroll
        for (int b = 0; b < 16; ++b) {
          if ((a + 1) * (b + 1) <= 16) {
            const unsigned key = (f2key(v1[a] + v2[b]) & ~0xFFu) | (unsigned)(255 - (a * 16 + b));
            KINSERT(list, key)
          }
        }
      }
      const float smax = key2f(list[0], 0xFFu);
      float ex[16];
      float se = 0.f;
#pragma unroll
      for (int q = 0; q < 16; ++q) { ex[q] = expf(key2f(list[q], 0xFFu) - smax); se += ex[q]; }
      const float inv = 1.f / se;
#pragma unroll
      for (int q = 0; q < 16; ++q) {
        const int flat = 255 - (int)(list[q] & 0xFFu);
        const int i1 = 127 - (int)(skey[ra * 16 + (flat >> 4)] & 0x7Fu);
        const int i2 = 127 - (int)(skey[rb * 16 + (flat & 15)] & 0x7Fu);
        sE[(tok * 8 + head) * 16 + q] = i1 * 128 + i2;
        sG[(tok * 8 + head) * 16 + q] = ex[q] * inv;
      }
    }
    __syncthreads();
#pragma unroll 1
    for (int tk = 0; tk < 2; ++tk) {
      const int tid = launder(threadIdx.x), lane = tid & 63, wave = tid >> 6, l15 = lane & 15;
      const int tok = wave * 2 + tk;
      const int t = t0 + tok;
      const u16* h2r = p.hbuf + (size_t)t * D;
      f2v hp[8];
      {
        const uint4 hx0 = *(const uint4*)&h2r[lane * 16];
        const uint4 hx1 = *(const uint4*)&h2r[lane * 16 + 8];
        hp[0] = (f2v){lo_f(hx0.x), hi_f(hx0.x)}; hp[1] = (f2v){lo_f(hx0.y), hi_f(hx0.y)};
        hp[2] = (f2v){lo_f(hx0.z), hi_f(hx0.z)}; hp[3] = (f2v){lo_f(hx0.w), hi_f(hx0.w)};
        hp[4] = (f2v){lo_f(hx1.x), hi_f(hx1.x)}; hp[5] = (f2v){lo_f(hx1.y), hi_f(hx1.y)};
        hp[6] = (f2v){lo_f(hx1.z), hi_f(hx1.z)}; hp[7] = (f2v){lo_f(hx1.w), hi_f(hx1.w)};
      }
      f2v o2[8];
#pragma unroll
      for (int j = 0; j < 8; ++j) o2[j] = (f2v){0.f, 0.f};
      uint4 A[16], B[16];
      int ids = sE[(tok * 8) * 16 + l15];
      G_ISSUE(A, p.ub8, ids)
      SBAR;
#pragma unroll 1
      for (int head = 0; head < 8; ++head) {
        const float gate = sG[(tok * 8 + head) * 16 + l15];
        const int ids_n = sE[(tok * 8 + ((head + 1) & 7)) * 16 + l15];
        const float sui = p.sinv[ids];
        const float svi = p.sinv[16384 + ids];
        float pa[16];
        G_ISSUE(B, p.vb8, ids)
        SBAR;
        G_DOTU(A)
        float q8[8], q4[4], q2[2], q1;
        {
          const bool b3 = (lane & 8) != 0;
#pragma unroll
          for (int i = 0; i < 8; ++i) {
            const float keep = b3 ? pa[i + 8] : pa[i];
            const float send = b3 ? pa[i] : pa[i + 8];
            q8[i] = keep + __shfl_xor(send, 8);
          }
          const bool b2 = (lane & 4) != 0;
#pragma unroll
          for (int i = 0; i < 4; ++i) {
            const float keep = b2 ? q8[i + 4] : q8[i];
            const float send = b2 ? q8[i] : q8[i + 4];
            q4[i] = keep + __shfl_xor(send, 4);
          }
          const bool b1 = (lane & 2) != 0;
#pragma unroll
          for (int i = 0; i < 2; ++i) {
            const float keep = b1 ? q4[i + 2] : q4[i];
            const float send = b1 ? q4[i] : q4[i + 2];
            q2[i] = keep + __shfl_xor(send, 2);
          }
          const bool b0 = (lane & 1) != 0;
          {
            const float keep = b0 ? q2[1] : q2[0];
            const float send = b0 ? q2[0] : q2[1];
            q1 = keep + __shfl_xor(send, 1);
          }
          q1 += __shfl_xor(q1, 16);
          q1 += __shfl_xor(q1, 32);
        }
        const float av = q1 * sui;
        const float ge = 0.5f * av * (1.f + erff(av * 0.7071067811865476f));
        const int wbits = __float_as_int(gate * ge * svi);
        SBAR;
        if (head < 7) { G_ISSUE(A, p.ub8, ids_n) }
        SBAR;
        G_ACCV(B)
        SBAR;
        ids = ids_n;
      }
      float o[16];
#pragma unroll
      for (int j = 0; j < 8; ++j) { o[2 * j] = o2[j].x; o[2 * j + 1] = o2[j].y; }
      const int ci = t < TCTX ? 0 : 1 + ((t - TCTX) >> 12);
      const float* ga2 = p.mod + ci * 6144 + 5 * 1024;
      float* xr = p.out + (size_t)t * D;
      float x2[16];
      float ss = 0.f;
#pragma unroll
      for (int q = 0; q < 4; ++q) {
        const int col = lane * 16 + q * 4;
        const float4 xa = *(const float4*)&xr[col];
        const float4 ga = *(const float4*)&ga2[col];
        x2[q * 4 + 0] = xa.x + ga.x * o[q * 4 + 0];
        x2[q * 4 + 1] = xa.y + ga.y * o[q * 4 + 1];
        x2[q * 4 + 2] = xa.z + ga.z * o[q * 4 + 2];
        x2[q * 4 + 3] = xa.w + ga.w * o[q * 4 + 3];
      }
#pragma unroll
      for (int j = 0; j < 16; ++j) ss += x2[j] * x2[j];
      ss = wave_sum(ss);
      const float rstd = rsqrtf(ss * (1.f / 1024.f) + EPS);
#pragma unroll
      for (int q = 0; q < 4; ++q) {
        const int col = lane * 16 + q * 4;
        const float4 g0 = *(const float4*)&p.g_final[col];
        *(float4*)&xr[col] = make_float4(x2[q * 4 + 0] * rstd * g0.x, x2[q * 4 + 1] * rstd * g0.y,
                                         x2[q * 4 + 2] * rstd * g0.z, x2[q * 4 + 3] * rstd * g0.w);
      }
    }
  }
}

__global__ void __launch_bounds__(NT) mega(P p, int ph_lo, int ph_hi) {
  extern __shared__ __attribute__((aligned(16))) char smem[];
  cg::grid_group grid = cg::this_grid();
#define RUN_PHASE(k, call)                              \
  if (ph_lo <= (k) && (k) < ph_hi) {                    \
    call;                                               \
    if ((k) + 1 < ph_hi) grid.sync();                   \
  }
  RUN_PHASE(0, phase_prep(p, smem))
  RUN_PHASE(1, phase_norm(p, 0))
  RUN_PHASE(2, gemm_phase<0>(p, p.hbuf, p.w_in_t, NPAD / 128, smem))
#if PROBE_SEL == 1
  gemm_phase<0>(p, p.hbuf, p.w_in_t, NPAD / 128, smem); grid.sync();
  gemm_phase<0>(p, p.hbuf, p.w_in_t, NPAD / 128, smem); grid.sync();
#elif PROBE_SEL == 2
  phase_mlstm(p, smem); grid.sync();
  phase_mlstm(p, smem); grid.sync();
#endif
  RUN_PHASE(3, phase_mlstm(p, smem))
  RUN_PHASE(4, phase_mix(p))
  RUN_PHASE(5, gemm_phase<1>(p, p.hbuf, p.w_out_t, 1024 / 128, smem))
  RUN_PHASE(6, (phase_norm(p, 1), convert_tables(p)))
  RUN_PHASE(7, gemm_phase<2>(p, p.hbuf, p.wq_t, 2048 / 128, smem))
  RUN_PHASE(8, phase_peer(p, smem))
}

extern "C" void kernel_launch(void* const* d_in, const int* in_sizes, int n_in, void* d_out, int out_size,
                              void* d_ws, size_t ws_size, hipStream_t stream) {
  P p{};
  const float* const* in = (const float* const*)d_in;
  p.x_prompt = in[0]; p.x_sample = in[1]; p.state_C = in[2]; p.state_n = in[3]; p.state_m = in[4];
  p.c = in[5]; p.c_ctx = in[6]; p.w_ada = in[7]; p.b_ada = in[8]; p.g_norm1 = in[9]; p.w_in = in[10];
  p.b_igate = in[11]; p.b_fgate = in[12]; p.conv_w = in[13]; p.conv_b = in[14]; p.g_mlstm = in[15];
  p.w_out = in[16]; p.g_norm2 = in[17]; p.wq = in[18]; p.k1 = in[19]; p.k2 = in[20]; p.u = in[21]; p.v = in[22];
  p.g_final = in[23];
  p.out = (float*)d_out;
  char* ws = (char*)d_ws;
  size_t off = 0;
  auto take = [&](size_t bytes) { char* r = ws + off; off += (bytes + 255) & ~(size_t)255; return r; };
  p.mod = (float*)take(5 * 6144 * 4);
  p.w_in_t = (u16*)take((size_t)NPAD * 1024 * 2);
  p.w_out_t = (u16*)take((size_t)1024 * 1024 * 2);
  p.wq_t = (u16*)take((size_t)2048 * 1024 * 2);
  p.kb = (u16*)take(2 * 16384 * 2);
  p.gates = (float*)take((size_t)T * 16 * 4);
  p.hbuf = (u16*)take((size_t)T * D * 2);
  p.proj = (u16*)take((size_t)T * NPROJ * 2);
  p.qp = p.proj;
  p.ub8 = (unsigned char*)(p.proj + (size_t)T * 2048);
  p.vb8 = p.ub8 + (size_t)16384 * 1024;
  p.sinv = (float*)(p.vb8 + (size_t)16384 * 1024);

  hipFuncSetAttribute((const void*)mega, hipFuncAttributeMaxDynamicSharedMemorySize, LDS_BYTES);
  int dev = 0, cus = 0, per = 0;
  hipGetDevice(&dev);
  hipDeviceGetAttribute(&cus, hipDeviceAttributeMultiprocessorCount, dev);
  hipOccupancyMaxActiveBlocksPerMultiprocessor(&per, (const void*)mega, NT, LDS_BYTES);
  if (per < 1) per = 1;
  const int grid = cus;
#if MULTI_LAUNCH
  for (int ph = 0; ph < NPHASE; ++ph) {
    hipLaunchKernelGGL(mega, dim3(grid), dim3(NT), LDS_BYTES, stream, p, ph, ph + 1);
  }
#else
  int lo = 0, hi = NPHASE;
  void* args[] = {&p, &lo, &hi};
  hipError_t e = hipLaunchCooperativeKernel((const void*)mega, dim3(grid), dim3(NT), args, LDS_BYTES, stream);
  if (e != hipSuccess) fprintf(stderr, "cooperative launch failed: %s (grid %d)\n", hipGetErrorString(e), grid);
#endif
}
```

```cpp
#include <hip/hip_runtime.h>
#include <hip/hip_cooperative_groups.h>
#include <cstdio>
#include <cstdint>
namespace cg = cooperative_groups;

#ifndef MULTI_LAUNCH
#define MULTI_LAUNCH 0
#endif

typedef unsigned short u16;
typedef __attribute__((ext_vector_type(8))) short bf16x8;
typedef __attribute__((ext_vector_type(4))) float f32x4;
typedef __attribute__((ext_vector_type(2))) __bf16 bf2_t;
typedef __attribute__((ext_vector_type(2))) float f2v;

constexpr int NT = 512;
constexpr int D = 1024;
constexpr int TCTX = 8192;
constexpr int TLAT = 16384;
constexpr int T = TCTX + TLAT;
constexpr int NPROJ = 3584;
constexpr int NPAD = 3712;
constexpr int LDS_BYTES = 256 * 130 * 4 + 256 * 16 * 4;
constexpr float EPS = 1e-6f;
constexpr int NPHASE = 9;

struct P {
  const float *x_prompt, *x_sample, *state_C, *state_n, *state_m, *c, *c_ctx, *w_ada, *b_ada, *g_norm1, *w_in,
      *b_igate, *b_fgate, *conv_w, *conv_b, *g_mlstm, *w_out, *g_norm2, *wq, *k1, *k2, *u, *v, *g_final;
  float* out;
  float* mod;
  u16* w_in_t;
  u16* w_out_t;
  u16* wq_t;
  u16* kb;
  float* gates;
  u16* hbuf;
  u16* proj;
  u16* qp;
  unsigned char* ub8;
  unsigned char* vb8;
  float* sinv;
};

__device__ __forceinline__ u16 f2bf(float f) {
  unsigned u = __float_as_uint(f);
  u += 0x7fffu + ((u >> 16) & 1u);
  return (u16)(u >> 16);
}
__device__ __forceinline__ float bf2f(u16 h) { return __uint_as_float(((unsigned)h) << 16); }
__device__ __forceinline__ unsigned pack2(float a, float b) { return (unsigned)f2bf(a) | ((unsigned)f2bf(b) << 16); }
__device__ __forceinline__ float lo_f(unsigned w) { return __uint_as_float(w << 16); }
__device__ __forceinline__ float hi_f(unsigned w) { return __uint_as_float(w & 0xffff0000u); }
__device__ __forceinline__ float wave_sum(float v) {
#pragma unroll
  for (int o = 32; o > 0; o >>= 1) v += __shfl_xor(v, o);
  return v;
}
__device__ __forceinline__ float dot2(unsigned a, unsigned b, float c) {
  return __builtin_amdgcn_fdot2_f32_bf16(__builtin_bit_cast(bf2_t, a), __builtin_bit_cast(bf2_t, b), c, false);
}
__device__ __forceinline__ float dot8(uint4 a, uint4 b, float c) {
  c = dot2(a.x, b.x, c); c = dot2(a.y, b.y, c); c = dot2(a.z, b.z, c); c = dot2(a.w, b.w, c);
  return c;
}
__device__ __forceinline__ f32x4 mfma16(bf16x8 a, bf16x8 b, f32x4 c) {
  return __builtin_amdgcn_mfma_f32_16x16x32_bf16(a, b, c, 0, 0, 0);
}

__device__ __forceinline__ void transpose_tile(const float* __restrict__ W, int Nreal, u16* __restrict__ Wt, int k0, int n0, float* tile) {
  const int tid = threadIdx.x;
#pragma unroll
  for (int i = 0; i < 8; ++i) {
    int idx = i * NT + tid;
    int kk = idx >> 6, nn = idx & 63;
    float v = (n0 + nn < Nreal) ? W[(size_t)(k0 + kk) * Nreal + n0 + nn] : 0.f;
    tile[kk * 65 + nn] = v;
  }
  __syncthreads();
#pragma unroll
  for (int i = 0; i < 8; ++i) {
    int idx = i * NT + tid;
    int nn = idx >> 6, kk = idx & 63;
    Wt[(size_t)(n0 + nn) * 1024 + k0 + kk] = f2bf(tile[kk * 65 + nn]);
  }
}

__device__ __forceinline__ void phase_prep(const P& p, char* smem) {
  const int tid = threadIdx.x;
  float* sf = (float*)smem;
  const int n_gemv = 96, n_tin = 16 * 58, n_tout = 16 * 16, n_tq = 16 * 32, n_k = 2;
  const int total = n_gemv + n_tin + n_tout + n_tq + n_k;
  for (int it = blockIdx.x; it < total; it += gridDim.x) {
    __syncthreads();
    if (it < n_gemv) {
      for (int i = tid; i < 5 * 1024; i += NT) {
        int ci = i >> 10, k = i & 1023;
        float cv = (ci == 0) ? p.c_ctx[k] : p.c[(ci - 1) * 1024 + k];
        sf[i] = cv / (1.f + expf(-cv));
      }
      __syncthreads();
      const int cl = tid & 15, kg = tid >> 4;
      const int col = it * 64 + cl * 4;
      float acc[5][4];
#pragma unroll
      for (int ci = 0; ci < 5; ++ci)
#pragma unroll
        for (int j = 0; j < 4; ++j) acc[ci][j] = 0.f;
      for (int kk = 0; kk < 32; ++kk) {
        int k = kg * 32 + kk;
        float4 w = *(const float4*)&p.w_ada[(size_t)k * 6144 + col];
#pragma unroll
        for (int ci = 0; ci < 5; ++ci) {
          float s = sf[ci * 1024 + k];
          acc[ci][0] += s * w.x; acc[ci][1] += s * w.y; acc[ci][2] += s * w.z; acc[ci][3] += s * w.w;
        }
      }
      float* red = sf + 5 * 1024;
#pragma unroll
      for (int ci = 0; ci < 5; ++ci)
#pragma unroll
        for (int j = 0; j < 4; ++j) red[(kg * 16 + cl) * 20 + ci * 4 + j] = acc[ci][j];
      __syncthreads();
      if (tid < 320) {
        int ci = tid >> 6, cc = tid & 63;
        int cl2 = cc >> 2, j = cc & 3;
        float s = 0.f;
        for (int g = 0; g < 32; ++g) s += red[(g * 16 + cl2) * 20 + ci * 4 + j];
        int col2 = it * 64 + cc;
        p.mod[ci * 6144 + col2] = s + p.b_ada[col2];
      }
    } else if (it < n_gemv + n_tin) {
      int j = it - n_gemv;
      transpose_tile(p.w_in, 3600, p.w_in_t, (j / 58) * 64, (j % 58) * 64, sf);
    } else if (it < n_gemv + n_tin + n_tout) {
      int j = it - n_gemv - n_tin;
      transpose_tile(p.w_out, 1024, p.w_out_t, (j / 16) * 64, (j % 16) * 64, sf);
    } else if (it < n_gemv + n_tin + n_tout + n_tq) {
      int j = it - n_gemv - n_tin - n_tout;
      transpose_tile(p.wq, 2048, p.wq_t, (j / 32) * 64, (j % 32) * 64, sf);
    } else {
      int j = it - n_gemv - n_tin - n_tout - n_tq;
      const float* src = j ? p.k2 : p.k1;
      u16* dst = p.kb + j * 16384;
      for (int i = tid; i < 16384; i += NT) dst[i] = f2bf(src[i]);
    }
  }
}

__device__ __forceinline__ void phase_norm(const P& p, int which) {
  const int wave = threadIdx.x >> 6, lane = threadIdx.x & 63;
  for (int t = blockIdx.x * 8 + wave; t < T; t += gridDim.x * 8) {
    const float* xr = which ? (p.out + (size_t)t * D)
                            : (t < TCTX ? p.x_prompt + (size_t)t * D : p.x_sample + (size_t)(t - TCTX) * D);
    const int ci = t < TCTX ? 0 : 1 + ((t - TCTX) >> 12);
    const float* md = p.mod + ci * 6144 + (which ? 3 * 1024 : 0);
    const float* g = which ? p.g_norm2 : p.g_norm1;
    float4 xv[4];
    float ss = 0.f;
#pragma unroll
    for (int i = 0; i < 4; ++i) {
      xv[i] = *(const float4*)&xr[i * 256 + lane * 4];
      ss += xv[i].x * xv[i].x + xv[i].y * xv[i].y + xv[i].z * xv[i].z + xv[i].w * xv[i].w;
    }
    ss = wave_sum(ss);
    const float rstd = rsqrtf(ss * (1.f / 1024.f) + EPS);
#pragma unroll
    for (int i = 0; i < 4; ++i) {
      int col = i * 256 + lane * 4;
      float4 g4 = *(const float4*)&g[col];
      float4 sh = *(const float4*)&md[col];
      float4 sc = *(const float4*)&md[1024 + col];
      float h0 = xv[i].x * rstd * g4.x * (1.f + sc.x) + sh.x;
      float h1 = xv[i].y * rstd * g4.y * (1.f + sc.y) + sh.y;
      float h2 = xv[i].z * rstd * g4.z * (1.f + sc.z) + sh.z;
      float h3 = xv[i].w * rstd * g4.w * (1.f + sc.w) + sh.w;
      uint2 o; o.x = pack2(h0, h1); o.y = pack2(h2, h3);
      *(uint2*)&p.hbuf[(size_t)t * D + col] = o;
    }
  }
}

__device__ __forceinline__ void convert_tables(const P& p) {
  const int wave = threadIdx.x >> 6, lane = threadIdx.x & 63;
  for (int row = blockIdx.x * 8 + wave; row < 32768; row += gridDim.x * 8) {
    const float* src = row < 16384 ? p.u + (size_t)row * D : p.v + (size_t)(row - 16384) * D;
    unsigned char* dst = row < 16384 ? p.ub8 + (size_t)row * D : p.vb8 + (size_t)(row - 16384) * D;
    float4 f[4];
    float amax = 0.f;
#pragma unroll
    for (int i = 0; i < 4; ++i) {
      f[i] = *(const float4*)&src[lane * 16 + i * 4];
      amax = fmaxf(amax, fmaxf(fmaxf(fabsf(f[i].x), fabsf(f[i].y)), fmaxf(fabsf(f[i].z), fabsf(f[i].w))));
    }
#pragma unroll
    for (int o = 32; o > 0; o >>= 1) amax = fmaxf(amax, __shfl_xor(amax, o));
    const float sc = amax > 0.f ? 384.f / amax : 1.f;
    const float inv = amax > 0.f ? amax * (1.f / 384.f) : 1.f;
    unsigned w[4];
#pragma unroll
    for (int i = 0; i < 4; ++i) {
      unsigned pk = 0u;
      pk = __builtin_amdgcn_cvt_pk_fp8_f32(f[i].x * sc, f[i].y * sc, pk, false);
      pk = __builtin_amdgcn_cvt_pk_fp8_f32(f[i].z * sc, f[i].w * sc, pk, true);
      w[i] = pk;
    }
    *(uint4*)&dst[lane * 16] = make_uint4(w[0], w[1], w[2], w[3]);
    if (lane == 0) p.sinv[row] = inv;
  }
}

template <int MODE>
__device__ __forceinline__ void gemm_phase(const P& p, const u16* __restrict__ A, const u16* __restrict__ Bt, int ntn, char* smem) {
  const int tid = threadIdx.x, lane = tid & 63, wave = tid >> 6;
  const int wm = wave >> 1, wn = wave & 1, l15 = lane & 15, quad = lane >> 4;
  u16* sA = (u16*)smem;
  u16* sB = sA + 2 * 256 * 72;
  const int ntiles = (T / 256) * ntn;
  for (int tile = blockIdx.x; tile < ntiles; tile += gridDim.x) {
    const int mt = tile / ntn, nt = tile % ntn;
    const int m0 = mt * 256, n0 = nt * 128;
    f32x4 acc[4][4];
#pragma unroll
    for (int i = 0; i < 4; ++i)
#pragma unroll
      for (int j = 0; j < 4; ++j) acc[i][j] = (f32x4){0.f, 0.f, 0.f, 0.f};
    uint4 ra[4], rb[2];
    const int lrow = tid >> 3, lch = tid & 7;
#pragma unroll
    for (int i = 0; i < 4; ++i) ra[i] = *(const uint4*)&A[(size_t)(m0 + i * 64 + lrow) * 1024 + lch * 8];
#pragma unroll
    for (int i = 0; i < 2; ++i) rb[i] = *(const uint4*)&Bt[(size_t)(n0 + i * 64 + lrow) * 1024 + lch * 8];
#pragma unroll
    for (int i = 0; i < 4; ++i) *(uint4*)&sA[(i * 64 + lrow) * 72 + lch * 8] = ra[i];
#pragma unroll
    for (int i = 0; i < 2; ++i) *(uint4*)&sB[(i * 64 + lrow) * 72 + lch * 8] = rb[i];
    __syncthreads();
    for (int kt = 0; kt < 16; ++kt) {
      if (kt + 1 < 16) {
#pragma unroll
        for (int i = 0; i < 4; ++i) ra[i] = *(const uint4*)&A[(size_t)(m0 + i * 64 + lrow) * 1024 + (kt + 1) * 64 + lch * 8];
#pragma unroll
        for (int i = 0; i < 2; ++i) rb[i] = *(const uint4*)&Bt[(size_t)(n0 + i * 64 + lrow) * 1024 + (kt + 1) * 64 + lch * 8];
      }
      const u16* a_s = sA + (kt & 1) * 256 * 72;
      const u16* b_s = sB + (kt & 1) * 128 * 72;
#pragma unroll
      for (int ks = 0; ks < 2; ++ks) {
        bf16x8 bfr[4], afr[4];
#pragma unroll
        for (int ni = 0; ni < 4; ++ni) bfr[ni] = *(const bf16x8*)&b_s[(wn * 64 + ni * 16 + l15) * 72 + ks * 32 + quad * 8];
#pragma unroll
        for (int mi = 0; mi < 4; ++mi) afr[mi] = *(const bf16x8*)&a_s[(wm * 64 + mi * 16 + l15) * 72 + ks * 32 + quad * 8];
#pragma unroll
        for (int ni = 0; ni < 4; ++ni)
#pragma unroll
          for (int mi = 0; mi < 4; ++mi) acc[ni][mi] = mfma16(bfr[ni], afr[mi], acc[ni][mi]);
      }
      if (kt + 1 < 16) {
        u16* a_w = sA + ((kt + 1) & 1) * 256 * 72;
        u16* b_w = sB + ((kt + 1) & 1) * 128 * 72;
#pragma unroll
        for (int i = 0; i < 4; ++i) *(uint4*)&a_w[(i * 64 + lrow) * 72 + lch * 8] = ra[i];
#pragma unroll
        for (int i = 0; i < 2; ++i) *(uint4*)&b_w[(i * 64 + lrow) * 72 + lch * 8] = rb[i];
      }
      __syncthreads();
    }
#pragma unroll
    for (int mi = 0; mi < 4; ++mi) {
      const int m = m0 + wm * 64 + mi * 16 + l15;
#pragma unroll
      for (int ni = 0; ni < 4; ++ni) {
        const int n = n0 + wn * 64 + ni * 16 + quad * 4;
        f32x4 a = acc[ni][mi];
        if (MODE == 0) {
          if (n < NPROJ) {
            uint2 o; o.x = pack2(a[0], a[1]); o.y = pack2(a[2], a[3]);
            *(uint2*)&p.proj[(size_t)m * NPROJ + n] = o;
          } else if (n < 3600) {
            *(float4*)&p.gates[(size_t)m * 16 + (n - NPROJ)] = make_float4(a[0], a[1], a[2], a[3]);
          }
        } else if (MODE == 1) {
          const float* xr = m < TCTX ? p.x_prompt + (size_t)m * D : p.x_sample + (size_t)(m - TCTX) * D;
          const int ci = m < TCTX ? 0 : 1 + ((m - TCTX) >> 12);
          float4 xv = *(const float4*)&xr[n];
          float4 ga = *(const float4*)&p.mod[ci * 6144 + 2 * 1024 + n];
          float4 o = make_float4(xv.x + ga.x * a[0], xv.y + ga.y * a[1], xv.z + ga.z * a[2], xv.w + ga.w * a[3]);
          *(float4*)&p.out[(size_t)m * D + n] = o;
        } else {
          uint2 o; o.x = pack2(a[0], a[1]); o.y = pack2(a[2], a[3]);
          *(uint2*)&p.qp[(size_t)m * 2048 + n] = o;
        }
      }
    }
  }
}

__device__ __forceinline__ void mlstm_task(const P& p, int task, char* smem) {
  const int tid = threadIdx.x, lane = tid & 63, wave = tid >> 6, l15 = lane & 15, quad = lane >> 4;
  const bool lat = task < 128;
  const int id = lat ? task : task - 128;
  const int slice = id & 3, dir = (id >> 2) & 1, head = (id >> 3) & 3, bat = id >> 5;
  const int tb = lat ? TCTX + bat * 4096 : bat * 256;
  const int L = lat ? 4096 : 256;
  const int nch = L >> 6;
  const int gcol = dir * 4 + head;
  const float big = p.b_igate[gcol], bfg = p.b_fgate[gcol];
  const float scale = 0.08838834764831845f;

  u16* sQ = (u16*)smem;
  u16* sK = sQ + 64 * 136;
  u16* sKt = sK + 64 * 136;
  u16* sVt = sKt + 128 * 72;
  u16* sS = sVt + 32 * 72;
  u16* sCt = sS + 64 * 72;
  float* sg = (float*)(sCt + 32 * 136);
  float* smm = sg + 64;
  float* sa = smm + 64;
  float* semt = sa + 64;
  float* sden = semt + 64;
  float* sqn = sden + 64;
  float* sN = sqn + 64;

  const int sbase = (bat * 2 + dir) * 4 + head;
  f32x4 C[2];
  float m;
  __syncthreads();
  if (lat) {
#pragma unroll
    for (int tj = 0; tj < 2; ++tj)
#pragma unroll
      for (int r = 0; r < 4; ++r)
        C[tj][r] = p.state_C[(size_t)sbase * 16384 + (wave * 16 + quad * 4 + r) * 128 + slice * 32 + tj * 16 + l15];
    m = p.state_m[sbase];
    if (tid < 128) sN[tid] = p.state_n[sbase * 128 + tid];
  } else {
    C[0] = (f32x4){0.f, 0.f, 0.f, 0.f};
    C[1] = (f32x4){0.f, 0.f, 0.f, 0.f};
    m = 0.f;
    if (tid < 128) sN[tid] = 0.f;
  }
#pragma unroll
  for (int tj = 0; tj < 2; ++tj) {
    uint2 o; o.x = pack2(C[tj][0], C[tj][1]); o.y = pack2(C[tj][2], C[tj][3]);
    *(uint2*)&sCt[(tj * 16 + l15) * 136 + wave * 16 + quad * 4] = o;
  }
  __syncthreads();

  float* hout = p.out + (size_t)dir * T * 512;
  const int s = tid >> 3, part = tid & 7;

  for (int c = 0; c < nch; ++c) {
    const int posl = c * 64 + lane;
    const int tl = tb + (dir ? (L - 1 - posl) : posl);
    const float ig = p.gates[(size_t)tl * 16 + gcol] + big;
    const float fr = p.gates[(size_t)tl * 16 + 8 + gcol] + bfg;
    const float lf = fminf(fr, 0.f) - log1pf(expf(-fabsf(fr)));
    float b = lf;
#pragma unroll
    for (int off = 1; off < 64; off <<= 1) { float v = __shfl_up(b, off); if (lane >= off) b += v; }
    const float g = ig - b;
    float G = g;
#pragma unroll
    for (int off = 1; off < 64; off <<= 1) { float v = __shfl_up(G, off); if (lane >= off) G = fmaxf(G, v); }
    const float mm = fmaxf(m, G);
    const float mmT = __shfl(mm, 63), bT = __shfl(b, 63);
    const float wgt = expf(g - mmT);
    const float decay = expf(m - mmT);
    const float m_new = bT + mmT;
    if (wave == 0) {
      sg[lane] = g; smm[lane] = mm; sa[lane] = expf(m - mm); semt[lane] = expf(-(b + mm)); sden[lane] = 0.f;
    }
    const int poss = c * 64 + s;
    const int ts = tb + (dir ? (L - 1 - poss) : poss);
    const u16* prow = p.proj + (size_t)ts * NPROJ;
    const uint4 q0 = *(const uint4*)&prow[1536 + head * 128 + part * 16];
    const uint4 q1 = *(const uint4*)&prow[1536 + head * 128 + part * 16 + 8];
    const uint4 k0 = *(const uint4*)&prow[2048 + head * 128 + part * 16];
    const uint4 k1 = *(const uint4*)&prow[2048 + head * 128 + part * 16 + 8];
    const uint2 vv = *(const uint2*)&prow[2560 + head * 128 + slice * 32 + part * 4];
    const float ws_ = __shfl(wgt, s);
    *(uint4*)&sQ[s * 136 + part * 16] = q0;
    *(uint4*)&sQ[s * 136 + part * 16 + 8] = q1;
    *(uint4*)&sK[s * 136 + part * 16] = k0;
    *(uint4*)&sK[s * 136 + part * 16 + 8] = k1;
    {
      const unsigned qw[8] = {q0.x, q0.y, q0.z, q0.w, q1.x, q1.y, q1.z, q1.w};
      float qn = 0.f;
#pragma unroll
      for (int j = 0; j < 8; ++j) {
        qn += lo_f(qw[j]) * sN[part * 16 + 2 * j] + hi_f(qw[j]) * sN[part * 16 + 2 * j + 1];
      }
      qn += __shfl_xor(qn, 1); qn += __shfl_xor(qn, 2); qn += __shfl_xor(qn, 4);
      if (part == 0) sqn[s] = qn * scale;
      const unsigned kw[8] = {k0.x, k0.y, k0.z, k0.w, k1.x, k1.y, k1.z, k1.w};
      const int pc = ((s >> 3) ^ part) * 8 + (s & 7);
#pragma unroll
      for (int j = 0; j < 8; ++j) {
        sKt[(part * 16 + 2 * j) * 72 + pc] = f2bf(lo_f(kw[j]) * ws_);
        sKt[(part * 16 + 2 * j + 1) * 72 + pc] = f2bf(hi_f(kw[j]) * ws_);
      }
      sVt[(part * 4 + 0) * 72 + pc] = (u16)(vv.x & 0xffffu);
      sVt[(part * 4 + 1) * 72 + pc] = (u16)(vv.x >> 16);
      sVt[(part * 4 + 2) * 72 + pc] = (u16)(vv.y & 0xffffu);
      sVt[(part * 4 + 3) * 72 + pc] = (u16)(vv.y >> 16);
    }
    __syncthreads();

    const int tj = wave >> 1, ti = wave & 1;
    const int trow = tj * 16 + l15;
    {
      const float mmt = smm[trow];
      float psum = 0.f;
#pragma unroll
      for (int tt = 0; tt < 2; ++tt) {
        const int si = (wave & 1) * 2 + tt;
        f32x4 acc = (f32x4){0.f, 0.f, 0.f, 0.f};
#pragma unroll
        for (int ks = 0; ks < 4; ++ks) {
          bf16x8 afr = *(const bf16x8*)&sK[(si * 16 + l15) * 136 + ks * 32 + quad * 8];
          bf16x8 bfr = *(const bf16x8*)&sQ[trow * 136 + ks * 32 + quad * 8];
          acc = mfma16(afr, bfr, acc);
        }
        const int s0 = si * 16 + quad * 4;
        float vals[4];
#pragma unroll
        for (int r = 0; r < 4; ++r) {
          const int sidx = s0 + r;
          const float e = expf(fminf(sg[sidx] - mmt, 0.f));
          const float val = (sidx <= trow) ? acc[r] * scale * e : 0.f;
          vals[r] = val;
          psum += val;
        }
        uint2 o; o.x = pack2(vals[0], vals[1]); o.y = pack2(vals[2], vals[3]);
        *(uint2*)&sS[trow * 72 + s0] = o;
      }
      psum += __shfl_xor(psum, 16);
      psum += __shfl_xor(psum, 32);
      if (quad == 0) atomicAdd(&sden[trow], psum);
    }
    f32x4 aqc = (f32x4){0.f, 0.f, 0.f, 0.f};
#pragma unroll
    for (int ks = 0; ks < 4; ++ks) {
      bf16x8 afr = *(const bf16x8*)&sCt[(ti * 16 + l15) * 136 + ks * 32 + quad * 8];
      bf16x8 bfr = *(const bf16x8*)&sQ[trow * 136 + ks * 32 + quad * 8];
      aqc = mfma16(afr, bfr, aqc);
    }
    __syncthreads();
    {
      f32x4 asv = (f32x4){0.f, 0.f, 0.f, 0.f};
      const int vrow = ti * 16 + l15;
      const int vkey = (vrow >> 2) & 7;
#pragma unroll
      for (int ks = 0; ks < 2; ++ks) {
        bf16x8 afr = *(const bf16x8*)&sVt[vrow * 72 + (((ks * 4 + quad) ^ vkey) * 8)];
        bf16x8 bfr = *(const bf16x8*)&sS[trow * 72 + ks * 32 + quad * 8];
        asv = mfma16(afr, bfr, asv);
      }
      const float a_t = sa[trow];
      const float den = a_t * sqn[trow] + sden[trow];
      const float inv = 1.f / fmaxf(fabsf(den), semt[trow]);
      const float as = a_t * scale;
      float4 h = make_float4((as * aqc[0] + asv[0]) * inv, (as * aqc[1] + asv[1]) * inv,
                             (as * aqc[2] + asv[2]) * inv, (as * aqc[3] + asv[3]) * inv);
      const int post = c * 64 + trow;
      const int tt = tb + (dir ? (L - 1 - post) : post);
      *(float4*)&hout[(size_t)tt * 512 + head * 128 + slice * 32 + ti * 16 + quad * 4] = h;
    }
#pragma unroll
    for (int t2 = 0; t2 < 2; ++t2) {
      C[t2][0] *= decay; C[t2][1] *= decay; C[t2][2] *= decay; C[t2][3] *= decay;
      const int krow = wave * 16 + l15;
      const int kkey = wave & 7;
      const int vrow = t2 * 16 + l15;
      const int vkey = (vrow >> 2) & 7;
#pragma unroll
      for (int ks = 0; ks < 2; ++ks) {
        bf16x8 afr = *(const bf16x8*)&sKt[krow * 72 + (((ks * 4 + quad) ^ kkey) * 8)];
        bf16x8 bfr = *(const bf16x8*)&sVt[vrow * 72 + (((ks * 4 + quad) ^ vkey) * 8)];
        C[t2] = mfma16(afr, bfr, C[t2]);
      }
    }
    if (tid < 128) {
      float sum = 0.f;
#pragma unroll
      for (int j = 0; j < 8; ++j) {
        uint4 w = *(const uint4*)&sKt[tid * 72 + j * 8];
        sum += lo_f(w.x) + hi_f(w.x) + lo_f(w.y) + hi_f(w.y) + lo_f(w.z) + hi_f(w.z) + lo_f(w.w) + hi_f(w.w);
      }
      sN[tid] = decay * sN[tid] + sum;
    }
#pragma unroll
    for (int t2 = 0; t2 < 2; ++t2) {
      uint2 o; o.x = pack2(C[t2][0], C[t2][1]); o.y = pack2(C[t2][2], C[t2][3]);
      *(uint2*)&sCt[(t2 * 16 + l15) * 136 + wave * 16 + quad * 4] = o;
    }
    m = m_new;
    __syncthreads();
  }
  if (!lat) {
    float* newC = p.out + (size_t)T * D;
    float* newn = newC + (size_t)32 * 2 * 4 * 128 * 128;
    float* newm = newn + 32 * 2 * 4 * 128;
#pragma unroll
    for (int t2 = 0; t2 < 2; ++t2)
#pragma unroll
      for (int r = 0; r < 4; ++r)
        newC[(size_t)sbase * 16384 + (wave * 16 + quad * 4 + r) * 128 + slice * 32 + t2 * 16 + l15] = C[t2][r];
    if (slice == 0) {
      if (tid < 128) newn[sbase * 128 + tid] = sN[tid];
      if (tid == 0) newm[sbase] = m;
    }
  }
}

__device__ __forceinline__ void phase_mlstm(const P& p, char* smem) {
  const int G = gridDim.x, b = blockIdx.x;
  if (G >= 256) {
    if (b < 128) mlstm_task(p, b, smem);
    else for (int task = b; task < 1152; task += G - 128) mlstm_task(p, task, smem);
  } else {
    for (int task = b; task < 1152; task += G) mlstm_task(p, task, smem);
  }
}

__device__ __forceinline__ void phase_mix(const P& p) {
  const int wave = threadIdx.x >> 6, lane = threadIdx.x & 63;
  for (int t = blockIdx.x * 8 + wave; t < T; t += gridDim.x * 8) {
    const u16* pr = p.proj + (size_t)t * NPROJ;
    const int seg = t < TCTX ? 256 : 64;
    const int pos = (t < TCTX ? t : t - TCTX) & (seg - 1);
    const bool hasL = pos > 0, hasR = pos < seg - 1;
    const int c0 = lane * 8;
    const uint4 zero4 = make_uint4(0u, 0u, 0u, 0u);
    const uint4 bg = *(const uint4*)&pr[c0];
    const uint4 cgC = *(const uint4*)&pr[512 + c0];
    const uint4 xgC = *(const uint4*)&pr[1024 + c0];
    const uint4 cgL = hasL ? *(const uint4*)&pr[-NPROJ + 512 + c0] : zero4;
    const uint4 xgL = hasL ? *(const uint4*)&pr[-NPROJ + 1024 + c0] : zero4;
    const uint4 cgR = hasR ? *(const uint4*)&pr[NPROJ + 512 + c0] : zero4;
    const uint4 xgR = hasR ? *(const uint4*)&pr[NPROJ + 1024 + c0] : zero4;
    const unsigned bgw[4] = {bg.x, bg.y, bg.z, bg.w};
    const unsigned cC[4] = {cgC.x, cgC.y, cgC.z, cgC.w}, xC[4] = {xgC.x, xgC.y, xgC.z, xgC.w};
    const unsigned cL[4] = {cgL.x, cgL.y, cgL.z, cgL.w}, xL[4] = {xgL.x, xgL.y, xgL.z, xgL.w};
    const unsigned cR[4] = {cgR.x, cgR.y, cgR.z, cgR.w}, xR[4] = {xgR.x, xgR.y, xgR.z, xgR.w};
    unsigned ow[4];
#pragma unroll
    for (int j = 0; j < 4; ++j) {
      const int ch = c0 + 2 * j;
      float w0a = p.conv_w[ch], w1a = p.conv_w[512 + ch], w2a = p.conv_w[1024 + ch], ba = p.conv_b[ch];
      float w0b = p.conv_w[ch + 1], w1b = p.conv_w[512 + ch + 1], w2b = p.conv_w[1024 + ch + 1], bb = p.conv_b[ch + 1];
      float ya = w0a * (lo_f(cL[j]) * lo_f(xL[j])) + w1a * (lo_f(cC[j]) * lo_f(xC[j])) + w2a * (lo_f(cR[j]) * lo_f(xR[j])) + ba;
      float yb = w0b * (hi_f(cL[j]) * hi_f(xL[j])) + w1b * (hi_f(cC[j]) * hi_f(xC[j])) + w2b * (hi_f(cR[j]) * hi_f(xR[j])) + bb;
      ow[j] = pack2(lo_f(bgw[j]) * ya, hi_f(bgw[j]) * yb);
    }
    *(uint4*)&p.hbuf[(size_t)t * D + c0] = make_uint4(ow[0], ow[1], ow[2], ow[3]);
    const float* hf = p.out + (size_t)t * 512 + c0;
    const float* hb = p.out + (size_t)T * 512 + (size_t)t * 512 + c0;
    const float4 f0 = *(const float4*)&hf[0], f1 = *(const float4*)&hf[4];
    const float4 b0 = *(const float4*)&hb[0], b1 = *(const float4*)&hb[4];
    float h[8] = {f0.x + b0.x, f0.y + b0.y, f0.z + b0.z, f0.w + b0.w, f1.x + b1.x, f1.y + b1.y, f1.z + b1.z, f1.w + b1.w};
    float ss = 0.f;
#pragma unroll
    for (int j = 0; j < 8; ++j) ss += h[j] * h[j];
    ss += __shfl_xor(ss, 1); ss += __shfl_xor(ss, 2); ss += __shfl_xor(ss, 4); ss += __shfl_xor(ss, 8);
    const float r = rsqrtf(ss * (1.f / 128.f) + EPS);
    const uint4 og = *(const uint4*)&pr[3072 + c0];
    const unsigned ogw[4] = {og.x, og.y, og.z, og.w};
    unsigned mw[4];
#pragma unroll
    for (int j = 0; j < 4; ++j) {
      float ga = p.g_mlstm[c0 + 2 * j], gb = p.g_mlstm[c0 + 2 * j + 1];
      float oa = lo_f(ogw[j]), ob = hi_f(ogw[j]);
      float sa_ = 1.f / (1.f + expf(-oa)), sb_ = 1.f / (1.f + expf(-ob));
      mw[j] = pack2(h[2 * j] * r * ga * sa_, h[2 * j + 1] * r * gb * sb_);
    }
    *(uint4*)&p.hbuf[(size_t)t * D + 512 + c0] = make_uint4(mw[0], mw[1], mw[2], mw[3]);
  }
}

__device__ __forceinline__ unsigned f2key(float f) {
  const unsigned u = __float_as_uint(f);
  return (u & 0x80000000u) ? ~u : (u | 0x80000000u);
}
__device__ __forceinline__ float key2f(unsigned k, unsigned mask) {
  const unsigned m = k & ~mask;
  const unsigned u = (m & 0x80000000u) ? (m & 0x7fffffffu) : ~m;
  return __uint_as_float(u);
}
#define KINSERT(LIST, KEY)                                   \
  {                                                          \
    unsigned kk_ = (KEY);                                    \
    _Pragma("unroll") for (int j_ = 0; j_ < 16; ++j_) {      \
      const unsigned hi_ = max(LIST[j_], kk_);               \
      kk_ = min(LIST[j_], kk_);                              \
      LIST[j_] = hi_;                                        \
    }                                                        \
  }
#define SBAR __builtin_amdgcn_sched_barrier(0)
__device__ __forceinline__ int launder(int v) { asm volatile("" : "+v"(v)); return v; }
#define G_ISSUE(BUF, TAB, IDS)                                                 \
  _Pragma("unroll") for (int i_ = 0; i_ < 16; ++i_) {                          \
    const int e_ = __builtin_amdgcn_readlane(IDS, i_);                         \
    BUF[i_] = *(const uint4*)&(TAB)[(size_t)e_ * D + lane * 16];               \
  }
#define U_DW(DW, J)                                                                        \
  acc_ = __builtin_elementwise_fma(__builtin_amdgcn_cvt_pk_f32_fp8(DW, false), hp[2 * (J)], acc_);      \
  acc_ = __builtin_elementwise_fma(__builtin_amdgcn_cvt_pk_f32_fp8(DW, true), hp[2 * (J) + 1], acc_);
#define G_DOTU(BUF)                                                            \
  _Pragma("unroll") for (int i_ = 0; i_ < 16; ++i_) {                          \
    f2v acc_ = (f2v){0.f, 0.f};                                                \
    U_DW(BUF[i_].x, 0) U_DW(BUF[i_].y, 1) U_DW(BUF[i_].z, 2) U_DW(BUF[i_].w, 3) \
    pa[i_] = acc_.x + acc_.y;                                                  \
  }
#define V_DW(DW, J)                                                                        \
  o2[2 * (J)] = __builtin_elementwise_fma(__builtin_amdgcn_cvt_pk_f32_fp8(DW, false), wv_, o2[2 * (J)]);      \
  o2[2 * (J) + 1] = __builtin_elementwise_fma(__builtin_amdgcn_cvt_pk_f32_fp8(DW, true), wv_, o2[2 * (J) + 1]);
#define G_ACCV(BUF)                                                            \
  _Pragma("unroll") for (int i_ = 0; i_ < 16; ++i_) {                          \
    const float w_ = __int_as_float(__builtin_amdgcn_readlane(wbits, i_));     \
    const f2v wv_ = (f2v){w_, w_};                                             \
    V_DW(BUF[i_].x, 0) V_DW(BUF[i_].y, 1) V_DW(BUF[i_].z, 2) V_DW(BUF[i_].w, 3) \
  }

__device__ __forceinline__ void phase_peer(const P& p, char* smem) {
  unsigned* sc = (unsigned*)smem;
  unsigned* skey = sc + 256 * 130;
  int* sE = (int*)sc;
  float* sG = (float*)(sc + 2048);
  for (int it = blockIdx.x; it < T / 16; it += gridDim.x) {
    const int t0 = it * 16;
    __syncthreads();
    {
      const int tid = launder(threadIdx.x), lane = tid & 63, wave = tid >> 6, l15 = lane & 15, quad = lane >> 4;
      const int half = wave >> 2;
      const u16* kb = p.kb + half * 16384;
#pragma unroll 1
      for (int hh = 0; hh < 2; ++hh) {
        const int head = (wave & 3) * 2 + hh;
        bf16x8 qf[4];
#pragma unroll
        for (int ks = 0; ks < 4; ++ks)
          qf[ks] = *(const bf16x8*)&p.qp[(size_t)(t0 + l15) * 2048 + head * 256 + half * 128 + ks * 32 + quad * 8];
        const int row = (head * 2 + half) * 16 + l15;
#pragma unroll 1
        for (int nt = 0; nt < 8; ++nt) {
          f32x4 acc = (f32x4){0.f, 0.f, 0.f, 0.f};
#pragma unroll
          for (int ks = 0; ks < 4; ++ks) {
            bf16x8 kf = *(const bf16x8*)&kb[(nt * 16 + l15) * 128 + ks * 32 + quad * 8];
            acc = mfma16(kf, qf[ks], acc);
          }
          const int key = nt * 16 + quad * 4;
          const int pos = key + (key >= 64 ? 1 : 0);
#pragma unroll
          for (int r = 0; r < 4; ++r) sc[row * 130 + pos + r] = (f2key(acc[r]) & ~0x7Fu) | (unsigned)(127 - (key + r));
        }
      }
    }
    __syncthreads();
    {
      const int tid = launder(threadIdx.x);
      const int row = tid >> 1, hs = tid & 1;
      const unsigned* src = sc + row * 130 + hs * 65;
      unsigned list[16];
#pragma unroll
      for (int j = 0; j < 16; ++j) list[j] = 0u;
#pragma unroll 1
      for (int k0 = 0; k0 < 64; k0 += 8) {
#pragma unroll
        for (int k = 0; k < 8; ++k) KINSERT(list, src[k0 + k])
      }
      unsigned other[16];
#pragma unroll
      for (int j = 0; j < 16; ++j) other[j] = __shfl_xor(list[j], 1);
#pragma unroll
      for (int j = 0; j < 16; ++j) KINSERT(list, other[j])
      if (hs == 0) {
#pragma unroll
        for (int j = 0; j < 16; ++j) skey[row * 16 + j] = list[j];
      }
    }
    __syncthreads();
    if (threadIdx.x < 128) {
      const int tid = launder(threadIdx.x);
      const int tok = tid & 15, head = tid >> 4;
      const int ra = (head * 2) * 16 + tok, rb = ra + 16;
      float v1[16], v2[16];
#pragma unroll
      for (int a = 0; a < 16; ++a) { v1[a] = key2f(skey[ra * 16 + a], 0x7Fu); v2[a] = key2f(skey[rb * 16 + a], 0x7Fu); }
      unsigned list[16];
#pragma unroll
      for (int j = 0; j < 16; ++j) list[j] = 0u;
#pragma unroll
      for (int a = 0; a < 16; ++a) {
#pragma unroll
        for (int b = 0; b < 16; ++b) {
          if ((a + 1) * (b + 1) <= 16) {
            const unsigned key = (f2key(v1[a] + v2[b]) & ~0xFFu) | (unsigned)(255 - (a * 16 + b));
            KINSERT(list, key)
          }
        }
      }
      const float smax = key2f(list[0], 0xFFu);
      float ex[16];
      float se = 0.f;
#pragma unroll
      for (int q = 0; q < 16; ++q) { ex[q] = expf(key2f(list[q], 0xFFu) - smax); se += ex[q]; }
      const float inv = 1.f / se;
#pragma unroll
      for (int q = 0; q < 16; ++q) {
        const int flat = 255 - (int)(list[q] & 0xFFu);
        const int i1 = 127 - (int)(skey[ra * 16 + (flat >> 4)] & 0x7Fu);
        const int i2 = 127 - (int)(skey[rb * 16 + (flat & 15)] & 0x7Fu);
        sE[(tok * 8 + head) * 16 + q] = i1 * 128 + i2;
        sG[(tok * 8 + head) * 16 + q] = ex[q] * inv;
      }
    }
    __syncthreads();
#pragma unroll 1
    for (int tk = 0; tk < 2; ++tk) {
      const int tid = launder(threadIdx.x), lane = tid & 63, wave = tid >> 6, l15 = lane & 15;
      const int tok = wave * 2 + tk;
      const int t = t0 + tok;
      const u16* h2r = p.hbuf + (size_t)t * D;
      f2v hp[8];
      {
        const uint4 hx0 = *(const uint4*)&h2r[lane * 16];
        const uint4 hx1 = *(const uint4*)&h2r[lane * 16 + 8];
        hp[0] = (f2v){lo_f(hx0.x), hi_f(hx0.x)}; hp[1] = (f2v){lo_f(hx0.y), hi_f(hx0.y)};
        hp[2] = (f2v){lo_f(hx0.z), hi_f(hx0.z)}; hp[3] = (f2v){lo_f(hx0.w), hi_f(hx0.w)};
        hp[4] = (f2v){lo_f(hx1.x), hi_f(hx1.x)}; hp[5] = (f2v){lo_f(hx1.y), hi_f(hx1.y)};
        hp[6] = (f2v){lo_f(hx1.z), hi_f(hx1.z)}; hp[7] = (f2v){lo_f(hx1.w), hi_f(hx1.w)};
      }
      f2v o2[8];
#pragma unroll
      for (int j = 0; j < 8; ++j) o2[j] = (f2v){0.f, 0.f};
      uint4 A[16], B[16];
      int ids = sE[(tok * 8) * 16 + l15];
      G_ISSUE(A, p.ub8, ids)
      SBAR;
#pragma unroll 1
      for (int head = 0; head < 8; ++head) {
        const float gate = sG[(tok * 8 + head) * 16 + l15];
        const int ids_n = sE[(tok * 8 + ((head + 1) & 7)) * 16 + l15];
        const float sui = p.sinv[ids];
        const float svi = p.sinv[16384 + ids];
        float pa[16];
        G_ISSUE(B, p.vb8, ids)
        SBAR;
        G_DOTU(A)
        float q8[8], q4[4], q2[2], q1;
        {
          const bool b3 = (lane & 8) != 0;
#pragma unroll
          for (int i = 0; i < 8; ++i) {
            const float keep = b3 ? pa[i + 8] : pa[i];
            const float send = b3 ? pa[i] : pa[i + 8];
            q8[i] = keep + __shfl_xor(send, 8);
          }
          const bool b2 = (lane & 4) != 0;
#pragma unroll
          for (int i = 0; i < 4; ++i) {
            const float keep = b2 ? q8[i + 4] : q8[i];
            const float send = b2 ? q8[i] : q8[i + 4];
            q4[i] = keep + __shfl_xor(send, 4);
          }
          const bool b1 = (lane & 2) != 0;
#pragma unroll
          for (int i = 0; i < 2; ++i) {
            const float keep = b1 ? q4[i + 2] : q4[i];
            const float send = b1 ? q4[i] : q4[i + 2];
            q2[i] = keep + __shfl_xor(send, 2);
          }
          const bool b0 = (lane & 1) != 0;
          {
            const float keep = b0 ? q2[1] : q2[0];
            const float send = b0 ? q2[0] : q2[1];
            q1 = keep + __shfl_xor(send, 1);
          }
          q1 += __shfl_xor(q1, 16);
          q1 += __shfl_xor(q1, 32);
        }
        const float av = q1 * sui;
        const float ge = 0.5f * av * (1.f + erff(av * 0.7071067811865476f));
        const int wbits = __float_as_int(gate * ge * svi);
        SBAR;
        if (head < 7) { G_ISSUE(A, p.ub8, ids_n) }
        SBAR;
        G_ACCV(B)
        SBAR;
        ids = ids_n;
      }
      float o[16];
#pragma unroll
      for (int j = 0; j < 8; ++j) { o[2 * j] = o2[j].x; o[2 * j + 1] = o2[j].y; }
      const int ci = t < TCTX ? 0 : 1 + ((t - TCTX) >> 12);
      const float* ga2 = p.mod + ci * 6144 + 5 * 1024;
      float* xr = p.out + (size_t)t * D;
      float x2[16];
      float ss = 0.f;
#pragma unroll
      for (int q = 0; q < 4; ++q) {
        const int col = lane * 16 + q * 4;
        const float4 xa = *(const float4*)&xr[col];
        const float4 ga = *(const float4*)&ga2[col];
        x2[q * 4 + 0] = xa.x + ga.x * o[q * 4 + 0];
        x2[q * 4 + 1] = xa.y + ga.y * o[q * 4 + 1];
        x2[q * 4 + 2] = xa.z + ga.z * o[q * 4 + 2];
        x2[q * 4 + 3] = xa.w + ga.w * o[q * 4 + 3];
      }
#pragma unroll
      for (int j = 0; j < 16; ++j) ss += x2[j] * x2[j];
      ss = wave_sum(ss);
      const float rstd = rsqrtf(ss * (1.f / 1024.f) + EPS);
#pragma unroll
      for (int q = 0; q < 4; ++q) {
        const int col = lane * 16 + q * 4;
        const float4 g0 = *(const float4*)&p.g_final[col];
        *(float4*)&xr[col] = make_float4(x2[q * 4 + 0] * rstd * g0.x, x2[q * 4 + 1] * rstd * g0.y,
                                         x2[q * 4 + 2] * rstd * g0.z, x2[q * 4 + 3] * rstd * g0.w);
      }
    }
  }
}

#define XB_TMO      128
#define XB_XCNT(j)  (256  + 64 * (j))
#define XB_XSUB(j)  (1280 + 64 * (j))
#define XB_XGEN(j)  (2304 + 64 * (j))
#define XB_TOP      3328
#define XB_TOPGEN   3392
#define XCD_BAR_WORDS 3456
#define XB_SPIN_CAP (1u << 22)
#define LAS __attribute__((address_space(3)))
__device__ __forceinline__ unsigned xb_ld(unsigned* p) { return __hip_atomic_load(p, __ATOMIC_RELAXED, __HIP_MEMORY_SCOPE_AGENT); }
__device__ __forceinline__ unsigned xb_add(unsigned* p, unsigned v) { return __hip_atomic_fetch_add(p, v, __ATOMIC_RELAXED, __HIP_MEMORY_SCOPE_AGENT); }
__device__ __forceinline__ unsigned xb_xcc_id() { return (unsigned)__builtin_amdgcn_s_getreg((3 << 11) | 20) & 0xFu; }
#define XB_SPIN(cond, bar) do { unsigned _sp = 0; while (cond) { __builtin_amdgcn_s_sleep(1); \
    if ((++_sp & 255u) == 0u) { if (xb_ld(&(bar)[XB_TMO])) break; if (_sp > XB_SPIN_CAP) { atomicAdd(&(bar)[XB_TMO], 1u); break; } } } } while (0)
struct XcdBarrier { unsigned* bar; unsigned x; volatile LAS unsigned* st; };
__device__ __forceinline__ XcdBarrier xcd_barrier_post(unsigned* bar, volatile LAS unsigned* st) {
  XcdBarrier b; b.bar = bar; b.x = xb_xcc_id(); b.st = st;
  if (threadIdx.x == 0) (void)xb_add(&bar[XB_XCNT(b.x)], 1u);
  return b;
}
__device__ __forceinline__ void xcd_barrier_complete(unsigned* bar, unsigned x, unsigned& nloc, unsigned& nx) {
  const unsigned G = gridDim.x * gridDim.y * gridDim.z;
  unsigned sum, cnt, mine, sp = 0u;
  for (;;) {
    sum = 0u; cnt = 0u; mine = 0u;
#pragma unroll
    for (unsigned j = 0; j < 16; ++j) { const unsigned c = xb_ld(&bar[XB_XCNT(j)]); sum += c; cnt += (c > 0u) ? 1u : 0u; mine = (j == x) ? c : mine; }
    if (sum == G) break;
    __builtin_amdgcn_s_sleep(1);
    if ((++sp & 255u) == 0u) { if (xb_ld(&bar[XB_TMO])) break; if (sp > XB_SPIN_CAP) { atomicAdd(&bar[XB_TMO], 1u); break; } }
  }
  nloc = mine > 0u ? mine : 1u; nx = cnt > 0u ? cnt : 1u;
}
__device__ __forceinline__ void xcd_barrier(const XcdBarrier& b) {
  asm volatile("s_waitcnt vmcnt(0)" ::: "memory");
  __syncthreads();
  if (threadIdx.x == 0) {
    unsigned* bar = b.bar;
    __builtin_amdgcn_s_waitcnt(0);
    unsigned nloc = b.st[0], nx = b.st[1];
    if (nloc == 0u) { xcd_barrier_complete(bar, b.x, nloc, nx); b.st[0] = nloc; b.st[1] = nx; }
    const unsigned old = xb_add(&bar[XB_XSUB(b.x)], 1u);
    const unsigned gen = old / nloc;
    if (old + 1u == (gen + 1u) * nloc) {
      __builtin_amdgcn_fence(__ATOMIC_RELEASE, "agent");
      asm volatile("s_waitcnt vmcnt(0)" ::: "memory");
      const unsigned og = xb_add(&bar[XB_TOP], 1u);
      const unsigned tg = og / nx;
      if (og + 1u == (tg + 1u) * nx) xb_add(&bar[XB_TOPGEN], 1u);
      else XB_SPIN(xb_ld(&bar[XB_TOPGEN]) == tg, bar);
      __builtin_amdgcn_fence(__ATOMIC_ACQUIRE, "agent");
      xb_add(&bar[XB_XGEN(b.x)], 1u);
      asm volatile("s_waitcnt vmcnt(0)" ::: "memory");
    } else {
      XB_SPIN(xb_ld(&bar[XB_XGEN(b.x)]) == gen, bar);
      __builtin_amdgcn_fence(__ATOMIC_ACQUIRE, "agent");
      asm volatile("s_waitcnt vmcnt(0)" ::: "memory");
    }
  }
  __syncthreads();
}

__global__ void __launch_bounds__(NT) mega(P p, unsigned* bar, int use_cg) {
  extern __shared__ __attribute__((aligned(16))) char smem[];
  __shared__ uint4 xb_words;
  cg::grid_group grid = cg::this_grid();
  if (threadIdx.x == 0) xb_words = make_uint4(0u, 0u, 0u, 0u);
  __syncthreads();
  XcdBarrier xb = xcd_barrier_post(bar, (volatile LAS unsigned*)&xb_words);
#define SEAM() do { if (use_cg) grid.sync(); else xcd_barrier(xb); } while (0)
  phase_prep(p, smem);
  SEAM();
  phase_norm(p, 0);
  SEAM();
  gemm_phase<0>(p, p.hbuf, p.w_in_t, NPAD / 128, smem);
  SEAM();
  phase_mlstm(p, smem);
  SEAM();
  phase_mix(p);
  SEAM();
  gemm_phase<1>(p, p.hbuf, p.w_out_t, 1024 / 128, smem);
  SEAM();
  phase_norm(p, 1);
  convert_tables(p);
  SEAM();
  gemm_phase<2>(p, p.hbuf, p.wq_t, 2048 / 128, smem);
  SEAM();
  phase_peer(p, smem);
}

extern "C" void kernel_launch(void* const* d_in, const int* in_sizes, int n_in, void* d_out, int out_size,
                              void* d_ws, size_t ws_size, hipStream_t stream) {
  P p{};
  const float* const* in = (const float* const*)d_in;
  p.x_prompt = in[0]; p.x_sample = in[1]; p.state_C = in[2]; p.state_n = in[3]; p.state_m = in[4];
  p.c = in[5]; p.c_ctx = in[6]; p.w_ada = in[7]; p.b_ada = in[8]; p.g_norm1 = in[9]; p.w_in = in[10];
  p.b_igate = in[11]; p.b_fgate = in[12]; p.conv_w = in[13]; p.conv_b = in[14]; p.g_mlstm = in[15];
  p.w_out = in[16]; p.g_norm2 = in[17]; p.wq = in[18]; p.k1 = in[19]; p.k2 = in[20]; p.u = in[21]; p.v = in[22];
  p.g_final = in[23];
  p.out = (float*)d_out;
  char* ws = (char*)d_ws;
  size_t off = 0;
  auto take = [&](size_t bytes) { char* r = ws + off; off += (bytes + 255) & ~(size_t)255; return r; };
  p.mod = (float*)take(5 * 6144 * 4);
  p.w_in_t = (u16*)take((size_t)NPAD * 1024 * 2);
  p.w_out_t = (u16*)take((size_t)1024 * 1024 * 2);
  p.wq_t = (u16*)take((size_t)2048 * 1024 * 2);
  p.kb = (u16*)take(2 * 16384 * 2);
  p.gates = (float*)take((size_t)T * 16 * 4);
  p.hbuf = (u16*)take((size_t)T * D * 2);
  p.proj = (u16*)take((size_t)T * NPROJ * 2);
  p.qp = p.proj;
  p.ub8 = (unsigned char*)(p.proj + (size_t)T * 2048);
  p.vb8 = p.ub8 + (size_t)16384 * 1024;
  p.sinv = (float*)(p.vb8 + (size_t)16384 * 1024);

  unsigned* bar = (unsigned*)take(XCD_BAR_WORDS * 4);
  (void)hipMemsetAsync(bar, 0, XCD_BAR_WORDS * 4, stream);
  (void)hipFuncSetAttribute((const void*)mega, hipFuncAttributeMaxDynamicSharedMemorySize, LDS_BYTES);
  int dev = 0, cus = 0, per = 0;
  (void)hipGetDevice(&dev);
  (void)hipDeviceGetAttribute(&cus, hipDeviceAttributeMultiprocessorCount, dev);
  (void)hipOccupancyMaxActiveBlocksPerMultiprocessor(&per, (const void*)mega, NT, LDS_BYTES);
  if (per < 1 || cus < 1) { fprintf(stderr, "occupancy query: %d blocks/CU on %d CUs\n", per, cus); }
  const int grid = cus;
  int use_cg = 0;
  void* args[] = {&p, &bar, &use_cg};
  hipError_t e = hipLaunchCooperativeKernel((const void*)mega, dim3(grid), dim3(NT), args, LDS_BYTES, stream);
  if (e != hipSuccess) fprintf(stderr, "cooperative launch failed: %s (grid %d)\n", hipGetErrorString(e), grid);
}
```

```cpp
#include <hip/hip_runtime.h>
#include <hip/hip_cooperative_groups.h>
#include <cstdio>
#include <cstdint>
namespace cg = cooperative_groups;

typedef unsigned short u16;
typedef __attribute__((ext_vector_type(8))) short bf16x8;
typedef __attribute__((ext_vector_type(4))) float f32x4;
typedef __attribute__((ext_vector_type(2))) __bf16 bf2_t;
typedef __attribute__((ext_vector_type(2))) float f2v;
typedef __attribute__((ext_vector_type(4))) short s16x4;
#define LAS __attribute__((address_space(3)))

constexpr int NT = 512;
constexpr int D = 1024;
constexpr int TCTX = 8192;
constexpr int TLAT = 16384;
constexpr int T = TCTX + TLAT;
constexpr int NPROJ = 3584;
constexpr int NPAD = 3840;
constexpr int LDS_BYTES = 256 * 130 * 4 + 256 * 16 * 4;
constexpr float EPS = 1e-6f;

struct P {
  const float *x_prompt, *x_sample, *state_C, *state_n, *state_m, *c, *c_ctx, *w_ada, *b_ada, *g_norm1, *w_in,
      *b_igate, *b_fgate, *conv_w, *conv_b, *g_mlstm, *w_out, *g_norm2, *wq, *k1, *k2, *u, *v, *g_final;
  float* out;
  float* mod;
  u16* w_in_t;
  u16* w_out_t;
  u16* wq_t;
  u16* kb;
  float* gates;
  u16* hbuf;
  u16* proj;
  u16* qp;
  unsigned char* ub8;
  unsigned char* vb8;
  float* sinv;
  float* wbuf;
  int* ibuf;
  float* scan;
  int conv_early;
  int pad_;
};

__device__ __forceinline__ u16 f2bf(float f) { return __builtin_bit_cast(u16, (__bf16)f); }
__device__ __forceinline__ float bf2f(u16 h) { return __uint_as_float(((unsigned)h) << 16); }
__device__ __forceinline__ unsigned pack2(float a, float b) {
  bf2_t v; v.x = (__bf16)a; v.y = (__bf16)b;
  return __builtin_bit_cast(unsigned, v);
}
__device__ __forceinline__ float lo_f(unsigned w) { return __uint_as_float(w << 16); }
__device__ __forceinline__ float hi_f(unsigned w) { return __uint_as_float(w & 0xffff0000u); }
__device__ __forceinline__ float wave_sum(float v) {
#pragma unroll
  for (int o = 32; o > 0; o >>= 1) v += __shfl_xor(v, o);
  return v;
}
__device__ __forceinline__ float dot2(unsigned a, unsigned b, float c) {
  return __builtin_amdgcn_fdot2_f32_bf16(__builtin_bit_cast(bf2_t, a), __builtin_bit_cast(bf2_t, b), c, false);
}
__device__ __forceinline__ float dot8(uint4 a, uint4 b, float c) {
  c = dot2(a.x, b.x, c); c = dot2(a.y, b.y, c); c = dot2(a.z, b.z, c); c = dot2(a.w, b.w, c);
  return c;
}
__device__ __forceinline__ f32x4 mfma16(bf16x8 a, bf16x8 b, f32x4 c) {
  return __builtin_amdgcn_mfma_f32_16x16x32_bf16(a, b, c, 0, 0, 0);
}

__device__ __forceinline__ void transpose_tile(const float* __restrict__ W, int Nreal, u16* __restrict__ Wt, int k0, int n0, float* tile) {
  const int tid = threadIdx.x;
#pragma unroll
  for (int i = 0; i < 8; ++i) {
    int idx = i * NT + tid;
    int kk = idx >> 6, nn = idx & 63;
    float v = (n0 + nn < Nreal) ? W[(size_t)(k0 + kk) * Nreal + n0 + nn] : 0.f;
    tile[kk * 65 + nn] = v;
  }
  __syncthreads();
  {
    const int nn = tid & 63, kg = tid >> 6;
    uint4 o;
    o.x = pack2(tile[(kg * 8 + 0) * 65 + nn], tile[(kg * 8 + 1) * 65 + nn]);
    o.y = pack2(tile[(kg * 8 + 2) * 65 + nn], tile[(kg * 8 + 3) * 65 + nn]);
    o.z = pack2(tile[(kg * 8 + 4) * 65 + nn], tile[(kg * 8 + 5) * 65 + nn]);
    o.w = pack2(tile[(kg * 8 + 6) * 65 + nn], tile[(kg * 8 + 7) * 65 + nn]);
    *(uint4*)&Wt[(size_t)(n0 + nn) * 1024 + k0 + kg * 8] = o;
  }
}

__device__ __forceinline__ void phase_prep(const P& p, char* smem) {
  const int tid = threadIdx.x;
  float* sf = (float*)smem;
  const int n_gemv = 384, n_tin = 16 * 60, n_tout = 16 * 16, n_tq = 16 * 32, n_k = 2;
  const int total = n_gemv + n_tin + n_tout + n_tq + n_k;
  (void)total;
  for (int it = blockIdx.x; it < n_gemv + n_tin; it += gridDim.x) {
    __syncthreads();
    if (it < n_gemv) {
      for (int i = tid; i < 5 * 1024; i += NT) {
        int ci = i >> 10, k = i & 1023;
        float cv = (ci == 0) ? p.c_ctx[k] : p.c[(ci - 1) * 1024 + k];
        sf[i] = cv / (1.f + expf(-cv));
      }
      __syncthreads();
      const int cl = tid & 3, kg = tid >> 2;
      const int col = it * 16 + cl * 4;
      float4 w[8];
#pragma unroll
      for (int kk = 0; kk < 8; ++kk) w[kk] = *(const float4*)&p.w_ada[(size_t)(kg * 8 + kk) * 6144 + col];
      float acc[5][4];
#pragma unroll
      for (int ci = 0; ci < 5; ++ci)
#pragma unroll
        for (int j = 0; j < 4; ++j) acc[ci][j] = 0.f;
#pragma unroll
      for (int kk = 0; kk < 8; ++kk) {
#pragma unroll
        for (int ci = 0; ci < 5; ++ci) {
          const float s = sf[ci * 1024 + kg * 8 + kk];
          acc[ci][0] += s * w[kk].x; acc[ci][1] += s * w[kk].y; acc[ci][2] += s * w[kk].z; acc[ci][3] += s * w[kk].w;
        }
      }
      float* red = sf + 5 * 1024;
#pragma unroll
      for (int ci = 0; ci < 5; ++ci)
#pragma unroll
        for (int j = 0; j < 4; ++j) red[(kg * 4 + cl) * 20 + ci * 4 + j] = acc[ci][j];
      __syncthreads();
      if (tid < 80) {
        const int ci = tid >> 4, cc = tid & 15;
        const int cl2 = cc >> 2, j = cc & 3;
        float s = 0.f;
        for (int g = 0; g < 128; ++g) s += red[(g * 4 + cl2) * 20 + ci * 4 + j];
        const int col2 = it * 16 + cc;
        p.mod[ci * 6144 + col2] = s + p.b_ada[col2];
      }
    } else if (it < n_gemv + n_tin) {
      int j = it - n_gemv;
      transpose_tile(p.w_in, 3600, p.w_in_t, (j / 60) * 64, (j % 60) * 64, sf);
    } else if (it < n_gemv + n_tin + n_tout) {
      int j = it - n_gemv - n_tin;
      transpose_tile(p.w_out, 1024, p.w_out_t, (j / 16) * 64, (j % 16) * 64, sf);
    } else if (it < n_gemv + n_tin + n_tout + n_tq) {
      int j = it - n_gemv - n_tin - n_tout;
      transpose_tile(p.wq, 2048, p.wq_t, (j / 32) * 64, (j % 32) * 64, sf);
    } else {
      int j = it - n_gemv - n_tin - n_tout - n_tq;
      const float* src = j ? p.k2 : p.k1;
      u16* dst = p.kb + j * 16384;
      for (int i = tid; i < 16384; i += NT) dst[i] = f2bf(src[i]);
    }
  }
}

__device__ __forceinline__ void phase_prep_late(const P& p, char* smem, int bi, int nb) {
  const int tid = threadIdx.x;
  float* sf = (float*)smem;
  const int n_tout = 16 * 16, n_tq = 16 * 32, n_k = 2;
  for (int it = bi; it < n_tout + n_tq + n_k; it += nb) {
    __syncthreads();
    if (it < n_tout) {
      transpose_tile(p.w_out, 1024, p.w_out_t, (it / 16) * 64, (it % 16) * 64, sf);
    } else if (it < n_tout + n_tq) {
      const int j = it - n_tout;
      transpose_tile(p.wq, 2048, p.wq_t, (j / 32) * 64, (j % 32) * 64, sf);
    } else {
      const int j = it - n_tout - n_tq;
      const float* src = j ? p.k2 : p.k1;
      u16* dst = p.kb + j * 16384;
      for (int i = tid; i < 16384; i += NT) dst[i] = f2bf(src[i]);
    }
  }
}

__device__ __forceinline__ void phase_norm(const P& p, int which) {
  const int wave = threadIdx.x >> 6, lane = threadIdx.x & 63;
  for (int t = blockIdx.x * 8 + wave; t < T; t += gridDim.x * 8) {
    const float* xr = which ? (p.out + (size_t)t * D)
                            : (t < TCTX ? p.x_prompt + (size_t)t * D : p.x_sample + (size_t)(t - TCTX) * D);
    const int ci = t < TCTX ? 0 : 1 + ((t - TCTX) >> 12);
    const float* md = p.mod + ci * 6144 + (which ? 3 * 1024 : 0);
    const float* g = which ? p.g_norm2 : p.g_norm1;
    float4 xv[4];
    float ss = 0.f;
#pragma unroll
    for (int i = 0; i < 4; ++i) {
      xv[i] = *(const float4*)&xr[(i >> 1) * 512 + lane * 8 + (i & 1) * 4];
      ss += xv[i].x * xv[i].x + xv[i].y * xv[i].y + xv[i].z * xv[i].z + xv[i].w * xv[i].w;
    }
    ss = wave_sum(ss);
    const float rstd = rsqrtf(ss * (1.f / 1024.f) + EPS);
    unsigned ow[8];
#pragma unroll
    for (int i = 0; i < 4; ++i) {
      const int col = (i >> 1) * 512 + lane * 8 + (i & 1) * 4;
      const float4 g4 = *(const float4*)&g[col];
      const float4 sh = *(const float4*)&md[col];
      const float4 sc = *(const float4*)&md[1024 + col];
      const float h0 = xv[i].x * rstd * g4.x * (1.f + sc.x) + sh.x;
      const float h1 = xv[i].y * rstd * g4.y * (1.f + sc.y) + sh.y;
      const float h2 = xv[i].z * rstd * g4.z * (1.f + sc.z) + sh.z;
      const float h3 = xv[i].w * rstd * g4.w * (1.f + sc.w) + sh.w;
      ow[i * 2] = pack2(h0, h1); ow[i * 2 + 1] = pack2(h2, h3);
    }
    *(uint4*)&p.hbuf[(size_t)t * D + lane * 8] = make_uint4(ow[0], ow[1], ow[2], ow[3]);
    *(uint4*)&p.hbuf[(size_t)t * D + 512 + lane * 8] = make_uint4(ow[4], ow[5], ow[6], ow[7]);
  }
}

__device__ __forceinline__ void convert_tables(const P& p, int bi, int nb) {
  const int wave = threadIdx.x >> 6, lane = threadIdx.x & 63;
  for (int row = bi * 8 + wave; row < 32768; row += nb * 8) {
    const float* src = row < 16384 ? p.u + (size_t)row * D : p.v + (size_t)(row - 16384) * D;
    unsigned char* dst = row < 16384 ? p.ub8 + (size_t)row * D : p.vb8 + (size_t)(row - 16384) * D;
    float4 f[4];
    float amax = 0.f;
#pragma unroll
    for (int i = 0; i < 4; ++i) {
      f[i] = *(const float4*)&src[lane * 16 + i * 4];
      amax = fmaxf(amax, fmaxf(fmaxf(fabsf(f[i].x), fabsf(f[i].y)), fmaxf(fabsf(f[i].z), fabsf(f[i].w))));
    }
#pragma unroll
    for (int o = 32; o > 0; o >>= 1) amax = fmaxf(amax, __shfl_xor(amax, o));
    const float sc = amax > 0.f ? 384.f / amax : 1.f;
    const float inv = amax > 0.f ? amax * (1.f / 384.f) : 1.f;
    unsigned w[4];
#pragma unroll
    for (int i = 0; i < 4; ++i) {
      unsigned pk = 0u;
      pk = __builtin_amdgcn_cvt_pk_fp8_f32(f[i].x * sc, f[i].y * sc, pk, false);
      pk = __builtin_amdgcn_cvt_pk_fp8_f32(f[i].z * sc, f[i].w * sc, pk, true);
      w[i] = pk;
    }
    *(uint4*)&dst[lane * 16] = make_uint4(w[0], w[1], w[2], w[3]);
    if (lane == 0) p.sinv[row] = inv;
  }
}

namespace pg8 {
#define PG8_LAS __attribute__((address_space(3)))
typedef unsigned short bf16_t;
typedef short bf16x8 __attribute__((ext_vector_type(8)));
typedef float f32x4 __attribute__((ext_vector_type(4)));
typedef unsigned u32x4 __attribute__((ext_vector_type(4)));
constexpr int BM = 256, BK = 64, HALF = 128, HTB = HALF * BK * 2  , STAGE_BYTES = 8 * HTB, NXCD = 8, WGM = 8;

__host__ __device__ __forceinline__ int lds_byte(int r, int c) { const int st = (r >> 4) * 2 + (c >> 5), rr = r & 15, cc = c & 31, ob = rr * 64 + cc * 2; return st * 1024 + (ob ^ (((ob >> 9) & 1) << 5)); }
__host__ __device__ __forceinline__ void stage_rc(int b, int& R, int& C) { const int st = b / 1024, sb = b % 1024, swz = sb ^ (((sb >> 9) & 1) << 5); R = (st >> 1) * 16 + swz / 64; C = (st & 1) * 32 + (swz % 64) / 2; }
__host__ __device__ __forceinline__ int perm32(int rho) { const int n = rho >> 4, i = rho & 15; return 8 * (i >> 2) + 4 * n + (i & 3); }

struct Unit { int pm, pn; };
struct Gemm { const bf16_t* A; const bf16_t* Bt; int M, N, K; };

struct StaticOrder {
    int nM, nN, nwg, G, c;
    __host__ __device__ void init(int M, int N, int G_, int c_) { nM = M / BM; nN = N / BM; nwg = nM * nN; G = G_; c = c_; }
    __host__ __device__ bool next(int i, Unit& u) const {
        const long L = (long)i * G + c; if (L >= nwg) return false;
        int wgid = (int)L; { const int q = nwg / NXCD, r = nwg % NXCD, xcd = wgid % NXCD, off = wgid / NXCD; wgid = (xcd < r ? xcd * (q + 1) : r * (q + 1) + (xcd - r) * q) + off; }
        const int nig = WGM * nN, gid = wgid / nig, fm = gid * WGM, gsz = (nM - fm) < WGM ? (nM - fm) : WGM;
        u.pm = fm + ((wgid % nig) % gsz); u.pn = (wgid % nig) / gsz; return true;
    }
    __device__ __forceinline__ void a_ready(const Unit&) const {}
    __device__ __forceinline__ void done(const Unit&) const {}
};

template <class Epi, class Sched, bool STAMP = false>
__device__ __forceinline__ void gemm_phase(PG8_LAS unsigned char* lds, const Gemm g, const Sched& S, const Epi& E, unsigned long long* stamps) {
    const int tid = threadIdx.x, wid = __builtin_amdgcn_readfirstlane(tid >> 6), lane = tid & 63, wr = wid >> 2, wc = wid & 3, fr = lane & 15, fq = lane >> 4;
    const int K = g.K, nt = K / BK;
    int ts_lo = 0, ts_hi = 0, nts = 0; const unsigned long long rt_entry = STAMP ? (unsigned long long)wall_clock64() : 0ull;
#define PG8_STAMP() do { if (STAMP && wid == 0 && nts < 64) { const unsigned long long _c = (unsigned long long)clock64(); \
        ts_lo = (lane == nts) ? (int)(unsigned)_c : ts_lo; ts_hi = (lane == nts) ? (int)(unsigned)(_c >> 32) : ts_hi; ++nts; } } while (0)
    PG8_STAMP();
    unsigned voffA[2], voffB[2];
#pragma unroll
    for (int i = 0; i < 2; ++i) { int R, C; stage_rc(tid * 16 + i * 8192, R, C); const int Rb = Epi::PERM ? ((R & ~31) + perm32(R & 31)) : R;
        voffA[i] = (unsigned)(R * K + C) * 2u; voffB[i] = (unsigned)(Rb * K + C) * 2u; }
    const size_t kstep = (size_t)(BK * 2);
    const size_t hstep = (size_t)HALF * K * 2;
    const size_t tstep = 2 * hstep;
    const unsigned ldsw = (unsigned)wid * 1024u;
    const int aoff = lds_byte(wr * 64 + fr, fq * 8), boff = lds_byte(wc * 32 + fr, fq * 8);
#define PG8_SA(b, h) (((b) * 2 + (h)) * HTB)
#define PG8_SB(b, h) ((4 + (b) * 2 + (h)) * HTB)
#define PG8_STAGE(bufoff, gbase, voff) do { _Pragma("unroll") for (int _i = 0; _i < 2; ++_i) \
        __builtin_amdgcn_global_load_lds((const unsigned*)((const char*)(gbase) + (voff)[_i]), (PG8_LAS unsigned*)(lds + (bufoff) + ldsw + _i * 8192), 16, 0, 0); } while (0)
#define PG8_LDA(dst, b, h) do { _Pragma("unroll") for (int m = 0; m < 4; ++m) _Pragma("unroll") for (int k = 0; k < 2; ++k) dst[m][k] = *(const PG8_LAS bf16x8*)(lds + PG8_SA(b, h) + aoff + m * 2048 + k * 1024); } while (0)
#define PG8_LDB(dst, b, h) do { _Pragma("unroll") for (int n = 0; n < 2; ++n) _Pragma("unroll") for (int k = 0; k < 2; ++k) dst[n][k] = *(const PG8_LAS bf16x8*)(lds + PG8_SB(b, h) + boff + n * 2048 + k * 1024); } while (0)
#define PG8_MMA(ai, bj, At, Bt) do { __builtin_amdgcn_s_setprio(1); _Pragma("unroll") for (int m = 0; m < 4; ++m) _Pragma("unroll") for (int n = 0; n < 2; ++n) _Pragma("unroll") for (int k = 0; k < 2; ++k) \
        acc[ai][bj][m][n] = __builtin_amdgcn_mfma_f32_16x16x32_bf16(Bt[n][k], At[m][k], acc[ai][bj][m][n], 0, 0, 0); __builtin_amdgcn_s_setprio(0); } while (0)
#define PG8_WAIT_V(n) asm volatile("s_waitcnt vmcnt(" #n ")" ::: "memory")
#define PG8_WAIT_L(n) asm volatile("s_waitcnt lgkmcnt(" #n ")" ::: "memory")
#define PG8_BAR __builtin_amdgcn_s_barrier()
#define PG8_SCHED __builtin_amdgcn_sched_barrier(0)
    Unit cur, nxt; int ui = 0;
    if (!S.next(0, cur)) return;
    f32x4 acc[2][2][4][2];
#pragma unroll
    for (int a = 0; a < 2; ++a)
#pragma unroll
        for (int b = 0; b < 2; ++b)
#pragma unroll
            for (int m = 0; m < 4; ++m)
#pragma unroll
                for (int n = 0; n < 2; ++n) acc[a][b][m][n] = (f32x4){0.f, 0.f, 0.f, 0.f};
    bf16x8 At[4][2], B0[2][2], B1[2][2];
    const char* cA = (const char*)g.A + (size_t)cur.pm * tstep; const char* cB = (const char*)g.Bt + (size_t)cur.pn * tstep;
    S.a_ready(cur);
    PG8_STAGE(PG8_SB(0, 0), cB, voffB); PG8_STAGE(PG8_SA(0, 0), cA, voffA); PG8_STAGE(PG8_SB(0, 1), cB + hstep, voffB); PG8_STAGE(PG8_SA(0, 1), cA + hstep, voffA);
    if (wr == 1) PG8_BAR;
    PG8_WAIT_V(4); PG8_BAR;
    PG8_STAGE(PG8_SB(1, 0), cB + kstep, voffB); PG8_STAGE(PG8_SA(1, 0), cA + kstep, voffA); PG8_STAGE(PG8_SB(1, 1), cB + hstep + kstep, voffB);
    PG8_WAIT_V(6); PG8_BAR;
    PG8_STAMP();
    for (;;) {
        const bool has_next = S.next(ui + 1, nxt);
        const char* nA = has_next ? (const char*)g.A + (size_t)nxt.pm * tstep : cA; const char* nB = has_next ? (const char*)g.Bt + (size_t)nxt.pn * tstep : cB;
        for (int t = 0; t < nt; t += 2) {
            const bool last = (t == nt - 2);
            const char* a1 = cA + (size_t)(t + 1) * kstep;
            const char* a2 = last ? nA : cA + (size_t)(t + 2) * kstep; const char* b2 = last ? nB : cB + (size_t)(t + 2) * kstep;
            const char* a3 = a2 + kstep; const char* b3 = b2 + kstep;
            if (last && has_next) S.a_ready(nxt);
            PG8_LDB(B0, 0, 0); PG8_SCHED; PG8_LDA(At, 0, 0); PG8_STAGE(PG8_SA(1, 1), a1 + hstep, voffA);
            PG8_WAIT_L(8); PG8_BAR; PG8_WAIT_L(0); PG8_MMA(0, 0, At, B0); PG8_BAR; PG8_SCHED;
            PG8_LDB(B1, 0, 1); PG8_STAGE(PG8_SB(0, 0), b2, voffB);
            PG8_BAR; PG8_WAIT_L(0); PG8_MMA(0, 1, At, B1); PG8_BAR;
            PG8_LDA(At, 0, 1); PG8_STAGE(PG8_SA(0, 0), a2, voffA);
            PG8_BAR; PG8_WAIT_L(0); PG8_MMA(1, 0, At, B0); PG8_BAR; PG8_SCHED;
            PG8_STAGE(PG8_SB(0, 1), b2 + hstep, voffB);
            PG8_WAIT_V(6); PG8_BAR; PG8_MMA(1, 1, At, B1); PG8_BAR;
            PG8_LDB(B0, 1, 0); PG8_SCHED; PG8_LDA(At, 1, 0); PG8_STAGE(PG8_SA(0, 1), a2 + hstep, voffA);
            PG8_WAIT_L(8); PG8_BAR; PG8_WAIT_L(0); PG8_MMA(0, 0, At, B0); PG8_BAR; PG8_SCHED;
            PG8_LDB(B1, 1, 1); PG8_STAGE(PG8_SB(1, 0), b3, voffB);
            PG8_BAR; PG8_WAIT_L(0); PG8_MMA(0, 1, At, B1); PG8_BAR;
            PG8_LDA(At, 1, 1); PG8_STAGE(PG8_SA(1, 0), a3, voffA);
            PG8_BAR; PG8_WAIT_L(0); PG8_MMA(1, 0, At, B0); PG8_BAR; PG8_SCHED;
            PG8_STAGE(PG8_SB(1, 1), b3 + hstep, voffB);
            PG8_WAIT_V(6); PG8_BAR; PG8_MMA(1, 1, At, B1); PG8_BAR;
        }
        PG8_STAMP();
        if constexpr (!Epi::AFTER_DRAIN) { E(acc, cur, wr, wc, fr, fq); S.done(cur); }
        PG8_STAMP();
        if (!has_next) break;
#pragma unroll
        for (int a = 0; a < 2; ++a)
#pragma unroll
            for (int b = 0; b < 2; ++b)
#pragma unroll
                for (int m = 0; m < 4; ++m)
#pragma unroll
                    for (int n = 0; n < 2; ++n) acc[a][b][m][n] = (f32x4){0.f, 0.f, 0.f, 0.f};
        cur = nxt; cA = nA; cB = nB; ++ui;
    }
    PG8_WAIT_V(0);
    if (wr == 0) PG8_BAR;
    PG8_BAR;
    if constexpr (Epi::AFTER_DRAIN) { E.fused(acc, cur, wr, wc, fr, fq, lds, wid, lane); S.done(cur); }
    PG8_STAMP();
    if (STAMP && wid == 0) { stamps[lane] = lane < nts ? (((unsigned long long)(unsigned)ts_hi << 32) | (unsigned)ts_lo) : 0ull;
        if (lane == 62) stamps[62] = rt_entry; if (lane == 63) stamps[63] = (unsigned long long)wall_clock64(); }
#undef PG8_STAMP
#undef PG8_SA
#undef PG8_SB
#undef PG8_STAGE
#undef PG8_LDA
#undef PG8_LDB
#undef PG8_MMA
#undef PG8_WAIT_V
#undef PG8_WAIT_L
#undef PG8_BAR
#undef PG8_SCHED
}
}


struct EpiProj {
  static constexpr bool PERM = true, AFTER_DRAIN = false;
  u16* proj; float* gates;
  __device__ __forceinline__ void operator()(const pg8::f32x4 (&acc)[2][2][4][2], const pg8::Unit& u, int wr, int wc, int fr, int fq) const {
    const int row0 = u.pm * 256 + wr * 64 + fr, col0 = u.pn * 256 + wc * 32 + 8 * fq;
#pragma unroll
    for (int ai = 0; ai < 2; ++ai)
#pragma unroll
      for (int m = 0; m < 4; ++m) {
        const int row = row0 + ai * 128 + m * 16;
#pragma unroll
        for (int bj = 0; bj < 2; ++bj) {
          const int col = col0 + bj * 128;
          const pg8::f32x4 a = acc[ai][bj][m][0], b = acc[ai][bj][m][1];
          if (col < NPROJ) {
            uint4 o; o.x = pack2(a[0], a[1]); o.y = pack2(a[2], a[3]); o.z = pack2(b[0], b[1]); o.w = pack2(b[2], b[3]);
            *(uint4*)&proj[(size_t)row * NPROJ + col] = o;
          } else if (col < 3600) {
            *(float4*)&gates[(size_t)row * 16 + (col - NPROJ)] = make_float4(a[0], a[1], a[2], a[3]);
            *(float4*)&gates[(size_t)row * 16 + (col - NPROJ) + 4] = make_float4(b[0], b[1], b[2], b[3]);
          }
        }
      }
  }
};
struct EpiResid {
  static constexpr bool PERM = false, AFTER_DRAIN = false;
  const float* x_prompt; const float* x_sample; const float* mod; float* out;
  __device__ __forceinline__ void operator()(const pg8::f32x4 (&acc)[2][2][4][2], const pg8::Unit& u, int wr, int wc, int fr, int fq) const {
    const int row0 = u.pm * 256 + wr * 64 + fr, col0 = u.pn * 256 + wc * 32 + 4 * fq;
#pragma unroll
    for (int ai = 0; ai < 2; ++ai)
#pragma unroll
      for (int m = 0; m < 4; ++m) {
        const int row = row0 + ai * 128 + m * 16;
        const float* xr = row < TCTX ? x_prompt + (size_t)row * D : x_sample + (size_t)(row - TCTX) * D;
        const int ci = row < TCTX ? 0 : 1 + ((row - TCTX) >> 12);
#pragma unroll
        for (int bj = 0; bj < 2; ++bj)
#pragma unroll
          for (int n = 0; n < 2; ++n) {
            const int col = col0 + bj * 128 + n * 16;
            const pg8::f32x4 a = acc[ai][bj][m][n];
            const float4 xv = *(const float4*)&xr[col];
            const float4 ga = *(const float4*)&mod[ci * 6144 + 2 * 1024 + col];
            *(float4*)&out[(size_t)row * D + col] = make_float4(xv.x + ga.x * a[0], xv.y + ga.y * a[1], xv.z + ga.z * a[2], xv.w + ga.w * a[3]);
          }
      }
  }
};
struct EpiQ {
  static constexpr bool PERM = true, AFTER_DRAIN = false;
  u16* qp;
  __device__ __forceinline__ void operator()(const pg8::f32x4 (&acc)[2][2][4][2], const pg8::Unit& u, int wr, int wc, int fr, int fq) const {
    const int row0 = u.pm * 256 + wr * 64 + fr, col0 = u.pn * 256 + wc * 32 + 8 * fq;
#pragma unroll
    for (int ai = 0; ai < 2; ++ai)
#pragma unroll
      for (int m = 0; m < 4; ++m) {
        const int row = row0 + ai * 128 + m * 16;
#pragma unroll
        for (int bj = 0; bj < 2; ++bj) {
          const int col = col0 + bj * 128;
          const pg8::f32x4 a = acc[ai][bj][m][0], b = acc[ai][bj][m][1];
          uint4 o; o.x = pack2(a[0], a[1]); o.y = pack2(a[2], a[3]); o.z = pack2(b[0], b[1]); o.w = pack2(b[2], b[3]);
          *(uint4*)&qp[(size_t)row * 2048 + col] = o;
        }
      }
  }
};
template <class Epi>
__device__ __forceinline__ void gemm_run(const u16* A, const u16* Bt, int N, const Epi& E, char* smem) {
  pg8::Gemm g; g.A = A; g.Bt = Bt; g.M = T; g.N = N; g.K = 1024;
  pg8::StaticOrder S; S.init(T, N, (int)gridDim.x, (int)blockIdx.x);
  pg8::gemm_phase<Epi, pg8::StaticOrder, false>((PG8_LAS unsigned char*)smem, g, S, E, nullptr);
  __syncthreads();
}

__device__ __forceinline__ bf16x8 tr8(LAS u16* base, int e0, int e1) {
  const s16x4 lo = __builtin_amdgcn_ds_read_tr16_b64_v4i16((LAS s16x4*)(base + e0));
  const s16x4 hi = __builtin_amdgcn_ds_read_tr16_b64_v4i16((LAS s16x4*)(base + e1));
  return __builtin_shufflevector(lo, hi, 0, 1, 2, 3, 4, 5, 6, 7);
}
__device__ __forceinline__ void mlstm_task(const P& p, int task, char* smem) {
  const int tid = threadIdx.x, lane = tid & 63, wave = tid >> 6, l15 = lane & 15, quad = lane >> 4;
  const bool lat = task < 128;
  const int id = lat ? task : task - 128;
  const int slice = id & 3, dir = (id >> 2) & 1, head = (id >> 3) & 3, bat = id >> 5;
  const int tb = lat ? TCTX + bat * 4096 : bat * 256;
  const int L = lat ? 4096 : 256;
  const int nch = L >> 6;
  const int gcol = dir * 4 + head;
  const float scale = 0.08838834764831845f;

  u16* sQ = (u16*)smem;
  u16* sK = sQ + 2 * 64 * 136;
  u16* sKw = sK + 64 * 136;
  u16* sV = sKw + 2 * 64 * 136;
  u16* sS = sV + 2 * 64 * 40;
  u16* sCt = sS + 2 * 64 * 72;
  LAS u16* lds16 = (LAS u16*)smem;
  const int oKw = 2 * 64 * 136 + 64 * 136, oV = oKw + 2 * 64 * 136;
  float* fl = (float*)(sCt + 2 * 32 * 136);
  float* sg = fl;
  float* smm = fl + 64;
  float* sa = fl + 128;
  float* semt = fl + 256;
  float* sden = fl + 384;
  float* sqn = fl + 512;
  float* sN = fl + 576;
  float* sM = fl + 832;
  float* sMMT = fl + 904;
  float* sDecay = fl + 968;
  float* sBT = fl + 1032;
  float* sGT = fl + 1096;
  float* scn = p.scan + (size_t)blockIdx.x * 12288;

  const int sbase = (bat * 2 + dir) * 4 + head;
  const bool isP = wave < 4;
  const int cw = wave - 4;
  __syncthreads();
  {
    const float big = p.b_igate[gcol], bfg = p.b_fgate[gcol];
    for (int ch = wave; ch < nch; ch += 8) {
      const int posl = ch * 64 + lane;
      const int tl = tb + (dir ? (L - 1 - posl) : posl);
      const float ig = p.gates[(size_t)tl * 16 + gcol] + big;
      const float fr = p.gates[(size_t)tl * 16 + 8 + gcol] + bfg;
      const float lf = fminf(fr, 0.f) - log1pf(expf(-fabsf(fr)));
      float b = lf;
#pragma unroll
      for (int off = 1; off < 64; off <<= 1) { float v = __shfl_up(b, off); if (lane >= off) b += v; }
      const float g = ig - b;
      float G = g;
#pragma unroll
      for (int off = 1; off < 64; off <<= 1) { float v = __shfl_up(G, off); if (lane >= off) G = fmaxf(G, v); }
      scn[ch * 64 + lane] = b; scn[4096 + ch * 64 + lane] = g; scn[8192 + ch * 64 + lane] = G;
      if (lane == 63) { sBT[ch] = b; sGT[ch] = G; }
    }
  }
  f32x4 C[2][2];
#pragma unroll
  for (int a = 0; a < 2; ++a)
#pragma unroll
    for (int vt = 0; vt < 2; ++vt) C[a][vt] = (f32x4){0.f, 0.f, 0.f, 0.f};
  if (!isP) {
    if (lat) {
#pragma unroll
      for (int a = 0; a < 2; ++a)
#pragma unroll
        for (int vt = 0; vt < 2; ++vt)
#pragma unroll
          for (int r = 0; r < 4; ++r)
            C[a][vt][r] = p.state_C[(size_t)sbase * 16384 + ((2 * cw + a) * 16 + quad * 4 + r) * 128 + slice * 32 + vt * 16 + l15];
    }
    if (tid - 256 < 128) sN[tid - 256] = lat ? p.state_n[sbase * 128 + (tid - 256)] : 0.f;
#pragma unroll
    for (int a = 0; a < 2; ++a)
#pragma unroll
      for (int vt = 0; vt < 2; ++vt) {
        uint2 o; o.x = pack2(C[a][vt][0], C[a][vt][1]); o.y = pack2(C[a][vt][2], C[a][vt][3]);
        *(uint2*)&sCt[(vt * 16 + l15) * 136 + (2 * cw + a) * 16 + quad * 4] = o;
      }
  }
  __syncthreads();
  if (tid == 0) {
    float m = lat ? p.state_m[sbase] : 0.f;
    for (int c = 0; c < nch; ++c) {
      const float mmT = fmaxf(m, sGT[c]);
      sM[c] = m; sMMT[c] = mmT; sDecay[c] = __expf(m - mmT);
      m = sBT[c] + mmT;
    }
    sM[nch] = m;
  }
  const int s = (tid & 255) >> 2, part = tid & 3;
  uint4 rq0, rq1, rq2, rq3, rk0, rk1, rk2, rk3, rv; float rb = 0.f, rg = 0.f, rG = 0.f;
  rq0 = rq1 = rq2 = rq3 = rk0 = rk1 = rk2 = rk3 = rv = make_uint4(0u, 0u, 0u, 0u);
#define ML_LOAD(CH)                                                                        \
  {                                                                                        \
    const int poss_ = (CH) * 64 + s;                                                       \
    const int ts_ = tb + (dir ? (L - 1 - poss_) : poss_);                                  \
    const u16* prow_ = p.proj + (size_t)ts_ * NPROJ;                                       \
    rq0 = *(const uint4*)&prow_[1536 + head * 128 + part * 32];                            \
    rq1 = *(const uint4*)&prow_[1536 + head * 128 + part * 32 + 8];                        \
    rq2 = *(const uint4*)&prow_[1536 + head * 128 + part * 32 + 16];                       \
    rq3 = *(const uint4*)&prow_[1536 + head * 128 + part * 32 + 24];                       \
    rk0 = *(const uint4*)&prow_[2048 + head * 128 + part * 32];                            \
    rk1 = *(const uint4*)&prow_[2048 + head * 128 + part * 32 + 8];                        \
    rk2 = *(const uint4*)&prow_[2048 + head * 128 + part * 32 + 16];                       \
    rk3 = *(const uint4*)&prow_[2048 + head * 128 + part * 32 + 24];                       \
    rv = *(const uint4*)&prow_[2560 + head * 128 + slice * 32 + part * 8];                 \
    rb = scn[poss_]; rg = scn[4096 + poss_]; rG = scn[8192 + poss_];                       \
  }
  __syncthreads();
  if (isP) ML_LOAD(0)

  float* hout = p.out + (size_t)dir * T * 512;
  f32x4 aqc[2];
  aqc[0] = (f32x4){0.f, 0.f, 0.f, 0.f}; aqc[1] = (f32x4){0.f, 0.f, 0.f, 0.f};
  for (int c = -1; c < nch; ++c) {
    const int n = c + 1, q = n & 1, pz = c & 1;
    if (isP) {
      if (n < nch) {
        const float m_n = sM[n], mmT = sMMT[n];
        const float mm = fmaxf(m_n, rG);
        const float w = __expf(rg - mmT);
        if (part == 0) {
          sg[s] = rg; smm[s] = mm; sa[q * 64 + s] = __expf(m_n - mm); semt[q * 64 + s] = __expf(-(rb + mm)); sden[q * 64 + s] = 0.f;
        }
        u16* dQ = sQ + q * 64 * 136;
        u16* dKw = sKw + q * 64 * 136;
        u16* dV = sV + q * 64 * 40;
        *(uint4*)&dQ[s * 136 + part * 32] = rq0;
        *(uint4*)&dQ[s * 136 + part * 32 + 8] = rq1;
        *(uint4*)&dQ[s * 136 + part * 32 + 16] = rq2;
        *(uint4*)&dQ[s * 136 + part * 32 + 24] = rq3;
        *(uint4*)&sK[s * 136 + part * 32] = rk0;
        *(uint4*)&sK[s * 136 + part * 32 + 8] = rk1;
        *(uint4*)&sK[s * 136 + part * 32 + 16] = rk2;
        *(uint4*)&sK[s * 136 + part * 32 + 24] = rk3;
#define KW_(W) pack2(lo_f(W) * w, hi_f(W) * w)
        *(uint4*)&dKw[s * 136 + part * 32] = make_uint4(KW_(rk0.x), KW_(rk0.y), KW_(rk0.z), KW_(rk0.w));
        *(uint4*)&dKw[s * 136 + part * 32 + 8] = make_uint4(KW_(rk1.x), KW_(rk1.y), KW_(rk1.z), KW_(rk1.w));
        *(uint4*)&dKw[s * 136 + part * 32 + 16] = make_uint4(KW_(rk2.x), KW_(rk2.y), KW_(rk2.z), KW_(rk2.w));
        *(uint4*)&dKw[s * 136 + part * 32 + 24] = make_uint4(KW_(rk3.x), KW_(rk3.y), KW_(rk3.z), KW_(rk3.w));
#undef KW_
        *(uint4*)&dV[s * 40 + part * 8] = rv;
        if (n + 1 < nch) ML_LOAD(n + 1)
      }
    } else {
      if (c >= 0) {
        const int ctid = tid - 256;
        const u16* cQ = sQ + pz * 64 * 136;
        const int eKw = oKw + pz * 64 * 136, eV = oV + pz * 64 * 40;
        const int tq = l15 >> 2, tp = l15 & 3;
        const u16* cCt = sCt + pz * 32 * 136;
        u16* nCt = sCt + (pz ^ 1) * 32 * 136;
        const float* cN = sN + pz * 128;
        float* nN = sN + (pz ^ 1) * 128;
        {
          const int t = ctid >> 2, pt = ctid & 3;
          float qn = 0.f;
#pragma unroll
          for (int i = 0; i < 4; ++i) {
            const uint4 qv = *(const uint4*)&cQ[t * 136 + pt * 32 + i * 8];
            const float4 n0 = *(const float4*)&cN[pt * 32 + i * 8];
            const float4 n1 = *(const float4*)&cN[pt * 32 + i * 8 + 4];
            qn += lo_f(qv.x) * n0.x + hi_f(qv.x) * n0.y + lo_f(qv.y) * n0.z + hi_f(qv.y) * n0.w
                + lo_f(qv.z) * n1.x + hi_f(qv.z) * n1.y + lo_f(qv.w) * n1.z + hi_f(qv.w) * n1.w;
          }
          qn += __int_as_float(__builtin_amdgcn_update_dpp(0, __float_as_int(qn), 0xB1, 0xF, 0xF, true));
          qn += __int_as_float(__builtin_amdgcn_update_dpp(0, __float_as_int(qn), 0x4E, 0xF, 0xF, true));
          if (pt == 0) sqn[t] = qn * scale;
        }
        const int trow = cw * 16 + l15;
#pragma unroll
        for (int ti = 0; ti < 2; ++ti) {
          f32x4 acc = (f32x4){0.f, 0.f, 0.f, 0.f};
#pragma unroll
          for (int ks = 0; ks < 4; ++ks) {
            bf16x8 afr = *(const bf16x8*)&cCt[(ti * 16 + l15) * 136 + ks * 32 + quad * 8];
            bf16x8 bfr = *(const bf16x8*)&cQ[trow * 136 + ks * 32 + quad * 8];
            acc = mfma16(afr, bfr, acc);
          }
          aqc[ti] = acc;
        }
        const float decay = sDecay[c];
        const bf16x8 ones = (bf16x8){0x3F80, 0x3F80, 0x3F80, 0x3F80, 0x3F80, 0x3F80, 0x3F80, 0x3F80};
        bf16x8 vfr[2][2];
#pragma unroll
        for (int vt = 0; vt < 2; ++vt)
#pragma unroll
          for (int ks = 0; ks < 2; ++ks) {
            const int s0 = ks * 32 + quad * 8;
            vfr[vt][ks] = tr8(lds16, eV + (s0 + tq) * 40 + vt * 16 + 4 * tp, eV + (s0 + 4 + tq) * 40 + vt * 16 + 4 * tp);
          }
#pragma unroll
        for (int a = 0; a < 2; ++a) {
          const int kt = 2 * cw + a;
          bf16x8 kfr[2];
#pragma unroll
          for (int ks = 0; ks < 2; ++ks) {
            const int s0 = ks * 32 + quad * 8;
            kfr[ks] = tr8(lds16, eKw + (s0 + tq) * 136 + kt * 16 + 4 * tp, eKw + (s0 + 4 + tq) * 136 + kt * 16 + 4 * tp);
          }
          f32x4 accn = (f32x4){0.f, 0.f, 0.f, 0.f};
          accn = mfma16(kfr[0], ones, accn);
          accn = mfma16(kfr[1], ones, accn);
#pragma unroll
          for (int vt = 0; vt < 2; ++vt) {
            C[a][vt][0] *= decay; C[a][vt][1] *= decay; C[a][vt][2] *= decay; C[a][vt][3] *= decay;
            C[a][vt] = mfma16(kfr[0], vfr[vt][0], C[a][vt]);
            C[a][vt] = mfma16(kfr[1], vfr[vt][1], C[a][vt]);
            uint2 o; o.x = pack2(C[a][vt][0], C[a][vt][1]); o.y = pack2(C[a][vt][2], C[a][vt][3]);
            *(uint2*)&nCt[(vt * 16 + l15) * 136 + kt * 16 + quad * 4] = o;
          }
          if (l15 == 0) {
#pragma unroll
            for (int r = 0; r < 4; ++r) {
              const int idx = kt * 16 + quad * 4 + r;
              nN[idx] = decay * cN[idx] + accn[r];
            }
          }
        }
      }
    }
    asm volatile("s_waitcnt lgkmcnt(0)" ::: "memory"); __builtin_amdgcn_s_barrier(); asm volatile("" ::: "memory");
    if (isP) {
      if (n < nch) {
        const u16* dQ = sQ + q * 64 * 136;
        u16* dS = sS + q * 64 * 72;
        const int trow = wave * 16 + l15;
        const float mmt = smm[trow];
        float psum = 0.f;
#pragma unroll
        for (int si = 0; si < 4; ++si) {
          const int s0 = si * 16 + quad * 4;
          uint2 o = make_uint2(0u, 0u);
          if (si <= wave) {
            f32x4 acc = (f32x4){0.f, 0.f, 0.f, 0.f};
#pragma unroll
            for (int ks = 0; ks < 4; ++ks) {
              bf16x8 afr = *(const bf16x8*)&sK[(si * 16 + l15) * 136 + ks * 32 + quad * 8];
              bf16x8 bfr = *(const bf16x8*)&dQ[trow * 136 + ks * 32 + quad * 8];
              acc = mfma16(afr, bfr, acc);
            }
            float vals[4];
#pragma unroll
            for (int r = 0; r < 4; ++r) {
              const int sidx = s0 + r;
              const float e = __expf(fminf(sg[sidx] - mmt, 0.f));
              vals[r] = (sidx <= trow) ? acc[r] * scale * e : 0.f;
              psum += vals[r];
            }
            o.x = pack2(vals[0], vals[1]); o.y = pack2(vals[2], vals[3]);
          }
          *(uint2*)&dS[trow * 72 + s0] = o;
        }
        atomicAdd(&sden[q * 64 + trow], psum);
      }
    } else {
      if (c >= 0) {
        const int eV = oV + pz * 64 * 40;
        const int tq = l15 >> 2, tp = l15 & 3;
        const u16* cS = sS + pz * 64 * 72;
        const int trow = cw * 16 + l15;
        const float a_t = sa[pz * 64 + trow];
        const float den = a_t * sqn[trow] + sden[pz * 64 + trow];
        const float inv = 1.f / fmaxf(fabsf(den), semt[pz * 64 + trow]);
        const float as = a_t * scale;
        const int post = c * 64 + trow;
        const int tt = tb + (dir ? (L - 1 - post) : post);
#pragma unroll
        for (int ti = 0; ti < 2; ++ti) {
          f32x4 asv = (f32x4){0.f, 0.f, 0.f, 0.f};
#pragma unroll
          for (int ks = 0; ks < 2; ++ks) {
            const int s0 = ks * 32 + quad * 8;
            bf16x8 afr = tr8(lds16, eV + (s0 + tq) * 40 + ti * 16 + 4 * tp, eV + (s0 + 4 + tq) * 40 + ti * 16 + 4 * tp);
            bf16x8 bfr = *(const bf16x8*)&cS[trow * 72 + ks * 32 + quad * 8];
            asv = mfma16(afr, bfr, asv);
          }
          float4 h = make_float4((as * aqc[ti][0] + asv[0]) * inv, (as * aqc[ti][1] + asv[1]) * inv,
                                 (as * aqc[ti][2] + asv[2]) * inv, (as * aqc[ti][3] + asv[3]) * inv);
          *(float4*)&hout[(size_t)tt * 512 + head * 128 + slice * 32 + ti * 16 + quad * 4] = h;
        }
      }
    }
    asm volatile("s_waitcnt lgkmcnt(0)" ::: "memory"); __builtin_amdgcn_s_barrier(); asm volatile("" ::: "memory");
  }
#undef ML_LOAD
  if (!lat && !isP) {
    float* newC = p.out + (size_t)T * D;
    float* newn = newC + (size_t)32 * 2 * 4 * 128 * 128;
    float* newm = newn + 32 * 2 * 4 * 128;
#pragma unroll
    for (int a = 0; a < 2; ++a)
#pragma unroll
      for (int vt = 0; vt < 2; ++vt)
#pragma unroll
        for (int r = 0; r < 4; ++r)
          newC[(size_t)sbase * 16384 + ((2 * cw + a) * 16 + quad * 4 + r) * 128 + slice * 32 + vt * 16 + l15] = C[a][vt][r];
    if (slice == 0) {
      const int ctid = tid - 256;
      if (ctid < 128) newn[sbase * 128 + ctid] = sN[(nch & 1) * 128 + ctid];
      if (ctid == 0) newm[sbase] = sM[nch];
    }
  }
}

__device__ __forceinline__ void phase_mlstm(const P& p, char* smem) {
  const int G = gridDim.x, b = blockIdx.x;
  if (G >= 256) {
    if (b < 128) mlstm_task(p, b, smem);
    else {
      for (int task = b; task < 1152; task += G - 128) mlstm_task(p, task, smem);
      if (p.conv_early) convert_tables(p, b - 128, G - 128);
    }
  } else {
    for (int task = b; task < 1152; task += G) mlstm_task(p, task, smem);
    if (p.conv_early) convert_tables(p, b, G);
  }
}

__device__ __forceinline__ void phase_mix(const P& p) {
  const int wave = threadIdx.x >> 6, lane = threadIdx.x & 63;
  for (int t = blockIdx.x * 8 + wave; t < T; t += gridDim.x * 8) {
    const u16* pr = p.proj + (size_t)t * NPROJ;
    const int seg = t < TCTX ? 256 : 64;
    const int pos = (t < TCTX ? t : t - TCTX) & (seg - 1);
    const bool hasL = pos > 0, hasR = pos < seg - 1;
    const int c0 = lane * 8;
    const uint4 zero4 = make_uint4(0u, 0u, 0u, 0u);
    const uint4 bg = *(const uint4*)&pr[c0];
    const uint4 cgC = *(const uint4*)&pr[512 + c0];
    const uint4 xgC = *(const uint4*)&pr[1024 + c0];
    const uint4 cgL = hasL ? *(const uint4*)&pr[-NPROJ + 512 + c0] : zero4;
    const uint4 xgL = hasL ? *(const uint4*)&pr[-NPROJ + 1024 + c0] : zero4;
    const uint4 cgR = hasR ? *(const uint4*)&pr[NPROJ + 512 + c0] : zero4;
    const uint4 xgR = hasR ? *(const uint4*)&pr[NPROJ + 1024 + c0] : zero4;
    const unsigned bgw[4] = {bg.x, bg.y, bg.z, bg.w};
    const unsigned cC[4] = {cgC.x, cgC.y, cgC.z, cgC.w}, xC[4] = {xgC.x, xgC.y, xgC.z, xgC.w};
    const unsigned cL[4] = {cgL.x, cgL.y, cgL.z, cgL.w}, xL[4] = {xgL.x, xgL.y, xgL.z, xgL.w};
    const unsigned cR[4] = {cgR.x, cgR.y, cgR.z, cgR.w}, xR[4] = {xgR.x, xgR.y, xgR.z, xgR.w};
    unsigned ow[4];
#pragma unroll
    for (int j = 0; j < 4; ++j) {
      const int ch = c0 + 2 * j;
      float w0a = p.conv_w[ch], w1a = p.conv_w[512 + ch], w2a = p.conv_w[1024 + ch], ba = p.conv_b[ch];
      float w0b = p.conv_w[ch + 1], w1b = p.conv_w[512 + ch + 1], w2b = p.conv_w[1024 + ch + 1], bb = p.conv_b[ch + 1];
      float ya = w0a * (lo_f(cL[j]) * lo_f(xL[j])) + w1a * (lo_f(cC[j]) * lo_f(xC[j])) + w2a * (lo_f(cR[j]) * lo_f(xR[j])) + ba;
      float yb = w0b * (hi_f(cL[j]) * hi_f(xL[j])) + w1b * (hi_f(cC[j]) * hi_f(xC[j])) + w2b * (hi_f(cR[j]) * hi_f(xR[j])) + bb;
      ow[j] = pack2(lo_f(bgw[j]) * ya, hi_f(bgw[j]) * yb);
    }
    *(uint4*)&p.hbuf[(size_t)t * D + c0] = make_uint4(ow[0], ow[1], ow[2], ow[3]);
    const float* hf = p.out + (size_t)t * 512 + c0;
    const float* hb = p.out + (size_t)T * 512 + (size_t)t * 512 + c0;
    const float4 f0 = *(const float4*)&hf[0], f1 = *(const float4*)&hf[4];
    const float4 b0 = *(const float4*)&hb[0], b1 = *(const float4*)&hb[4];
    float h[8] = {f0.x + b0.x, f0.y + b0.y, f0.z + b0.z, f0.w + b0.w, f1.x + b1.x, f1.y + b1.y, f1.z + b1.z, f1.w + b1.w};
    float ss = 0.f;
#pragma unroll
    for (int j = 0; j < 8; ++j) ss += h[j] * h[j];
    ss += __shfl_xor(ss, 1); ss += __shfl_xor(ss, 2); ss += __shfl_xor(ss, 4); ss += __shfl_xor(ss, 8);
    const float r = rsqrtf(ss * (1.f / 128.f) + EPS);
    const uint4 og = *(const uint4*)&pr[3072 + c0];
    const unsigned ogw[4] = {og.x, og.y, og.z, og.w};
    unsigned mw[4];
#pragma unroll
    for (int j = 0; j < 4; ++j) {
      float ga = p.g_mlstm[c0 + 2 * j], gb = p.g_mlstm[c0 + 2 * j + 1];
      float oa = lo_f(ogw[j]), ob = hi_f(ogw[j]);
      float sa_ = 1.f / (1.f + expf(-oa)), sb_ = 1.f / (1.f + expf(-ob));
      mw[j] = pack2(h[2 * j] * r * ga * sa_, h[2 * j + 1] * r * gb * sb_);
    }
    *(uint4*)&p.hbuf[(size_t)t * D + 512 + c0] = make_uint4(mw[0], mw[1], mw[2], mw[3]);
  }
}

__device__ __forceinline__ unsigned f2key(float f) {
  const unsigned u = __float_as_uint(f);
  return (u & 0x80000000u) ? ~u : (u | 0x80000000u);
}
__device__ __forceinline__ float key2f(unsigned k, unsigned mask) {
  const unsigned m = k & ~mask;
  const unsigned u = (m & 0x80000000u) ? (m & 0x7fffffffu) : ~m;
  return __uint_as_float(u);
}
#define KINSERT(LIST, KEY)                                   \
  {                                                          \
    unsigned kk_ = (KEY);                                    \
    _Pragma("unroll") for (int j_ = 0; j_ < 16; ++j_) {      \
      const unsigned hi_ = max(LIST[j_], kk_);               \
      kk_ = min(LIST[j_], kk_);                              \
      LIST[j_] = hi_;                                        \
    }                                                        \
  }

__device__ __forceinline__ void bsort16_desc(unsigned (&a)[16]) {
#pragma unroll
  for (int k = 2; k <= 16; k <<= 1) {
#pragma unroll
    for (int j = k >> 1; j > 0; j >>= 1) {
#pragma unroll
      for (int i = 0; i < 16; ++i) {
        const int l = i ^ j;
        if (l > i) {
          const unsigned hi = max(a[i], a[l]), lo = min(a[i], a[l]);
          if ((i & k) == 0) { a[i] = hi; a[l] = lo; } else { a[i] = lo; a[l] = hi; }
        }
      }
    }
  }
}
__device__ __forceinline__ void bmerge16_desc(unsigned (&a)[16]) {
#pragma unroll
  for (int j = 8; j > 0; j >>= 1) {
#pragma unroll
    for (int i = 0; i < 16; ++i) {
      const int l = i ^ j;
      if (l > i) { const unsigned hi = max(a[i], a[l]), lo = min(a[i], a[l]); a[i] = hi; a[l] = lo; }
    }
  }
}
__device__ __forceinline__ void top16_merge(unsigned (&L)[16], const unsigned (&G)[16]) {
#pragma unroll
  for (int i = 0; i < 16; ++i) L[i] = max(L[i], G[15 - i]);
  bmerge16_desc(L);
}
__device__ constexpr int PEER_PA[64] = {0, 0, 0, 0, 0, 0, 0, 0, 0, 0, 0, 0, 0, 0, 0, 0, 1, 1, 1, 1, 1, 1, 1, 1, 2, 2, 2, 2, 2, 3, 3, 3, 3, 4, 4, 4, 5, 5, 6, 6, 7, 7, 8, 9, 10, 11, 12, 13, 14, 15, -1, -1, -1, -1, -1, -1, -1, -1, -1, -1, -1, -1, -1, -1};
__device__ constexpr int PEER_PB[64] = {0, 1, 2, 3, 4, 5, 6, 7, 8, 9, 10, 11, 12, 13, 14, 15, 0, 1, 2, 3, 4, 5, 6, 7, 0, 1, 2, 3, 4, 0, 1, 2, 3, 0, 1, 2, 0, 1, 0, 1, 0, 1, 0, 0, 0, 0, 0, 0, 0, 0, 0, 0, 0, 0, 0, 0, 0, 0, 0, 0, 0, 0, 0, 0};
#define SBAR __builtin_amdgcn_sched_barrier(0)
__device__ __forceinline__ int launder(int v) { asm volatile("" : "+v"(v)); return v; }
#define G_ISSUE(BUF, TAB, IDS)                                                 \
  _Pragma("unroll") for (int i_ = 0; i_ < 16; ++i_) {                          \
    const int e_ = __builtin_amdgcn_readlane(IDS, i_);                         \
    BUF[i_] = *(const uint4*)&(TAB)[(size_t)e_ * D + lane * 16];               \
  }
#define U_DW(DW, J)                                                                        \
  acc_ = __builtin_elementwise_fma(__builtin_amdgcn_cvt_pk_f32_fp8(DW, false), hp[2 * (J)], acc_);      \
  acc_ = __builtin_elementwise_fma(__builtin_amdgcn_cvt_pk_f32_fp8(DW, true), hp[2 * (J) + 1], acc_);
#define G_DOTU(BUF)                                                            \
  _Pragma("unroll") for (int i_ = 0; i_ < 16; ++i_) {                          \
    f2v acc_ = (f2v){0.f, 0.f};                                                \
    U_DW(BUF[i_].x, 0) U_DW(BUF[i_].y, 1) U_DW(BUF[i_].z, 2) U_DW(BUF[i_].w, 3) \
    pa[i_] = acc_.x + acc_.y;                                                  \
  }
#define V_DW(DW, J)                                                                        \
  o2[2 * (J)] = __builtin_elementwise_fma(__builtin_amdgcn_cvt_pk_f32_fp8(DW, false), wv_, o2[2 * (J)]);      \
  o2[2 * (J) + 1] = __builtin_elementwise_fma(__builtin_amdgcn_cvt_pk_f32_fp8(DW, true), wv_, o2[2 * (J) + 1]);
#define G_ACCV(BUF)                                                            \
  _Pragma("unroll") for (int i_ = 0; i_ < 16; ++i_) {                          \
    const float w_ = __int_as_float(__builtin_amdgcn_readlane(wbits, i_));     \
    const f2v wv_ = (f2v){w_, w_};                                             \
    V_DW(BUF[i_].x, 0) V_DW(BUF[i_].y, 1) V_DW(BUF[i_].z, 2) V_DW(BUF[i_].w, 3) \
  }

__device__ __forceinline__ float gelu_as(float v) {
  const float av = fabsf(v);
  const float t = __builtin_amdgcn_rcpf(av * 0.2316418882f + 1.0f);
  float q = t * 0.5307027145f + (-0.7265760135f);
  q = q * t + 0.7107068705f; q = q * t + (-0.142248368f); q = q * t + 0.127414796f; q = q * t;
  const float e = __builtin_amdgcn_exp2f((v * v) * (-0.72134752044f));
  const float m = v * (q * e);
  return v < 0.f ? m : v - m;
}
#define G_DOTU_MFMA(BUF)                                                                   \
  _Pragma("unroll") for (int i_ = 0; i_ < 16; ++i_) {                                      \
    const long alo_ = (long)(((unsigned long long)BUF[i_].y << 32) | (unsigned long long)BUF[i_].x); \
    const long ahi_ = (long)(((unsigned long long)BUF[i_].w << 32) | (unsigned long long)BUF[i_].z); \
    f32x4 d_ = (f32x4){0.f, 0.f, 0.f, 0.f};                                                \
    d_ = __builtin_amdgcn_mfma_f32_16x16x32_fp8_fp8(alo_, h8lo, d_, 0, 0, 0);              \
    d_ = __builtin_amdgcn_mfma_f32_16x16x32_fp8_fp8(ahi_, h8hi, d_, 0, 0, 0);              \
    const float s01_ = dsel1 ? d_[1] : d_[0];                                              \
    const float s23_ = dsel1 ? d_[3] : d_[2];                                              \
    pa[i_] = diag ? (dsel2 ? s23_ : s01_) : 0.f;                                           \
  }
#define DPPF(X, CTRL) __int_as_float(__builtin_amdgcn_update_dpp(0, __float_as_int(X), CTRL, 0xF, 0xF, true))
#define REDUCE16(PA, Q1)                                                                   \
  {                                                                                        \
    float q8_[8], q4_[4], q2_[2];                                                          \
    const bool b3_ = (lane & 8) != 0, b2_ = (lane & 4) != 0, b1_ = (lane & 2) != 0, b0_ = (lane & 1) != 0; \
    _Pragma("unroll") for (int i_ = 0; i_ < 8; ++i_) { const float k_ = b3_ ? PA[i_ + 8] : PA[i_]; const float s_ = b3_ ? PA[i_] : PA[i_ + 8]; q8_[i_] = k_ + DPPF(s_, 0x128);   } \
    _Pragma("unroll") for (int i_ = 0; i_ < 4; ++i_) { const float k_ = b2_ ? q8_[i_ + 4] : q8_[i_]; const float s_ = b2_ ? q8_[i_] : q8_[i_ + 4]; q4_[i_] = k_ + __shfl_xor(s_, 4); } \
    _Pragma("unroll") for (int i_ = 0; i_ < 2; ++i_) { const float k_ = b1_ ? q4_[i_ + 2] : q4_[i_]; const float s_ = b1_ ? q4_[i_] : q4_[i_ + 2]; q2_[i_] = k_ + DPPF(s_, 0x4E);   } \
    { const float k_ = b0_ ? q2_[1] : q2_[0]; const float s_ = b0_ ? q2_[0] : q2_[1]; Q1 = k_ + DPPF(s_, 0xB1);   } \
    Q1 += __shfl_xor(Q1, 16); Q1 += __shfl_xor(Q1, 32);                                    \
  }
#define U_HEAD(BUF, IDS, SUI, SVI, HEAD)                                                   \
  {                                                                                        \
    float pa[16]; G_DOTU(BUF)                                                              \
    float q1_; REDUCE16(pa, q1_)                                                           \
    const float av_ = q1_ * (SUI);                                                         \
    const float ge_ = 0.5f * av_ * (1.f + erff(av_ * 0.7071067811865476f));                \
    const float w_ = sG[(tok * 8 + (HEAD)) * 16 + l15] * ge_ * (SVI);                      \
    if (lane < 16) { p.wbuf[(size_t)t * 128 + (HEAD) * 16 + lane] = w_; p.ibuf[(size_t)t * 128 + (HEAD) * 16 + lane] = (IDS); } \
  }

__device__ __forceinline__ void phase_peer(const P& p, char* smem) {
  unsigned* sc = (unsigned*)smem;
  unsigned* skey = sc + 256 * 130;
  int* sE = (int*)sc;
  float* sG = (float*)(sc + 2048);
  for (int it = blockIdx.x; it < T / 16; it += gridDim.x) {
    const int t0 = it * 16;
    __syncthreads();
    {
      const int tid = launder(threadIdx.x), lane = tid & 63, wave = tid >> 6, l15 = lane & 15, quad = lane >> 4;
      const int half = wave >> 2;
      const u16* kb = p.kb + half * 16384;
#pragma unroll 1
      for (int hh = 0; hh < 2; ++hh) {
        const int head = (wave & 3) * 2 + hh;
        bf16x8 qf[4];
#pragma unroll
        for (int ks = 0; ks < 4; ++ks)
          qf[ks] = *(const bf16x8*)&p.qp[(size_t)(t0 + l15) * 2048 + head * 256 + half * 128 + ks * 32 + quad * 8];
        const int row = (head * 2 + half) * 16 + l15;
#pragma unroll 1
        for (int nt = 0; nt < 8; ++nt) {
          f32x4 acc = (f32x4){0.f, 0.f, 0.f, 0.f};
#pragma unroll
          for (int ks = 0; ks < 4; ++ks) {
            bf16x8 kf = *(const bf16x8*)&kb[(nt * 16 + l15) * 128 + ks * 32 + quad * 8];
            acc = mfma16(kf, qf[ks], acc);
          }
          const int key = nt * 16 + quad * 4;
          const int pos = key + (key >= 64 ? 1 : 0);
#pragma unroll
          for (int r = 0; r < 4; ++r) sc[row * 130 + pos + r] = (f2key(acc[r]) & ~0x7Fu) | (unsigned)(127 - (key + r));
        }
      }
    }
    __syncthreads();
    {
      const int tid = launder(threadIdx.x);
      const int row = tid >> 1, hs = tid & 1;
      const unsigned* src = sc + row * 130 + hs * 65;
      unsigned list[16];
#pragma unroll
      for (int j = 0; j < 16; ++j) list[j] = src[j];
      bsort16_desc(list);
#pragma unroll 1
      for (int g = 1; g < 4; ++g) {
        unsigned grp[16];
#pragma unroll
        for (int j = 0; j < 16; ++j) grp[j] = src[g * 16 + j];
        bsort16_desc(grp);
        top16_merge(list, grp);
      }
      {
        unsigned other[16];
#pragma unroll
        for (int j = 0; j < 16; ++j) other[j] = __shfl_xor(list[j], 1);
        top16_merge(list, other);
      }
      if (hs == 0) {
#pragma unroll
        for (int j = 0; j < 16; ++j) skey[row * 16 + j] = list[j];
      }
    }
    __syncthreads();
    if (threadIdx.x < 128) {
      const int tid = launder(threadIdx.x);
      const int tok = tid & 15, head = tid >> 4;
      const int ra = (head * 2) * 16 + tok, rb = ra + 16;
      float v1[16], v2[16];
#pragma unroll
      for (int a = 0; a < 16; ++a) { v1[a] = key2f(skey[ra * 16 + a], 0x7Fu); v2[a] = key2f(skey[rb * 16 + a], 0x7Fu); }
      unsigned list[16];
#define CKEY(I) ((PEER_PA[I] < 0) ? 0u : ((f2key(v1[PEER_PA[I] < 0 ? 0 : PEER_PA[I]] + v2[PEER_PB[I]]) & ~0xFFu) | (unsigned)(255 - ((PEER_PA[I] < 0 ? 0 : PEER_PA[I]) * 16 + PEER_PB[I]))))
#pragma unroll
      for (int j = 0; j < 16; ++j) list[j] = CKEY(j);
      bsort16_desc(list);
#pragma unroll
      for (int g = 1; g < 4; ++g) {
        unsigned grp[16];
#pragma unroll
        for (int j = 0; j < 16; ++j) grp[j] = CKEY(g * 16 + j);
        bsort16_desc(grp);
        top16_merge(list, grp);
      }
#undef CKEY
      const float smax = key2f(list[0], 0xFFu);
      float ex[16];
      float se = 0.f;
#pragma unroll
      for (int q = 0; q < 16; ++q) { ex[q] = expf(key2f(list[q], 0xFFu) - smax); se += ex[q]; }
      const float inv = 1.f / se;
#pragma unroll
      for (int q = 0; q < 16; ++q) {
        const int flat = 255 - (int)(list[q] & 0xFFu);
        const int i1 = 127 - (int)(skey[ra * 16 + (flat >> 4)] & 0x7Fu);
        const int i2 = 127 - (int)(skey[rb * 16 + (flat & 15)] & 0x7Fu);
        sE[(tok * 8 + head) * 16 + q] = i1 * 128 + i2;
        sG[(tok * 8 + head) * 16 + q] = ex[q] * inv;
      }
    }
    __syncthreads();
    {
      const int tid = threadIdx.x;
#pragma unroll
      for (int i = 0; i < 4; ++i) {
        const int idx = i * NT + tid;
        p.ibuf[(size_t)t0 * 128 + idx] = sE[idx];
        p.wbuf[(size_t)t0 * 128 + idx] = sG[idx];
      }
    }
  }
}

__device__ __forceinline__ void phase_peer_u(const P& p, char* smem) {
  const int lane = threadIdx.x & 63, wave = threadIdx.x >> 6, l15 = lane & 15;
  int* lid = (int*)(smem + wave * 1536);
  int* lent = lid + 128;
  float* lg = (float*)(lent + 128);
  const int Gn = gridDim.x, bb = blockIdx.x;
  const int ngrp = bb < T / 16 ? (T / 16 - bb + Gn - 1) / Gn : 0;
  const int nseq = 2 * ngrp;
#define SEQ_TOK(S) (((bb + ((S) >> 1) * Gn) << 4) + wave * 2 + ((S) & 1))
#pragma unroll 1
  for (int r = launder(0); r < 2; ++r) {
    __syncthreads();
    int ids8n[8]; float g8n[8]; uint4 hxn0 = make_uint4(0u, 0u, 0u, 0u), hxn1 = make_uint4(0u, 0u, 0u, 0u);
#pragma unroll
    for (int h = 0; h < 8; ++h) { ids8n[h] = 0; g8n[h] = 0.f; }
    {
      const int tf = SEQ_TOK(0);
      if (nseq > 0) {
#pragma unroll
        for (int h = 0; h < 8; ++h) { ids8n[h] = p.ibuf[(size_t)tf * 128 + h * 16 + l15]; g8n[h] = p.wbuf[(size_t)tf * 128 + h * 16 + l15]; }
        hxn0 = *(const uint4*)&p.hbuf[(size_t)tf * D + lane * 16];
        hxn1 = *(const uint4*)&p.hbuf[(size_t)tf * D + lane * 16 + 8];
      }
    }
#pragma unroll 1
    for (int sq = 0; sq < nseq; ++sq) {
      const int t = SEQ_TOK(sq);
      int n = 0;
      const uint4 hx0 = hxn0, hx1 = hxn1;
      {
        int ids8[8]; float g8[8];
#pragma unroll
        for (int h = 0; h < 8; ++h) { ids8[h] = ids8n[h]; g8[h] = g8n[h]; }
        {
          const int tn = SEQ_TOK(sq + 1);
          if (sq + 1 < nseq) {
#pragma unroll
            for (int h = 0; h < 8; ++h) { ids8n[h] = p.ibuf[(size_t)tn * 128 + h * 16 + l15]; g8n[h] = p.wbuf[(size_t)tn * 128 + h * 16 + l15]; }
            hxn0 = *(const uint4*)&p.hbuf[(size_t)tn * D + lane * 16];
            hxn1 = *(const uint4*)&p.hbuf[(size_t)tn * D + lane * 16 + 8];
          }
        }
        asm volatile("s_waitcnt lgkmcnt(0)" ::: "memory");
#pragma unroll
        for (int h = 0; h < 8; ++h) {
          const bool valid = ((ids8[h] >> 13) & 1) == r;
          const unsigned m16 = (unsigned)__ballot(valid) & 0xFFFFu;
          const int pos = n + __builtin_popcount(m16 & ((1u << l15) - 1u));
          if (lane < 16 && valid) { lid[pos] = ids8[h]; lent[pos] = h * 16 + l15; lg[pos] = g8[h]; }
          n += __builtin_popcount(m16);
        }
        asm volatile("s_waitcnt lgkmcnt(0)" ::: "memory");
      }
      n = __builtin_amdgcn_readfirstlane(n);
      if (n == 0) continue;
      long h8lo, h8hi; float hinv;
      {
        const unsigned hw[8] = {hx0.x, hx0.y, hx0.z, hx0.w, hx1.x, hx1.y, hx1.z, hx1.w};
        float amax = 0.f;
#pragma unroll
        for (int j = 0; j < 8; ++j) amax = fmaxf(amax, fmaxf(fabsf(lo_f(hw[j])), fabsf(hi_f(hw[j]))));
#pragma unroll
        for (int o = 32; o > 0; o >>= 1) amax = fmaxf(amax, __shfl_xor(amax, o));
        const float hs = amax > 0.f ? 384.f / amax : 1.f;
        hinv = amax > 0.f ? amax * (1.f / 384.f) : 1.f;
        unsigned q[4];
#pragma unroll
        for (int j = 0; j < 4; ++j) {
          unsigned pk = 0u;
          pk = __builtin_amdgcn_cvt_pk_fp8_f32(lo_f(hw[2 * j]) * hs, hi_f(hw[2 * j]) * hs, pk, false);
          pk = __builtin_amdgcn_cvt_pk_fp8_f32(lo_f(hw[2 * j + 1]) * hs, hi_f(hw[2 * j + 1]) * hs, pk, true);
          q[j] = pk;
        }
        h8lo = (long)(((unsigned long long)q[1] << 32) | (unsigned long long)q[0]);
        h8hi = (long)(((unsigned long long)q[3] << 32) | (unsigned long long)q[2]);
      }
      const bool diag = (l15 >> 2) == (lane >> 4);
      const bool dsel1 = (l15 & 1) != 0, dsel2 = (l15 & 2) != 0;
      const int nu = (n + 15) >> 4;
      uint4 A[16], B[16];
#define U2_DESC(U, IDS, ENT, GT, SUI, SVI, OK)                                   \
      {                                                                         \
        const int j_ = (U) * 16 + l15;                                          \
        OK = j_ < n;                                                            \
        const int jc_ = OK ? j_ : 0;                                            \
        IDS = lid[jc_]; ENT = lent[jc_]; GT = lg[jc_];                          \
        SUI = p.sinv[IDS]; SVI = p.sinv[16384 + IDS];                           \
      }
#define U2_FIN(BUF, ENT, GT, SUI, SVI, OK)                                       \
      {                                                                         \
        float pa[16]; G_DOTU_MFMA(BUF)                                          \
        float q1_; REDUCE16(pa, q1_)                                            \
        const float av_ = q1_ * (SUI) * hinv;                                   \
        const float ge_ = gelu_as(av_);                                         \
        if (lane < 16 && (OK)) p.wbuf[(size_t)t * 128 + (ENT)] = (GT) * ge_ * (SVI); \
      }
      int idsA, entA, idsB = 0, entB = 0; float gA, suA, svA, gB = 0.f, suB = 0.f, svB = 0.f; bool okA, okB = false;
      U2_DESC(0, idsA, entA, gA, suA, svA, okA)
      G_ISSUE(A, p.ub8, idsA)
      SBAR;
#pragma unroll 1
      for (int u = 0; u < nu; u += 2) {
        const bool hasB = u + 1 < nu;
        if (hasB) { U2_DESC(u + 1, idsB, entB, gB, suB, svB, okB) G_ISSUE(B, p.ub8, idsB) }
        SBAR;
        U2_FIN(A, entA, gA, suA, svA, okA)
        SBAR;
        if (u + 2 < nu) { U2_DESC(u + 2, idsA, entA, gA, suA, svA, okA) G_ISSUE(A, p.ub8, idsA) }
        SBAR;
        if (hasB) { U2_FIN(B, entB, gB, suB, svB, okB) }
        SBAR;
      }
#undef U2_DESC
#undef U2_FIN
    }
  }
}

__device__ __forceinline__ void phase_peer_v(const P& p) {
  const int lane = threadIdx.x & 63, wave = threadIdx.x >> 6, l15 = lane & 15;
  const int tstride = gridDim.x * 8;
  int ids8n[8]; float w8n[8];
  {
    const int t0 = blockIdx.x * 8 + wave;
#pragma unroll
    for (int h = 0; h < 8; ++h) { ids8n[h] = 0; w8n[h] = 0.f; }
    if (t0 < T) {
#pragma unroll
      for (int h = 0; h < 8; ++h) { ids8n[h] = p.ibuf[(size_t)t0 * 128 + h * 16 + l15]; w8n[h] = p.wbuf[(size_t)t0 * 128 + h * 16 + l15]; }
    }
  }
#pragma unroll 1
  for (int t = blockIdx.x * 8 + wave; t < T; t += tstride) {
    int ids8[8]; float w8[8];
#pragma unroll
    for (int h = 0; h < 8; ++h) { ids8[h] = ids8n[h]; w8[h] = w8n[h]; }
    if (t + tstride < T) {
#pragma unroll
      for (int h = 0; h < 8; ++h) { ids8n[h] = p.ibuf[(size_t)(t + tstride) * 128 + h * 16 + l15]; w8n[h] = p.wbuf[(size_t)(t + tstride) * 128 + h * 16 + l15]; }
    }
    f2v o2[8];
#pragma unroll
    for (int j = 0; j < 8; ++j) o2[j] = (f2v){0.f, 0.f};
    uint4 A[16], B[16];
    G_ISSUE(A, p.vb8, ids8[0])
    SBAR;
#pragma unroll
    for (int h = 0; h < 8; ++h) {
      const int wbits = __float_as_int(w8[h]);
      if ((h & 1) == 0) {
        if (h < 7) { G_ISSUE(B, p.vb8, ids8[(h + 1) & 7]) }
        SBAR;
        G_ACCV(A)
      } else {
        if (h < 7) { G_ISSUE(A, p.vb8, ids8[(h + 1) & 7]) }
        SBAR;
        G_ACCV(B)
      }
      SBAR;
    }
    float o[16];
#pragma unroll
    for (int j = 0; j < 8; ++j) { o[2 * j] = o2[j].x; o[2 * j + 1] = o2[j].y; }
    const int ci = t < TCTX ? 0 : 1 + ((t - TCTX) >> 12);
    const float* ga2 = p.mod + ci * 6144 + 5 * 1024;
    float* xr = p.out + (size_t)t * D;
    float x2[16];
    float ss = 0.f;
#pragma unroll
    for (int q = 0; q < 4; ++q) {
      const int col = lane * 16 + q * 4;
      const float4 xa = *(const float4*)&xr[col];
      const float4 ga = *(const float4*)&ga2[col];
      x2[q * 4 + 0] = xa.x + ga.x * o[q * 4 + 0];
      x2[q * 4 + 1] = xa.y + ga.y * o[q * 4 + 1];
      x2[q * 4 + 2] = xa.z + ga.z * o[q * 4 + 2];
      x2[q * 4 + 3] = xa.w + ga.w * o[q * 4 + 3];
    }
#pragma unroll
    for (int j = 0; j < 16; ++j) ss += x2[j] * x2[j];
    ss = wave_sum(ss);
    const float rstd = rsqrtf(ss * (1.f / 1024.f) + EPS);
#pragma unroll
    for (int q = 0; q < 4; ++q) {
      const int col = lane * 16 + q * 4;
      const float4 g0 = *(const float4*)&p.g_final[col];
      *(float4*)&xr[col] = make_float4(x2[q * 4 + 0] * rstd * g0.x, x2[q * 4 + 1] * rstd * g0.y,
                                       x2[q * 4 + 2] * rstd * g0.z, x2[q * 4 + 3] * rstd * g0.w);
    }
  }
}

__device__ __forceinline__ void phase_peer_vr(const P& p, char* smem, int r) {
  const int lane = threadIdx.x & 63, wave = threadIdx.x >> 6, l15 = lane & 15;
  int* lid = (int*)(smem + wave * 1024);
  float* lw = (float*)(lid + 128);
  u16* pbuf = p.qp;
  const int Gn = gridDim.x, bb = blockIdx.x;
  const int ngrp = bb < T / 16 ? (T / 16 - bb + Gn - 1) / Gn : 0;
  const int nseq = 2 * ngrp;
#pragma unroll 1
  for (int sq = 0; sq < nseq; ++sq) {
    const int t = SEQ_TOK(sq);
    int n = 0;
    {
      int ids8[8]; float w8[8];
#pragma unroll
      for (int h = 0; h < 8; ++h) { ids8[h] = p.ibuf[(size_t)t * 128 + h * 16 + l15]; w8[h] = p.wbuf[(size_t)t * 128 + h * 16 + l15]; }
      asm volatile("s_waitcnt lgkmcnt(0)" ::: "memory");
#pragma unroll
      for (int h = 0; h < 8; ++h) {
        const bool valid = ((ids8[h] >> 13) & 1) == r;
        const unsigned m16 = (unsigned)__ballot(valid) & 0xFFFFu;
        const int pos = n + __builtin_popcount(m16 & ((1u << l15) - 1u));
        if (lane < 16 && valid) { lid[pos] = ids8[h]; lw[pos] = w8[h]; }
        n += __builtin_popcount(m16);
      }
      asm volatile("s_waitcnt lgkmcnt(0)" ::: "memory");
    }
    n = __builtin_amdgcn_readfirstlane(n);
    f2v o2[8];
    if (r == 0) {
#pragma unroll
      for (int j = 0; j < 8; ++j) o2[j] = (f2v){0.f, 0.f};
    } else {
      const uint4 p0 = *(const uint4*)&pbuf[(size_t)t * D + lane * 16];
      const uint4 p1 = *(const uint4*)&pbuf[(size_t)t * D + lane * 16 + 8];
      o2[0] = (f2v){lo_f(p0.x), hi_f(p0.x)}; o2[1] = (f2v){lo_f(p0.y), hi_f(p0.y)};
      o2[2] = (f2v){lo_f(p0.z), hi_f(p0.z)}; o2[3] = (f2v){lo_f(p0.w), hi_f(p0.w)};
      o2[4] = (f2v){lo_f(p1.x), hi_f(p1.x)}; o2[5] = (f2v){lo_f(p1.y), hi_f(p1.y)};
      o2[6] = (f2v){lo_f(p1.z), hi_f(p1.z)}; o2[7] = (f2v){lo_f(p1.w), hi_f(p1.w)};
    }
    const int nu = (n + 15) >> 4;
    if (nu > 0) {
      uint4 A[16], B[16];
#define V2_DESC(U, IDS, W)                                                       \
      {                                                                         \
        const int j_ = (U) * 16 + l15;                                          \
        const bool ok_ = j_ < n;                                                \
        const int jc_ = ok_ ? j_ : 0;                                           \
        IDS = lid[jc_]; W = ok_ ? lw[jc_] : 0.f;                                \
      }
      int idsA, idsB = 0; float wA, wB = 0.f;
      V2_DESC(0, idsA, wA)
      G_ISSUE(A, p.vb8, idsA)
      SBAR;
#pragma unroll 1
      for (int u = 0; u < nu; u += 2) {
        const bool hasB = u + 1 < nu;
        if (hasB) { V2_DESC(u + 1, idsB, wB) G_ISSUE(B, p.vb8, idsB) }
        SBAR;
        { const int wbits = __float_as_int(wA); G_ACCV(A) }
        SBAR;
        if (u + 2 < nu) { V2_DESC(u + 2, idsA, wA) G_ISSUE(A, p.vb8, idsA) }
        SBAR;
        if (hasB) { const int wbits = __float_as_int(wB); G_ACCV(B) }
        SBAR;
      }
#undef V2_DESC
    }
    if (r == 0) {
      *(uint4*)&pbuf[(size_t)t * D + lane * 16] = make_uint4(pack2(o2[0].x, o2[0].y), pack2(o2[1].x, o2[1].y), pack2(o2[2].x, o2[2].y), pack2(o2[3].x, o2[3].y));
      *(uint4*)&pbuf[(size_t)t * D + lane * 16 + 8] = make_uint4(pack2(o2[4].x, o2[4].y), pack2(o2[5].x, o2[5].y), pack2(o2[6].x, o2[6].y), pack2(o2[7].x, o2[7].y));
    } else {
      float o[16];
#pragma unroll
      for (int j = 0; j < 8; ++j) { o[2 * j] = o2[j].x; o[2 * j + 1] = o2[j].y; }
      const int ci = t < TCTX ? 0 : 1 + ((t - TCTX) >> 12);
      const float* ga2 = p.mod + ci * 6144 + 5 * 1024;
      float* xr = p.out + (size_t)t * D;
      float x2[16];
      float ss = 0.f;
#pragma unroll
      for (int q = 0; q < 4; ++q) {
        const int col = lane * 16 + q * 4;
        const float4 xa = *(const float4*)&xr[col];
        const float4 ga = *(const float4*)&ga2[col];
        x2[q * 4 + 0] = xa.x + ga.x * o[q * 4 + 0];
        x2[q * 4 + 1] = xa.y + ga.y * o[q * 4 + 1];
        x2[q * 4 + 2] = xa.z + ga.z * o[q * 4 + 2];
        x2[q * 4 + 3] = xa.w + ga.w * o[q * 4 + 3];
      }
#pragma unroll
      for (int j = 0; j < 16; ++j) ss += x2[j] * x2[j];
      ss = wave_sum(ss);
      const float rstd = rsqrtf(ss * (1.f / 1024.f) + EPS);
#pragma unroll
      for (int q = 0; q < 4; ++q) {
        const int col = lane * 16 + q * 4;
        const float4 g0 = *(const float4*)&p.g_final[col];
        *(float4*)&xr[col] = make_float4(x2[q * 4 + 0] * rstd * g0.x, x2[q * 4 + 1] * rstd * g0.y,
                                         x2[q * 4 + 2] * rstd * g0.z, x2[q * 4 + 3] * rstd * g0.w);
      }
    }
  }
}

#define XB_TMO      128
#define XB_XCNT(j)  (256  + 64 * (j))
#define XB_XSUB(j)  (1280 + 64 * (j))
#define XB_XGEN(j)  (2304 + 64 * (j))
#define XB_TOP      3328
#define XB_TOPGEN   3392
#define XCD_BAR_WORDS 3456
#define XB_SPIN_CAP (1u << 22)
__device__ __forceinline__ unsigned xb_ld(unsigned* p) { return __hip_atomic_load(p, __ATOMIC_RELAXED, __HIP_MEMORY_SCOPE_AGENT); }
__device__ __forceinline__ unsigned xb_add(unsigned* p, unsigned v) { return __hip_atomic_fetch_add(p, v, __ATOMIC_RELAXED, __HIP_MEMORY_SCOPE_AGENT); }
__device__ __forceinline__ unsigned xb_xcc_id() { return (unsigned)__builtin_amdgcn_s_getreg((3 << 11) | 20) & 0xFu; }
#define XB_SPIN(cond, bar) do { unsigned _sp = 0; while (cond) { __builtin_amdgcn_s_sleep(1); \
    if ((++_sp & 255u) == 0u) { if (xb_ld(&(bar)[XB_TMO])) break; if (_sp > XB_SPIN_CAP) { atomicAdd(&(bar)[XB_TMO], 1u); break; } } } } while (0)
struct XcdBarrier { unsigned* bar; unsigned x; volatile LAS unsigned* st; };
__device__ __forceinline__ XcdBarrier xcd_barrier_post(unsigned* bar, volatile LAS unsigned* st) {
  XcdBarrier b; b.bar = bar; b.x = xb_xcc_id(); b.st = st;
  if (threadIdx.x == 0) (void)xb_add(&bar[XB_XCNT(b.x)], 1u);
  return b;
}
__device__ __forceinline__ void xcd_barrier_complete(unsigned* bar, unsigned x, unsigned& nloc, unsigned& nx) {
  const unsigned G = gridDim.x * gridDim.y * gridDim.z;
  unsigned sum, cnt, mine, sp = 0u;
  for (;;) {
    sum = 0u; cnt = 0u; mine = 0u;
#pragma unroll
    for (unsigned j = 0; j < 16; ++j) { const unsigned c = xb_ld(&bar[XB_XCNT(j)]); sum += c; cnt += (c > 0u) ? 1u : 0u; mine = (j == x) ? c : mine; }
    if (sum == G) break;
    __builtin_amdgcn_s_sleep(1);
    if ((++sp & 255u) == 0u) { if (xb_ld(&bar[XB_TMO])) break; if (sp > XB_SPIN_CAP) { atomicAdd(&bar[XB_TMO], 1u); break; } }
  }
  nloc = mine > 0u ? mine : 1u; nx = cnt > 0u ? cnt : 1u;
}
__device__ __forceinline__ void xcd_barrier(const XcdBarrier& b) {
  asm volatile("s_waitcnt vmcnt(0)" ::: "memory");
  __syncthreads();
  if (threadIdx.x == 0) {
    unsigned* bar = b.bar;
    __builtin_amdgcn_s_waitcnt(0);
    unsigned nloc = b.st[0], nx = b.st[1];
    if (nloc == 0u) { xcd_barrier_complete(bar, b.x, nloc, nx); b.st[0] = nloc; b.st[1] = nx; }
    const unsigned old = xb_add(&bar[XB_XSUB(b.x)], 1u);
    const unsigned gen = old / nloc;
    if (old + 1u == (gen + 1u) * nloc) {
      __builtin_amdgcn_fence(__ATOMIC_RELEASE, "agent");
      asm volatile("s_waitcnt vmcnt(0)" ::: "memory");
      const unsigned og = xb_add(&bar[XB_TOP], 1u);
      const unsigned tg = og / nx;
      if (og + 1u == (tg + 1u) * nx) xb_add(&bar[XB_TOPGEN], 1u);
      else XB_SPIN(xb_ld(&bar[XB_TOPGEN]) == tg, bar);
      __builtin_amdgcn_fence(__ATOMIC_ACQUIRE, "agent");
      xb_add(&bar[XB_XGEN(b.x)], 1u);
      asm volatile("s_waitcnt vmcnt(0)" ::: "memory");
    } else {
      XB_SPIN(xb_ld(&bar[XB_XGEN(b.x)]) == gen, bar);
      __builtin_amdgcn_fence(__ATOMIC_ACQUIRE, "agent");
      asm volatile("s_waitcnt vmcnt(0)" ::: "memory");
    }
  }
  __syncthreads();
}

__global__ void __launch_bounds__(NT) mega(P p, unsigned* bar, int use_cg) {
  extern __shared__ __attribute__((aligned(16))) char smem[];
  __shared__ uint4 xb_words;
  cg::grid_group grid = cg::this_grid();
  if (threadIdx.x == 0) xb_words = make_uint4(0u, 0u, 0u, 0u);
  __syncthreads();
  XcdBarrier xb = xcd_barrier_post(bar, (volatile LAS unsigned*)&xb_words);
#define SEAM() do { if (use_cg) grid.sync(); else xcd_barrier(xb); } while (0)
  phase_prep(p, smem);
  SEAM();
  phase_norm(p, 0);
  SEAM();
  { EpiProj e; e.proj = p.proj; e.gates = p.gates; gemm_run(p.hbuf, p.w_in_t, NPAD, e, smem); }
  {
    const int G = (int)gridDim.x, rem = ((T / 256) * (NPAD / 256)) % G;
    const int bi = rem == 0 ? (int)blockIdx.x : (int)blockIdx.x - rem;
    if (bi >= 0) phase_prep_late(p, smem, bi, rem == 0 ? G : G - rem);
  }
  SEAM();
  phase_mlstm(p, smem);
  SEAM();
  phase_mix(p);
  SEAM();
  { EpiResid e; e.x_prompt = p.x_prompt; e.x_sample = p.x_sample; e.mod = p.mod; e.out = p.out; gemm_run(p.hbuf, p.w_out_t, 1024, e, smem); }
  SEAM();
  phase_norm(p, 1);
  if (!p.conv_early) convert_tables(p, (int)blockIdx.x, (int)gridDim.x);
  SEAM();
  { EpiQ e; e.qp = p.qp; gemm_run(p.hbuf, p.wq_t, 2048, e, smem); }
  SEAM();
  phase_peer(p, smem);
  __syncthreads();
  phase_peer_u(p, smem);
  __syncthreads();
#pragma unroll 1
  for (int rr = launder(0); rr < 2; ++rr) {
    phase_peer_vr(p, smem, rr);
    __syncthreads();
  }
}

extern "C" void kernel_launch(void* const* d_in, const int* in_sizes, int n_in, void* d_out, int out_size,
                              void* d_ws, size_t ws_size, hipStream_t stream) {
  P p{};
  const float* const* in = (const float* const*)d_in;
  p.x_prompt = in[0]; p.x_sample = in[1]; p.state_C = in[2]; p.state_n = in[3]; p.state_m = in[4];
  p.c = in[5]; p.c_ctx = in[6]; p.w_ada = in[7]; p.b_ada = in[8]; p.g_norm1 = in[9]; p.w_in = in[10];
  p.b_igate = in[11]; p.b_fgate = in[12]; p.conv_w = in[13]; p.conv_b = in[14]; p.g_mlstm = in[15];
  p.w_out = in[16]; p.g_norm2 = in[17]; p.wq = in[18]; p.k1 = in[19]; p.k2 = in[20]; p.u = in[21]; p.v = in[22];
  p.g_final = in[23];
  p.out = (float*)d_out;
  char* ws = (char*)d_ws;
  size_t off = 0;
  auto take = [&](size_t bytes) { char* r = ws + off; off += (bytes + 255) & ~(size_t)255; return r; };
  p.mod = (float*)take(5 * 6144 * 4);
  p.w_in_t = (u16*)take((size_t)NPAD * 1024 * 2);
  p.w_out_t = (u16*)take((size_t)1024 * 1024 * 2);
  p.wq_t = (u16*)take((size_t)2048 * 1024 * 2);
  p.kb = (u16*)take(2 * 16384 * 2);
  p.gates = (float*)take((size_t)T * 16 * 4);
  p.hbuf = (u16*)take((size_t)T * D * 2);
  p.proj = (u16*)take((size_t)T * NPROJ * 2);
  p.qp = p.proj;
  p.wbuf = (float*)(p.proj + (size_t)70000000);
  p.ibuf = (int*)(p.wbuf + (size_t)T * 128);
  unsigned* bar = (unsigned*)take(XCD_BAR_WORDS * 4);
  p.scan = (float*)p.hbuf;
  const size_t tab_bytes = (size_t)2 * 16384 * 1024 + (size_t)2 * 16384 * 4;
  if (ws_size >= off + tab_bytes + 256) {
    p.ub8 = (unsigned char*)take((size_t)16384 * 1024);
    p.vb8 = (unsigned char*)take((size_t)16384 * 1024);
    p.sinv = (float*)take((size_t)2 * 16384 * 4);
    p.conv_early = 1;
  } else {
    p.ub8 = (unsigned char*)(p.proj + (size_t)T * 2048);
    p.vb8 = p.ub8 + (size_t)16384 * 1024;
    p.sinv = (float*)(p.vb8 + (size_t)16384 * 1024);
    p.conv_early = 0;
  }
  (void)hipMemsetAsync(bar, 0, XCD_BAR_WORDS * 4, stream);
  (void)hipFuncSetAttribute((const void*)mega, hipFuncAttributeMaxDynamicSharedMemorySize, LDS_BYTES);
  int dev = 0, cus = 0, per = 0;
  (void)hipGetDevice(&dev);
  (void)hipDeviceGetAttribute(&cus, hipDeviceAttributeMultiprocessorCount, dev);
  (void)hipOccupancyMaxActiveBlocksPerMultiprocessor(&per, (const void*)mega, NT, LDS_BYTES);
  if (per < 1 || cus < 1) { fprintf(stderr, "occupancy query: %d blocks/CU on %d CUs\n", per, cus); }
  const int grid = cus;
  int use_cg = 0;
  void* args[] = {&p, &bar, &use_cg};
  hipError_t e = hipLaunchCooperativeKernel((const void*)mega, dim3(grid), dim3(NT), args, LDS_BYTES, stream);
  if (e != hipSuccess) fprintf(stderr, "cooperative launch failed: %s (grid %d)\n", hipGetErrorString(e), grid);
}
```

```cpp
#include <hip/hip_runtime.h>
#include <hip/hip_cooperative_groups.h>
#include <cstdio>
#include <cstdint>
namespace cg = cooperative_groups;

typedef unsigned short u16;
typedef __attribute__((ext_vector_type(8))) short bf16x8;
typedef __attribute__((ext_vector_type(4))) float f32x4;
typedef __attribute__((ext_vector_type(2))) __bf16 bf2_t;
typedef __attribute__((ext_vector_type(2))) float f2v;
typedef __attribute__((ext_vector_type(4))) short s16x4;
#define LAS __attribute__((address_space(3)))

constexpr int NT = 512;
constexpr int D = 1024;
constexpr int TCTX = 8192;
constexpr int TLAT = 16384;
constexpr int T = TCTX + TLAT;
constexpr int NPROJ = 3584;
constexpr int NPAD = 3840;
constexpr int LDS_BYTES = 256 * 130 * 4 + 256 * 16 * 4;
constexpr float EPS = 1e-6f;

struct P {
  const float *x_prompt, *x_sample, *state_C, *state_n, *state_m, *c, *c_ctx, *w_ada, *b_ada, *g_norm1, *w_in,
      *b_igate, *b_fgate, *conv_w, *conv_b, *g_mlstm, *w_out, *g_norm2, *wq, *k1, *k2, *u, *v, *g_final;
  float* out;
  float* mod;
  u16* w_in_t;
  u16* w_out_t;
  u16* wq_t;
  u16* kb;
  float* gates;
  u16* hbuf;
  u16* proj;
  u16* qp;
  unsigned char* ub8;
  unsigned char* vb8;
  float* sinv;
  float* wbuf;
  int* ibuf;
  float* scan;
  int conv_early;
  int pad_;
};

__device__ __forceinline__ u16 f2bf(float f) { return __builtin_bit_cast(u16, (__bf16)f); }
__device__ __forceinline__ float bf2f(u16 h) { return __uint_as_float(((unsigned)h) << 16); }
__device__ __forceinline__ unsigned pack2(float a, float b) {
  bf2_t v; v.x = (__bf16)a; v.y = (__bf16)b;
  return __builtin_bit_cast(unsigned, v);
}
__device__ __forceinline__ float lo_f(unsigned w) { return __uint_as_float(w << 16); }
__device__ __forceinline__ float hi_f(unsigned w) { return __uint_as_float(w & 0xffff0000u); }
__device__ __forceinline__ float wave_sum(float v) {
#pragma unroll
  for (int o = 32; o > 0; o >>= 1) v += __shfl_xor(v, o);
  return v;
}
__device__ __forceinline__ float dot2(unsigned a, unsigned b, float c) {
  return __builtin_amdgcn_fdot2_f32_bf16(__builtin_bit_cast(bf2_t, a), __builtin_bit_cast(bf2_t, b), c, false);
}
__device__ __forceinline__ float dot8(uint4 a, uint4 b, float c) {
  c = dot2(a.x, b.x, c); c = dot2(a.y, b.y, c); c = dot2(a.z, b.z, c); c = dot2(a.w, b.w, c);
  return c;
}
__device__ __forceinline__ f32x4 mfma16(bf16x8 a, bf16x8 b, f32x4 c) {
  return __builtin_amdgcn_mfma_f32_16x16x32_bf16(a, b, c, 0, 0, 0);
}

__device__ __forceinline__ void transpose_tile(const float* __restrict__ W, int Nreal, u16* __restrict__ Wt, int k0, int n0, float* tile) {
  const int tid = threadIdx.x;
#pragma unroll
  for (int i = 0; i < 8; ++i) {
    int idx = i * NT + tid;
    int kk = idx >> 6, nn = idx & 63;
    float v = (n0 + nn < Nreal) ? W[(size_t)(k0 + kk) * Nreal + n0 + nn] : 0.f;
    tile[kk * 65 + nn] = v;
  }
  __syncthreads();
  {
    const int nn = tid & 63, kg = tid >> 6;
    uint4 o;
    o.x = pack2(tile[(kg * 8 + 0) * 65 + nn], tile[(kg * 8 + 1) * 65 + nn]);
    o.y = pack2(tile[(kg * 8 + 2) * 65 + nn], tile[(kg * 8 + 3) * 65 + nn]);
    o.z = pack2(tile[(kg * 8 + 4) * 65 + nn], tile[(kg * 8 + 5) * 65 + nn]);
    o.w = pack2(tile[(kg * 8 + 6) * 65 + nn], tile[(kg * 8 + 7) * 65 + nn]);
    *(uint4*)&Wt[(size_t)(n0 + nn) * 1024 + k0 + kg * 8] = o;
  }
}

__device__ __forceinline__ void phase_prep(const P& p, char* smem) {
  const int tid = threadIdx.x;
  float* sf = (float*)smem;
  const int n_gemv = 96, n_tin = 16 * 60, n_tout = 16 * 16, n_tq = 16 * 32, n_k = 2;
  const int total = n_gemv + n_tin + n_tout + n_tq + n_k;
  (void)total;
  for (int it = blockIdx.x; it < n_gemv + n_tin; it += gridDim.x) {
    __syncthreads();
    if (it < n_gemv) {
      for (int i = tid; i < 5 * 1024; i += NT) {
        int ci = i >> 10, k = i & 1023;
        float cv = (ci == 0) ? p.c_ctx[k] : p.c[(ci - 1) * 1024 + k];
        sf[i] = cv / (1.f + expf(-cv));
      }
      __syncthreads();
      const int cl = tid & 15, kg = tid >> 4;
      const int col = it * 64 + cl * 4;
      float acc[5][4];
#pragma unroll
      for (int ci = 0; ci < 5; ++ci)
#pragma unroll
        for (int j = 0; j < 4; ++j) acc[ci][j] = 0.f;
      for (int kk = 0; kk < 32; ++kk) {
        int k = kg * 32 + kk;
        float4 w = *(const float4*)&p.w_ada[(size_t)k * 6144 + col];
#pragma unroll
        for (int ci = 0; ci < 5; ++ci) {
          float s = sf[ci * 1024 + k];
          acc[ci][0] += s * w.x; acc[ci][1] += s * w.y; acc[ci][2] += s * w.z; acc[ci][3] += s * w.w;
        }
      }
      float* red = sf + 5 * 1024;
#pragma unroll
      for (int ci = 0; ci < 5; ++ci)
#pragma unroll
        for (int j = 0; j < 4; ++j) red[(kg * 16 + cl) * 20 + ci * 4 + j] = acc[ci][j];
      __syncthreads();
      if (tid < 320) {
        int ci = tid >> 6, cc = tid & 63;
        int cl2 = cc >> 2, j = cc & 3;
        float s = 0.f;
        for (int g = 0; g < 32; ++g) s += red[(g * 16 + cl2) * 20 + ci * 4 + j];
        int col2 = it * 64 + cc;
        p.mod[ci * 6144 + col2] = s + p.b_ada[col2];
      }
    } else if (it < n_gemv + n_tin) {
      int j = it - n_gemv;
      transpose_tile(p.w_in, 3600, p.w_in_t, (j / 60) * 64, (j % 60) * 64, sf);
    } else if (it < n_gemv + n_tin + n_tout) {
      int j = it - n_gemv - n_tin;
      transpose_tile(p.w_out, 1024, p.w_out_t, (j / 16) * 64, (j % 16) * 64, sf);
    } else if (it < n_gemv + n_tin + n_tout + n_tq) {
      int j = it - n_gemv - n_tin - n_tout;
      transpose_tile(p.wq, 2048, p.wq_t, (j / 32) * 64, (j % 32) * 64, sf);
    } else {
      int j = it - n_gemv - n_tin - n_tout - n_tq;
      const float* src = j ? p.k2 : p.k1;
      u16* dst = p.kb + j * 16384;
      for (int i = tid; i < 16384; i += NT) dst[i] = f2bf(src[i]);
    }
  }
}

__device__ __forceinline__ void phase_prep_late(const P& p, char* smem, int bi, int nb) {
  const int tid = threadIdx.x;
  float* sf = (float*)smem;
  const int n_tout = 16 * 16, n_tq = 16 * 32, n_k = 2;
  for (int it = bi; it < n_tout + n_tq + n_k; it += nb) {
    __syncthreads();
    if (it < n_tout) {
      transpose_tile(p.w_out, 1024, p.w_out_t, (it / 16) * 64, (it % 16) * 64, sf);
    } else if (it < n_tout + n_tq) {
      const int j = it - n_tout;
      transpose_tile(p.wq, 2048, p.wq_t, (j / 32) * 64, (j % 32) * 64, sf);
    } else {
      const int j = it - n_tout - n_tq;
      const float* src = j ? p.k2 : p.k1;
      u16* dst = p.kb + j * 16384;
      for (int i = tid; i < 16384; i += NT) dst[i] = f2bf(src[i]);
    }
  }
}

__device__ __forceinline__ void phase_norm(const P& p, int which) {
  const int wave = threadIdx.x >> 6, lane = threadIdx.x & 63;
  for (int t = blockIdx.x * 8 + wave; t < T; t += gridDim.x * 8) {
    const float* xr = which ? (p.out + (size_t)t * D)
                            : (t < TCTX ? p.x_prompt + (size_t)t * D : p.x_sample + (size_t)(t - TCTX) * D);
    const int ci = t < TCTX ? 0 : 1 + ((t - TCTX) >> 12);
    const float* md = p.mod + ci * 6144 + (which ? 3 * 1024 : 0);
    const float* g = which ? p.g_norm2 : p.g_norm1;
    float4 xv[4];
    float ss = 0.f;
#pragma unroll
    for (int i = 0; i < 4; ++i) {
      xv[i] = *(const float4*)&xr[(i >> 1) * 512 + lane * 8 + (i & 1) * 4];
      ss += xv[i].x * xv[i].x + xv[i].y * xv[i].y + xv[i].z * xv[i].z + xv[i].w * xv[i].w;
    }
    ss = wave_sum(ss);
    const float rstd = rsqrtf(ss * (1.f / 1024.f) + EPS);
    unsigned ow[8];
#pragma unroll
    for (int i = 0; i < 4; ++i) {
      const int col = (i >> 1) * 512 + lane * 8 + (i & 1) * 4;
      const float4 g4 = *(const float4*)&g[col];
      const float4 sh = *(const float4*)&md[col];
      const float4 sc = *(const float4*)&md[1024 + col];
      const float h0 = xv[i].x * rstd * g4.x * (1.f + sc.x) + sh.x;
      const float h1 = xv[i].y * rstd * g4.y * (1.f + sc.y) + sh.y;
      const float h2 = xv[i].z * rstd * g4.z * (1.f + sc.z) + sh.z;
      const float h3 = xv[i].w * rstd * g4.w * (1.f + sc.w) + sh.w;
      ow[i * 2] = pack2(h0, h1); ow[i * 2 + 1] = pack2(h2, h3);
    }
    *(uint4*)&p.hbuf[(size_t)t * D + lane * 8] = make_uint4(ow[0], ow[1], ow[2], ow[3]);
    *(uint4*)&p.hbuf[(size_t)t * D + 512 + lane * 8] = make_uint4(ow[4], ow[5], ow[6], ow[7]);
  }
}

__device__ __forceinline__ void convert_tables(const P& p, int bi, int nb) {
  const int wave = threadIdx.x >> 6, lane = threadIdx.x & 63;
  for (int row = bi * 8 + wave; row < 32768; row += nb * 8) {
    const float* src = row < 16384 ? p.u + (size_t)row * D : p.v + (size_t)(row - 16384) * D;
    unsigned char* dst = row < 16384 ? p.ub8 + (size_t)row * D : p.vb8 + (size_t)(row - 16384) * D;
    float4 f[4];
    float amax = 0.f;
#pragma unroll
    for (int i = 0; i < 4; ++i) {
      f[i] = *(const float4*)&src[lane * 16 + i * 4];
      amax = fmaxf(amax, fmaxf(fmaxf(fabsf(f[i].x), fabsf(f[i].y)), fmaxf(fabsf(f[i].z), fabsf(f[i].w))));
    }
#pragma unroll
    for (int o = 32; o > 0; o >>= 1) amax = fmaxf(amax, __shfl_xor(amax, o));
    const float sc = amax > 0.f ? 384.f / amax : 1.f;
    const float inv = amax > 0.f ? amax * (1.f / 384.f) : 1.f;
    unsigned w[4];
#pragma unroll
    for (int i = 0; i < 4; ++i) {
      unsigned pk = 0u;
      pk = __builtin_amdgcn_cvt_pk_fp8_f32(f[i].x * sc, f[i].y * sc, pk, false);
      pk = __builtin_amdgcn_cvt_pk_fp8_f32(f[i].z * sc, f[i].w * sc, pk, true);
      w[i] = pk;
    }
    *(uint4*)&dst[lane * 16] = make_uint4(w[0], w[1], w[2], w[3]);
    if (lane == 0) p.sinv[row] = inv;
  }
}

namespace pg8 {
#define PG8_LAS __attribute__((address_space(3)))
typedef unsigned short bf16_t;
typedef short bf16x8 __attribute__((ext_vector_type(8)));
typedef float f32x4 __attribute__((ext_vector_type(4)));
typedef unsigned u32x4 __attribute__((ext_vector_type(4)));
constexpr int BM = 256, BK = 64, HALF = 128, HTB = HALF * BK * 2  , STAGE_BYTES = 8 * HTB, NXCD = 8, WGM = 8;

__host__ __device__ __forceinline__ int lds_byte(int r, int c) { const int st = (r >> 4) * 2 + (c >> 5), rr = r & 15, cc = c & 31, ob = rr * 64 + cc * 2; return st * 1024 + (ob ^ (((ob >> 9) & 1) << 5)); }
__host__ __device__ __forceinline__ void stage_rc(int b, int& R, int& C) { const int st = b / 1024, sb = b % 1024, swz = sb ^ (((sb >> 9) & 1) << 5); R = (st >> 1) * 16 + swz / 64; C = (st & 1) * 32 + (swz % 64) / 2; }
__host__ __device__ __forceinline__ int perm32(int rho) { const int n = rho >> 4, i = rho & 15; return 8 * (i >> 2) + 4 * n + (i & 3); }

struct Unit { int pm, pn; };
struct Gemm { const bf16_t* A; const bf16_t* Bt; int M, N, K; };

struct StaticOrder {
    int nM, nN, nwg, G, c;
    __host__ __device__ void init(int M, int N, int G_, int c_) { nM = M / BM; nN = N / BM; nwg = nM * nN; G = G_; c = c_; }
    __host__ __device__ bool next(int i, Unit& u) const {
        const long L = (long)i * G + c; if (L >= nwg) return false;
        int wgid = (int)L; { const int q = nwg / NXCD, r = nwg % NXCD, xcd = wgid % NXCD, off = wgid / NXCD; wgid = (xcd < r ? xcd * (q + 1) : r * (q + 1) + (xcd - r) * q) + off; }
        const int nig = WGM * nN, gid = wgid / nig, fm = gid * WGM, gsz = (nM - fm) < WGM ? (nM - fm) : WGM;
        u.pm = fm + ((wgid % nig) % gsz); u.pn = (wgid % nig) / gsz; return true;
    }
    __device__ __forceinline__ void a_ready(const Unit&) const {}
    __device__ __forceinline__ void done(const Unit&) const {}
};

template <class Epi, class Sched, bool STAMP = false>
__device__ __forceinline__ void gemm_phase(PG8_LAS unsigned char* lds, const Gemm g, const Sched& S, const Epi& E, unsigned long long* stamps) {
    const int tid = threadIdx.x, wid = __builtin_amdgcn_readfirstlane(tid >> 6), lane = tid & 63, wr = wid >> 2, wc = wid & 3, fr = lane & 15, fq = lane >> 4;
    const int K = g.K, nt = K / BK;
    int ts_lo = 0, ts_hi = 0, nts = 0; const unsigned long long rt_entry = STAMP ? (unsigned long long)wall_clock64() : 0ull;
#define PG8_STAMP() do { if (STAMP && wid == 0 && nts < 64) { const unsigned long long _c = (unsigned long long)clock64(); \
        ts_lo = (lane == nts) ? (int)(unsigned)_c : ts_lo; ts_hi = (lane == nts) ? (int)(unsigned)(_c >> 32) : ts_hi; ++nts; } } while (0)
    PG8_STAMP();
    unsigned voffA[2], voffB[2];
#pragma unroll
    for (int i = 0; i < 2; ++i) { int R, C; stage_rc(tid * 16 + i * 8192, R, C); const int Rb = Epi::PERM ? ((R & ~31) + perm32(R & 31)) : R;
        voffA[i] = (unsigned)(R * K + C) * 2u; voffB[i] = (unsigned)(Rb * K + C) * 2u; }
    const size_t kstep = (size_t)(BK * 2);
    const size_t hstep = (size_t)HALF * K * 2;
    const size_t tstep = 2 * hstep;
    const unsigned ldsw = (unsigned)wid * 1024u;
    const int aoff = lds_byte(wr * 64 + fr, fq * 8), boff = lds_byte(wc * 32 + fr, fq * 8);
#define PG8_SA(b, h) (((b) * 2 + (h)) * HTB)
#define PG8_SB(b, h) ((4 + (b) * 2 + (h)) * HTB)
#define PG8_STAGE(bufoff, gbase, voff) do { _Pragma("unroll") for (int _i = 0; _i < 2; ++_i) \
        __builtin_amdgcn_global_load_lds((const unsigned*)((const char*)(gbase) + (voff)[_i]), (PG8_LAS unsigned*)(lds + (bufoff) + ldsw + _i * 8192), 16, 0, 0); } while (0)
#define PG8_LDA(dst, b, h) do { _Pragma("unroll") for (int m = 0; m < 4; ++m) _Pragma("unroll") for (int k = 0; k < 2; ++k) dst[m][k] = *(const PG8_LAS bf16x8*)(lds + PG8_SA(b, h) + aoff + m * 2048 + k * 1024); } while (0)
#define PG8_LDB(dst, b, h) do { _Pragma("unroll") for (int n = 0; n < 2; ++n) _Pragma("unroll") for (int k = 0; k < 2; ++k) dst[n][k] = *(const PG8_LAS bf16x8*)(lds + PG8_SB(b, h) + boff + n * 2048 + k * 1024); } while (0)
#define PG8_MMA(ai, bj, At, Bt) do { __builtin_amdgcn_s_setprio(1); _Pragma("unroll") for (int m = 0; m < 4; ++m) _Pragma("unroll") for (int n = 0; n < 2; ++n) _Pragma("unroll") for (int k = 0; k < 2; ++k) \
        acc[ai][bj][m][n] = __builtin_amdgcn_mfma_f32_16x16x32_bf16(Bt[n][k], At[m][k], acc[ai][bj][m][n], 0, 0, 0); __builtin_amdgcn_s_setprio(0); } while (0)
#define PG8_WAIT_V(n) asm volatile("s_waitcnt vmcnt(" #n ")" ::: "memory")
#define PG8_WAIT_L(n) asm volatile("s_waitcnt lgkmcnt(" #n ")" ::: "memory")
#define PG8_BAR __builtin_amdgcn_s_barrier()
#define PG8_SCHED __builtin_amdgcn_sched_barrier(0)
    Unit cur, nxt; int ui = 0;
    if (!S.next(0, cur)) return;
    f32x4 acc[2][2][4][2];
#pragma unroll
    for (int a = 0; a < 2; ++a)
#pragma unroll
        for (int b = 0; b < 2; ++b)
#pragma unroll
            for (int m = 0; m < 4; ++m)
#pragma unroll
                for (int n = 0; n < 2; ++n) acc[a][b][m][n] = (f32x4){0.f, 0.f, 0.f, 0.f};
    bf16x8 At[4][2], B0[2][2], B1[2][2];
    const char* cA = (const char*)g.A + (size_t)cur.pm * tstep; const char* cB = (const char*)g.Bt + (size_t)cur.pn * tstep;
    S.a_ready(cur);
    PG8_STAGE(PG8_SB(0, 0), cB, voffB); PG8_STAGE(PG8_SA(0, 0), cA, voffA); PG8_STAGE(PG8_SB(0, 1), cB + hstep, voffB); PG8_STAGE(PG8_SA(0, 1), cA + hstep, voffA);
    if (wr == 1) PG8_BAR;
    PG8_WAIT_V(4); PG8_BAR;
    PG8_STAGE(PG8_SB(1, 0), cB + kstep, voffB); PG8_STAGE(PG8_SA(1, 0), cA + kstep, voffA); PG8_STAGE(PG8_SB(1, 1), cB + hstep + kstep, voffB);
    PG8_WAIT_V(6); PG8_BAR;
    PG8_STAMP();
    for (;;) {
        const bool has_next = S.next(ui + 1, nxt);
        const char* nA = has_next ? (const char*)g.A + (size_t)nxt.pm * tstep : cA; const char* nB = has_next ? (const char*)g.Bt + (size_t)nxt.pn * tstep : cB;
        for (int t = 0; t < nt; t += 2) {
            const bool last = (t == nt - 2);
            const char* a1 = cA + (size_t)(t + 1) * kstep;
            const char* a2 = last ? nA : cA + (size_t)(t + 2) * kstep; const char* b2 = last ? nB : cB + (size_t)(t + 2) * kstep;
            const char* a3 = a2 + kstep; const char* b3 = b2 + kstep;
            if (last && has_next) S.a_ready(nxt);
            PG8_LDB(B0, 0, 0); PG8_SCHED; PG8_LDA(At, 0, 0); PG8_STAGE(PG8_SA(1, 1), a1 + hstep, voffA);
            PG8_WAIT_L(8); PG8_BAR; PG8_WAIT_L(0); PG8_MMA(0, 0, At, B0); PG8_BAR; PG8_SCHED;
            PG8_LDB(B1, 0, 1); PG8_STAGE(PG8_SB(0, 0), b2, voffB);
            PG8_BAR; PG8_WAIT_L(0); PG8_MMA(0, 1, At, B1); PG8_BAR;
            PG8_LDA(At, 0, 1); PG8_STAGE(PG8_SA(0, 0), a2, voffA);
            PG8_BAR; PG8_WAIT_L(0); PG8_MMA(1, 0, At, B0); PG8_BAR; PG8_SCHED;
            PG8_STAGE(PG8_SB(0, 1), b2 + hstep, voffB);
            PG8_WAIT_V(6); PG8_BAR; PG8_MMA(1, 1, At, B1); PG8_BAR;
            PG8_LDB(B0, 1, 0); PG8_SCHED; PG8_LDA(At, 1, 0); PG8_STAGE(PG8_SA(0, 1), a2 + hstep, voffA);
            PG8_WAIT_L(8); PG8_BAR; PG8_WAIT_L(0); PG8_MMA(0, 0, At, B0); PG8_BAR; PG8_SCHED;
            PG8_LDB(B1, 1, 1); PG8_STAGE(PG8_SB(1, 0), b3, voffB);
            PG8_BAR; PG8_WAIT_L(0); PG8_MMA(0, 1, At, B1); PG8_BAR;
            PG8_LDA(At, 1, 1); PG8_STAGE(PG8_SA(1, 0), a3, voffA);
            PG8_BAR; PG8_WAIT_L(0); PG8_MMA(1, 0, At, B0); PG8_BAR; PG8_SCHED;
            PG8_STAGE(PG8_SB(1, 1), b3 + hstep, voffB);
            PG8_WAIT_V(6); PG8_BAR; PG8_MMA(1, 1, At, B1); PG8_BAR;
        }
        PG8_STAMP();
        if constexpr (!Epi::AFTER_DRAIN) { E(acc, cur, wr, wc, fr, fq); S.done(cur); }
        PG8_STAMP();
        if (!has_next) break;
#pragma unroll
        for (int a = 0; a < 2; ++a)
#pragma unroll
            for (int b = 0; b < 2; ++b)
#pragma unroll
                for (int m = 0; m < 4; ++m)
#pragma unroll
                    for (int n = 0; n < 2; ++n) acc[a][b][m][n] = (f32x4){0.f, 0.f, 0.f, 0.f};
        cur = nxt; cA = nA; cB = nB; ++ui;
    }
    PG8_WAIT_V(0);
    if (wr == 0) PG8_BAR;
    PG8_BAR;
    if constexpr (Epi::AFTER_DRAIN) { E.fused(acc, cur, wr, wc, fr, fq, lds, wid, lane); S.done(cur); }
    PG8_STAMP();
    if (STAMP && wid == 0) { stamps[lane] = lane < nts ? (((unsigned long long)(unsigned)ts_hi << 32) | (unsigned)ts_lo) : 0ull;
        if (lane == 62) stamps[62] = rt_entry; if (lane == 63) stamps[63] = (unsigned long long)wall_clock64(); }
#undef PG8_STAMP
#undef PG8_SA
#undef PG8_SB
#undef PG8_STAGE
#undef PG8_LDA
#undef PG8_LDB
#undef PG8_MMA
#undef PG8_WAIT_V
#undef PG8_WAIT_L
#undef PG8_BAR
#undef PG8_SCHED
}
}


struct EpiProj {
  static constexpr bool PERM = true, AFTER_DRAIN = false;
  u16* proj; float* gates;
  __device__ __forceinline__ void operator()(const pg8::f32x4 (&acc)[2][2][4][2], const pg8::Unit& u, int wr, int wc, int fr, int fq) const {
    const int row0 = u.pm * 256 + wr * 64 + fr, col0 = u.pn * 256 + wc * 32 + 8 * fq;
#pragma unroll
    for (int ai = 0; ai < 2; ++ai)
#pragma unroll
      for (int m = 0; m < 4; ++m) {
        const int row = row0 + ai * 128 + m * 16;
#pragma unroll
        for (int bj = 0; bj < 2; ++bj) {
          const int col = col0 + bj * 128;
          const pg8::f32x4 a = acc[ai][bj][m][0], b = acc[ai][bj][m][1];
          if (col < NPROJ) {
            uint4 o; o.x = pack2(a[0], a[1]); o.y = pack2(a[2], a[3]); o.z = pack2(b[0], b[1]); o.w = pack2(b[2], b[3]);
            *(uint4*)&proj[(size_t)row * NPROJ + col] = o;
          } else if (col < 3600) {
            *(float4*)&gates[(size_t)row * 16 + (col - NPROJ)] = make_float4(a[0], a[1], a[2], a[3]);
            *(float4*)&gates[(size_t)row * 16 + (col - NPROJ) + 4] = make_float4(b[0], b[1], b[2], b[3]);
          }
        }
      }
  }
};
struct EpiResid {
  static constexpr bool PERM = false, AFTER_DRAIN = false;
  const float* x_prompt; const float* x_sample; const float* mod; float* out;
  __device__ __forceinline__ void operator()(const pg8::f32x4 (&acc)[2][2][4][2], const pg8::Unit& u, int wr, int wc, int fr, int fq) const {
    const int row0 = u.pm * 256 + wr * 64 + fr, col0 = u.pn * 256 + wc * 32 + 4 * fq;
#pragma unroll
    for (int ai = 0; ai < 2; ++ai)
#pragma unroll
      for (int m = 0; m < 4; ++m) {
        const int row = row0 + ai * 128 + m * 16;
        const float* xr = row < TCTX ? x_prompt + (size_t)row * D : x_sample + (size_t)(row - TCTX) * D;
        const int ci = row < TCTX ? 0 : 1 + ((row - TCTX) >> 12);
#pragma unroll
        for (int bj = 0; bj < 2; ++bj)
#pragma unroll
          for (int n = 0; n < 2; ++n) {
            const int col = col0 + bj * 128 + n * 16;
            const pg8::f32x4 a = acc[ai][bj][m][n];
            const float4 xv = *(const float4*)&xr[col];
            const float4 ga = *(const float4*)&mod[ci * 6144 + 2 * 1024 + col];
            *(float4*)&out[(size_t)row * D + col] = make_float4(xv.x + ga.x * a[0], xv.y + ga.y * a[1], xv.z + ga.z * a[2], xv.w + ga.w * a[3]);
          }
      }
  }
};
struct EpiQ {
  static constexpr bool PERM = true, AFTER_DRAIN = false;
  u16* qp;
  __device__ __forceinline__ void operator()(const pg8::f32x4 (&acc)[2][2][4][2], const pg8::Unit& u, int wr, int wc, int fr, int fq) const {
    const int row0 = u.pm * 256 + wr * 64 + fr, col0 = u.pn * 256 + wc * 32 + 8 * fq;
#pragma unroll
    for (int ai = 0; ai < 2; ++ai)
#pragma unroll
      for (int m = 0; m < 4; ++m) {
        const int row = row0 + ai * 128 + m * 16;
#pragma unroll
        for (int bj = 0; bj < 2; ++bj) {
          const int col = col0 + bj * 128;
          const pg8::f32x4 a = acc[ai][bj][m][0], b = acc[ai][bj][m][1];
          uint4 o; o.x = pack2(a[0], a[1]); o.y = pack2(a[2], a[3]); o.z = pack2(b[0], b[1]); o.w = pack2(b[2], b[3]);
          *(uint4*)&qp[(size_t)row * 2048 + col] = o;
        }
      }
  }
};
template <class Epi>
__device__ __forceinline__ void gemm_run(const u16* A, const u16* Bt, int N, const Epi& E, char* smem) {
  pg8::Gemm g; g.A = A; g.Bt = Bt; g.M = T; g.N = N; g.K = 1024;
  pg8::StaticOrder S; S.init(T, N, (int)gridDim.x, (int)blockIdx.x);
  pg8::gemm_phase<Epi, pg8::StaticOrder, false>((PG8_LAS unsigned char*)smem, g, S, E, nullptr);
  __syncthreads();
}

__device__ __forceinline__ bf16x8 tr8(LAS u16* base, int e0, int e1) {
  const s16x4 lo = __builtin_amdgcn_ds_read_tr16_b64_v4i16((LAS s16x4*)(base + e0));
  const s16x4 hi = __builtin_amdgcn_ds_read_tr16_b64_v4i16((LAS s16x4*)(base + e1));
  return __builtin_shufflevector(lo, hi, 0, 1, 2, 3, 4, 5, 6, 7);
}
__device__ __forceinline__ void mlstm_task(const P& p, int task, char* smem) {
  const int tid = threadIdx.x, lane = tid & 63, wave = tid >> 6, l15 = lane & 15, quad = lane >> 4;
  const bool lat = task < 128;
  const int id = lat ? task : task - 128;
  const int slice = id & 3, dir = (id >> 2) & 1, head = (id >> 3) & 3, bat = id >> 5;
  const int tb = lat ? TCTX + bat * 4096 : bat * 256;
  const int L = lat ? 4096 : 256;
  const int nch = L >> 6;
  const int gcol = dir * 4 + head;
  const float scale = 0.08838834764831845f;

  u16* sQ = (u16*)smem;
  u16* sK = sQ + 2 * 64 * 136;
  u16* sKw = sK + 64 * 136;
  u16* sV = sKw + 2 * 64 * 136;
  u16* sS = sV + 2 * 64 * 40;
  u16* sCt = sS + 2 * 64 * 72;
  LAS u16* lds16 = (LAS u16*)smem;
  const int oKw = 2 * 64 * 136 + 64 * 136, oV = oKw + 2 * 64 * 136;
  float* fl = (float*)(sCt + 2 * 32 * 136);
  float* sg = fl;
  float* smm = fl + 64;
  float* sa = fl + 128;
  float* semt = fl + 256;
  float* sden = fl + 384;
  float* sqn = fl + 512;
  float* sN = fl + 576;
  float* sM = fl + 832;
  float* sMMT = fl + 904;
  float* sDecay = fl + 968;
  float* sBT = fl + 1032;
  float* sGT = fl + 1096;
  float* scn = p.scan + (size_t)blockIdx.x * 12288;

  const int sbase = (bat * 2 + dir) * 4 + head;
  const bool isP = wave < 4;
  const int cw = wave - 4;
  __syncthreads();
  {
    const float big = p.b_igate[gcol], bfg = p.b_fgate[gcol];
    for (int ch = wave; ch < nch; ch += 8) {
      const int posl = ch * 64 + lane;
      const int tl = tb + (dir ? (L - 1 - posl) : posl);
      const float ig = p.gates[(size_t)tl * 16 + gcol] + big;
      const float fr = p.gates[(size_t)tl * 16 + 8 + gcol] + bfg;
      const float lf = fminf(fr, 0.f) - log1pf(expf(-fabsf(fr)));
      float b = lf;
#pragma unroll
      for (int off = 1; off < 64; off <<= 1) { float v = __shfl_up(b, off); if (lane >= off) b += v; }
      const float g = ig - b;
      float G = g;
#pragma unroll
      for (int off = 1; off < 64; off <<= 1) { float v = __shfl_up(G, off); if (lane >= off) G = fmaxf(G, v); }
      scn[ch * 64 + lane] = b; scn[4096 + ch * 64 + lane] = g; scn[8192 + ch * 64 + lane] = G;
      if (lane == 63) { sBT[ch] = b; sGT[ch] = G; }
    }
  }
  f32x4 C[2][2];
#pragma unroll
  for (int a = 0; a < 2; ++a)
#pragma unroll
    for (int vt = 0; vt < 2; ++vt) C[a][vt] = (f32x4){0.f, 0.f, 0.f, 0.f};
  if (!isP) {
    if (lat) {
#pragma unroll
      for (int a = 0; a < 2; ++a)
#pragma unroll
        for (int vt = 0; vt < 2; ++vt)
#pragma unroll
          for (int r = 0; r < 4; ++r)
            C[a][vt][r] = p.state_C[(size_t)sbase * 16384 + ((2 * cw + a) * 16 + quad * 4 + r) * 128 + slice * 32 + vt * 16 + l15];
    }
    if (tid - 256 < 128) sN[tid - 256] = lat ? p.state_n[sbase * 128 + (tid - 256)] : 0.f;
#pragma unroll
    for (int a = 0; a < 2; ++a)
#pragma unroll
      for (int vt = 0; vt < 2; ++vt) {
        uint2 o; o.x = pack2(C[a][vt][0], C[a][vt][1]); o.y = pack2(C[a][vt][2], C[a][vt][3]);
        *(uint2*)&sCt[(vt * 16 + l15) * 136 + (2 * cw + a) * 16 + quad * 4] = o;
      }
  }
  __syncthreads();
  if (wave == 0) {
    const float m0 = lat ? p.state_m[sbase] : 0.f;
    const float gt = lane < nch ? sGT[lane] : 0.f;
    float a = lane < nch ? sBT[lane] : 0.f;
    float d = lane < nch ? gt + a : -__builtin_huge_valf();
#pragma unroll
    for (int off = 1; off < 64; off <<= 1) {
      const float ap = __shfl_up(a, off), dp = __shfl_up(d, off);
      if (lane >= off) { d = fmaxf(dp + a, d); a = ap + a; }
    }
    const float m_next = fmaxf(m0 + a, d);
    float m_c = __shfl_up(m_next, 1);
    if (lane == 0) m_c = m0;
    if (lane < nch) {
      const float mmT = fmaxf(m_c, gt);
      sM[lane] = m_c; sMMT[lane] = mmT; sDecay[lane] = __expf(m_c - mmT);
    }
    if (lane == nch - 1) sM[nch] = m_next;
  }
  const int s = (tid & 255) >> 2, part = tid & 3;
  uint4 rq0, rq1, rq2, rq3, rk0, rk1, rk2, rk3, rv; float rb = 0.f, rg = 0.f, rG = 0.f;
  rq0 = rq1 = rq2 = rq3 = rk0 = rk1 = rk2 = rk3 = rv = make_uint4(0u, 0u, 0u, 0u);
#define ML_LOAD(CH)                                                                        \
  {                                                                                        \
    const int poss_ = (CH) * 64 + s;                                                       \
    const int ts_ = tb + (dir ? (L - 1 - poss_) : poss_);                                  \
    const u16* prow_ = p.proj + (size_t)ts_ * NPROJ;                                       \
    rq0 = *(const uint4*)&prow_[1536 + head * 128 + part * 32];                            \
    rq1 = *(const uint4*)&prow_[1536 + head * 128 + part * 32 + 8];                        \
    rq2 = *(const uint4*)&prow_[1536 + head * 128 + part * 32 + 16];                       \
    rq3 = *(const uint4*)&prow_[1536 + head * 128 + part * 32 + 24];                       \
    rk0 = *(const uint4*)&prow_[2048 + head * 128 + part * 32];                            \
    rk1 = *(const uint4*)&prow_[2048 + head * 128 + part * 32 + 8];                        \
    rk2 = *(const uint4*)&prow_[2048 + head * 128 + part * 32 + 16];                       \
    rk3 = *(const uint4*)&prow_[2048 + head * 128 + part * 32 + 24];                       \
    rv = *(const uint4*)&prow_[2560 + head * 128 + slice * 32 + part * 8];                 \
    rb = scn[poss_]; rg = scn[4096 + poss_]; rG = scn[8192 + poss_];                       \
  }
  __syncthreads();
  if (isP) ML_LOAD(0)

  float* hout = p.out + (size_t)dir * T * 512;
  f32x4 aqc[2];
  aqc[0] = (f32x4){0.f, 0.f, 0.f, 0.f}; aqc[1] = (f32x4){0.f, 0.f, 0.f, 0.f};
  for (int c = -1; c < nch; ++c) {
    const int n = c + 1, q = n & 1, pz = c & 1;
    if (isP) {
      if (n < nch) {
        const float m_n = sM[n], mmT = sMMT[n];
        const float mm = fmaxf(m_n, rG);
        const float w = __expf(rg - mmT);
        if (part == 0) {
          sg[s] = rg; smm[s] = mm; sa[q * 64 + s] = __expf(m_n - mm); semt[q * 64 + s] = __expf(-(rb + mm)); sden[q * 64 + s] = 0.f;
        }
        u16* dQ = sQ + q * 64 * 136;
        u16* dKw = sKw + q * 64 * 136;
        u16* dV = sV + q * 64 * 40;
        *(uint4*)&dQ[s * 136 + part * 32] = rq0;
        *(uint4*)&dQ[s * 136 + part * 32 + 8] = rq1;
        *(uint4*)&dQ[s * 136 + part * 32 + 16] = rq2;
        *(uint4*)&dQ[s * 136 + part * 32 + 24] = rq3;
        *(uint4*)&sK[s * 136 + part * 32] = rk0;
        *(uint4*)&sK[s * 136 + part * 32 + 8] = rk1;
        *(uint4*)&sK[s * 136 + part * 32 + 16] = rk2;
        *(uint4*)&sK[s * 136 + part * 32 + 24] = rk3;
#define KW_(W) pack2(lo_f(W) * w, hi_f(W) * w)
        *(uint4*)&dKw[s * 136 + part * 32] = make_uint4(KW_(rk0.x), KW_(rk0.y), KW_(rk0.z), KW_(rk0.w));
        *(uint4*)&dKw[s * 136 + part * 32 + 8] = make_uint4(KW_(rk1.x), KW_(rk1.y), KW_(rk1.z), KW_(rk1.w));
        *(uint4*)&dKw[s * 136 + part * 32 + 16] = make_uint4(KW_(rk2.x), KW_(rk2.y), KW_(rk2.z), KW_(rk2.w));
        *(uint4*)&dKw[s * 136 + part * 32 + 24] = make_uint4(KW_(rk3.x), KW_(rk3.y), KW_(rk3.z), KW_(rk3.w));
#undef KW_
        *(uint4*)&dV[s * 40 + part * 8] = rv;
        if (n + 1 < nch) ML_LOAD(n + 1)
      }
    } else {
      if (c >= 0) {
        const int ctid = tid - 256;
        const u16* cQ = sQ + pz * 64 * 136;
        const int eKw = oKw + pz * 64 * 136, eV = oV + pz * 64 * 40;
        const int tq = l15 >> 2, tp = l15 & 3;
        const u16* cCt = sCt + pz * 32 * 136;
        u16* nCt = sCt + (pz ^ 1) * 32 * 136;
        const float* cN = sN + pz * 128;
        float* nN = sN + (pz ^ 1) * 128;
        {
          const int t = ctid >> 2, pt = ctid & 3;
          float qn = 0.f;
#pragma unroll
          for (int i = 0; i < 4; ++i) {
            const uint4 qv = *(const uint4*)&cQ[t * 136 + pt * 32 + i * 8];
            const float4 n0 = *(const float4*)&cN[pt * 32 + i * 8];
            const float4 n1 = *(const float4*)&cN[pt * 32 + i * 8 + 4];
            qn += lo_f(qv.x) * n0.x + hi_f(qv.x) * n0.y + lo_f(qv.y) * n0.z + hi_f(qv.y) * n0.w
                + lo_f(qv.z) * n1.x + hi_f(qv.z) * n1.y + lo_f(qv.w) * n1.z + hi_f(qv.w) * n1.w;
          }
          qn += __int_as_float(__builtin_amdgcn_update_dpp(0, __float_as_int(qn), 0xB1, 0xF, 0xF, true));
          qn += __int_as_float(__builtin_amdgcn_update_dpp(0, __float_as_int(qn), 0x4E, 0xF, 0xF, true));
          if (pt == 0) sqn[t] = qn * scale;
        }
        const int trow = cw * 16 + l15;
#pragma unroll
        for (int ti = 0; ti < 2; ++ti) {
          f32x4 acc = (f32x4){0.f, 0.f, 0.f, 0.f};
#pragma unroll
          for (int ks = 0; ks < 4; ++ks) {
            bf16x8 afr = *(const bf16x8*)&cCt[(ti * 16 + l15) * 136 + ks * 32 + quad * 8];
            bf16x8 bfr = *(const bf16x8*)&cQ[trow * 136 + ks * 32 + quad * 8];
            acc = mfma16(afr, bfr, acc);
          }
          aqc[ti] = acc;
        }
        const float decay = sDecay[c];
        const bf16x8 ones = (bf16x8){0x3F80, 0x3F80, 0x3F80, 0x3F80, 0x3F80, 0x3F80, 0x3F80, 0x3F80};
        bf16x8 vfr[2][2];
#pragma unroll
        for (int vt = 0; vt < 2; ++vt)
#pragma unroll
          for (int ks = 0; ks < 2; ++ks) {
            const int s0 = ks * 32 + quad * 8;
            vfr[vt][ks] = tr8(lds16, eV + (s0 + tq) * 40 + vt * 16 + 4 * tp, eV + (s0 + 4 + tq) * 40 + vt * 16 + 4 * tp);
          }
#pragma unroll
        for (int a = 0; a < 2; ++a) {
          const int kt = 2 * cw + a;
          bf16x8 kfr[2];
#pragma unroll
          for (int ks = 0; ks < 2; ++ks) {
            const int s0 = ks * 32 + quad * 8;
            kfr[ks] = tr8(lds16, eKw + (s0 + tq) * 136 + kt * 16 + 4 * tp, eKw + (s0 + 4 + tq) * 136 + kt * 16 + 4 * tp);
          }
          f32x4 accn = (f32x4){0.f, 0.f, 0.f, 0.f};
          accn = mfma16(kfr[0], ones, accn);
          accn = mfma16(kfr[1], ones, accn);
#pragma unroll
          for (int vt = 0; vt < 2; ++vt) {
            C[a][vt][0] *= decay; C[a][vt][1] *= decay; C[a][vt][2] *= decay; C[a][vt][3] *= decay;
            C[a][vt] = mfma16(kfr[0], vfr[vt][0], C[a][vt]);
            C[a][vt] = mfma16(kfr[1], vfr[vt][1], C[a][vt]);
            uint2 o; o.x = pack2(C[a][vt][0], C[a][vt][1]); o.y = pack2(C[a][vt][2], C[a][vt][3]);
            *(uint2*)&nCt[(vt * 16 + l15) * 136 + kt * 16 + quad * 4] = o;
          }
          if (l15 == 0) {
#pragma unroll
            for (int r = 0; r < 4; ++r) {
              const int idx = kt * 16 + quad * 4 + r;
              nN[idx] = decay * cN[idx] + accn[r];
            }
          }
        }
      }
    }
    asm volatile("s_waitcnt lgkmcnt(0)" ::: "memory"); __builtin_amdgcn_s_barrier(); asm volatile("" ::: "memory");
    if (isP) {
      if (n < nch) {
        const u16* dQ = sQ + q * 64 * 136;
        u16* dS = sS + q * 64 * 72;
        const int trow = wave * 16 + l15;
        const float mmt = smm[trow];
        float psum = 0.f;
#pragma unroll
        for (int si = 0; si < 4; ++si) {
          const int s0 = si * 16 + quad * 4;
          uint2 o = make_uint2(0u, 0u);
          if (si <= wave) {
            f32x4 acc = (f32x4){0.f, 0.f, 0.f, 0.f};
#pragma unroll
            for (int ks = 0; ks < 4; ++ks) {
              bf16x8 afr = *(const bf16x8*)&sK[(si * 16 + l15) * 136 + ks * 32 + quad * 8];
              bf16x8 bfr = *(const bf16x8*)&dQ[trow * 136 + ks * 32 + quad * 8];
              acc = mfma16(afr, bfr, acc);
            }
            float vals[4];
#pragma unroll
            for (int r = 0; r < 4; ++r) {
              const int sidx = s0 + r;
              const float e = __expf(fminf(sg[sidx] - mmt, 0.f));
              vals[r] = (sidx <= trow) ? acc[r] * scale * e : 0.f;
              psum += vals[r];
            }
            o.x = pack2(vals[0], vals[1]); o.y = pack2(vals[2], vals[3]);
          }
          *(uint2*)&dS[trow * 72 + s0] = o;
        }
        atomicAdd(&sden[q * 64 + trow], psum);
      }
    } else {
      if (c >= 0) {
        const int eV = oV + pz * 64 * 40;
        const int tq = l15 >> 2, tp = l15 & 3;
        const u16* cS = sS + pz * 64 * 72;
        const int trow = cw * 16 + l15;
        const float a_t = sa[pz * 64 + trow];
        const float den = a_t * sqn[trow] + sden[pz * 64 + trow];
        const float inv = 1.f / fmaxf(fabsf(den), semt[pz * 64 + trow]);
        const float as = a_t * scale;
        const int post = c * 64 + trow;
        const int tt = tb + (dir ? (L - 1 - post) : post);
#pragma unroll
        for (int ti = 0; ti < 2; ++ti) {
          f32x4 asv = (f32x4){0.f, 0.f, 0.f, 0.f};
#pragma unroll
          for (int ks = 0; ks < 2; ++ks) {
            const int s0 = ks * 32 + quad * 8;
            bf16x8 afr = tr8(lds16, eV + (s0 + tq) * 40 + ti * 16 + 4 * tp, eV + (s0 + 4 + tq) * 40 + ti * 16 + 4 * tp);
            bf16x8 bfr = *(const bf16x8*)&cS[trow * 72 + ks * 32 + quad * 8];
            asv = mfma16(afr, bfr, asv);
          }
          float4 h = make_float4((as * aqc[ti][0] + asv[0]) * inv, (as * aqc[ti][1] + asv[1]) * inv,
                                 (as * aqc[ti][2] + asv[2]) * inv, (as * aqc[ti][3] + asv[3]) * inv);
          *(float4*)&hout[(size_t)tt * 512 + head * 128 + slice * 32 + ti * 16 + quad * 4] = h;
        }
      }
    }
    asm volatile("s_waitcnt lgkmcnt(0)" ::: "memory"); __builtin_amdgcn_s_barrier(); asm volatile("" ::: "memory");
  }
#undef ML_LOAD
  if (!lat && !isP) {
    float* newC = p.out + (size_t)T * D;
    float* newn = newC + (size_t)32 * 2 * 4 * 128 * 128;
    float* newm = newn + 32 * 2 * 4 * 128;
#pragma unroll
    for (int a = 0; a < 2; ++a)
#pragma unroll
      for (int vt = 0; vt < 2; ++vt)
#pragma unroll
        for (int r = 0; r < 4; ++r)
          newC[(size_t)sbase * 16384 + ((2 * cw + a) * 16 + quad * 4 + r) * 128 + slice * 32 + vt * 16 + l15] = C[a][vt][r];
    if (slice == 0) {
      const int ctid = tid - 256;
      if (ctid < 128) newn[sbase * 128 + ctid] = sN[(nch & 1) * 128 + ctid];
      if (ctid == 0) newm[sbase] = sM[nch];
    }
  }
}

__device__ __forceinline__ void phase_mlstm(const P& p, char* smem) {
  const int G = gridDim.x, b = blockIdx.x;
  if (G >= 256) {
    if (b < 128) mlstm_task(p, b, smem);
    else {
      for (int task = b; task < 1152; task += G - 128) mlstm_task(p, task, smem);
      if (p.conv_early) convert_tables(p, b - 128, G - 128);
    }
  } else {
    for (int task = b; task < 1152; task += G) mlstm_task(p, task, smem);
    if (p.conv_early) convert_tables(p, b, G);
  }
}

__device__ __forceinline__ void phase_mix(const P& p) {
  const int wave = threadIdx.x >> 6, lane = threadIdx.x & 63;
  for (int t = blockIdx.x * 8 + wave; t < T; t += gridDim.x * 8) {
    const u16* pr = p.proj + (size_t)t * NPROJ;
    const int seg = t < TCTX ? 256 : 64;
    const int pos = (t < TCTX ? t : t - TCTX) & (seg - 1);
    const bool hasL = pos > 0, hasR = pos < seg - 1;
    const int c0 = lane * 8;
    const uint4 zero4 = make_uint4(0u, 0u, 0u, 0u);
    const uint4 bg = *(const uint4*)&pr[c0];
    const uint4 cgC = *(const uint4*)&pr[512 + c0];
    const uint4 xgC = *(const uint4*)&pr[1024 + c0];
    const uint4 cgL = hasL ? *(const uint4*)&pr[-NPROJ + 512 + c0] : zero4;
    const uint4 xgL = hasL ? *(const uint4*)&pr[-NPROJ + 1024 + c0] : zero4;
    const uint4 cgR = hasR ? *(const uint4*)&pr[NPROJ + 512 + c0] : zero4;
    const uint4 xgR = hasR ? *(const uint4*)&pr[NPROJ + 1024 + c0] : zero4;
    const unsigned bgw[4] = {bg.x, bg.y, bg.z, bg.w};
    const unsigned cC[4] = {cgC.x, cgC.y, cgC.z, cgC.w}, xC[4] = {xgC.x, xgC.y, xgC.z, xgC.w};
    const unsigned cL[4] = {cgL.x, cgL.y, cgL.z, cgL.w}, xL[4] = {xgL.x, xgL.y, xgL.z, xgL.w};
    const unsigned cR[4] = {cgR.x, cgR.y, cgR.z, cgR.w}, xR[4] = {xgR.x, xgR.y, xgR.z, xgR.w};
    unsigned ow[4];
#pragma unroll
    for (int j = 0; j < 4; ++j) {
      const int ch = c0 + 2 * j;
      float w0a = p.conv_w[ch], w1a = p.conv_w[512 + ch], w2a = p.conv_w[1024 + ch], ba = p.conv_b[ch];
      float w0b = p.conv_w[ch + 1], w1b = p.conv_w[512 + ch + 1], w2b = p.conv_w[1024 + ch + 1], bb = p.conv_b[ch + 1];
      float ya = w0a * (lo_f(cL[j]) * lo_f(xL[j])) + w1a * (lo_f(cC[j]) * lo_f(xC[j])) + w2a * (lo_f(cR[j]) * lo_f(xR[j])) + ba;
      float yb = w0b * (hi_f(cL[j]) * hi_f(xL[j])) + w1b * (hi_f(cC[j]) * hi_f(xC[j])) + w2b * (hi_f(cR[j]) * hi_f(xR[j])) + bb;
      ow[j] = pack2(lo_f(bgw[j]) * ya, hi_f(bgw[j]) * yb);
    }
    *(uint4*)&p.hbuf[(size_t)t * D + c0] = make_uint4(ow[0], ow[1], ow[2], ow[3]);
    const float* hf = p.out + (size_t)t * 512 + c0;
    const float* hb = p.out + (size_t)T * 512 + (size_t)t * 512 + c0;
    const float4 f0 = *(const float4*)&hf[0], f1 = *(const float4*)&hf[4];
    const float4 b0 = *(const float4*)&hb[0], b1 = *(const float4*)&hb[4];
    float h[8] = {f0.x + b0.x, f0.y + b0.y, f0.z + b0.z, f0.w + b0.w, f1.x + b1.x, f1.y + b1.y, f1.z + b1.z, f1.w + b1.w};
    float ss = 0.f;
#pragma unroll
    for (int j = 0; j < 8; ++j) ss += h[j] * h[j];
    ss += __shfl_xor(ss, 1); ss += __shfl_xor(ss, 2); ss += __shfl_xor(ss, 4); ss += __shfl_xor(ss, 8);
    const float r = rsqrtf(ss * (1.f / 128.f) + EPS);
    const uint4 og = *(const uint4*)&pr[3072 + c0];
    const unsigned ogw[4] = {og.x, og.y, og.z, og.w};
    unsigned mw[4];
#pragma unroll
    for (int j = 0; j < 4; ++j) {
      float ga = p.g_mlstm[c0 + 2 * j], gb = p.g_mlstm[c0 + 2 * j + 1];
      float oa = lo_f(ogw[j]), ob = hi_f(ogw[j]);
      float sa_ = 1.f / (1.f + expf(-oa)), sb_ = 1.f / (1.f + expf(-ob));
      mw[j] = pack2(h[2 * j] * r * ga * sa_, h[2 * j + 1] * r * gb * sb_);
    }
    *(uint4*)&p.hbuf[(size_t)t * D + 512 + c0] = make_uint4(mw[0], mw[1], mw[2], mw[3]);
  }
}

__device__ __forceinline__ unsigned f2key(float f) {
  const unsigned u = __float_as_uint(f);
  return (u & 0x80000000u) ? ~u : (u | 0x80000000u);
}
__device__ __forceinline__ float key2f(unsigned k, unsigned mask) {
  const unsigned m = k & ~mask;
  const unsigned u = (m & 0x80000000u) ? (m & 0x7fffffffu) : ~m;
  return __uint_as_float(u);
}
#define KINSERT(LIST, KEY)                                   \
  {                                                          \
    unsigned kk_ = (KEY);                                    \
    _Pragma("unroll") for (int j_ = 0; j_ < 16; ++j_) {      \
      const unsigned hi_ = max(LIST[j_], kk_);               \
      kk_ = min(LIST[j_], kk_);                              \
      LIST[j_] = hi_;                                        \
    }                                                        \
  }

__device__ __forceinline__ void bsort16_desc(unsigned (&a)[16]) {
#pragma unroll
  for (int k = 2; k <= 16; k <<= 1) {
#pragma unroll
    for (int j = k >> 1; j > 0; j >>= 1) {
#pragma unroll
      for (int i = 0; i < 16; ++i) {
        const int l = i ^ j;
        if (l > i) {
          const unsigned hi = max(a[i], a[l]), lo = min(a[i], a[l]);
          if ((i & k) == 0) { a[i] = hi; a[l] = lo; } else { a[i] = lo; a[l] = hi; }
        }
      }
    }
  }
}
__device__ __forceinline__ void bmerge16_desc(unsigned (&a)[16]) {
#pragma unroll
  for (int j = 8; j > 0; j >>= 1) {
#pragma unroll
    for (int i = 0; i < 16; ++i) {
      const int l = i ^ j;
      if (l > i) { const unsigned hi = max(a[i], a[l]), lo = min(a[i], a[l]); a[i] = hi; a[l] = lo; }
    }
  }
}
__device__ __forceinline__ void top16_merge(unsigned (&L)[16], const unsigned (&G)[16]) {
#pragma unroll
  for (int i = 0; i < 16; ++i) L[i] = max(L[i], G[15 - i]);
  bmerge16_desc(L);
}
__device__ constexpr int PEER_PA[64] = {0, 0, 0, 0, 0, 0, 0, 0, 0, 0, 0, 0, 0, 0, 0, 0, 1, 1, 1, 1, 1, 1, 1, 1, 2, 2, 2, 2, 2, 3, 3, 3, 3, 4, 4, 4, 5, 5, 6, 6, 7, 7, 8, 9, 10, 11, 12, 13, 14, 15, -1, -1, -1, -1, -1, -1, -1, -1, -1, -1, -1, -1, -1, -1};
__device__ constexpr int PEER_PB[64] = {0, 1, 2, 3, 4, 5, 6, 7, 8, 9, 10, 11, 12, 13, 14, 15, 0, 1, 2, 3, 4, 5, 6, 7, 0, 1, 2, 3, 4, 0, 1, 2, 3, 0, 1, 2, 0, 1, 0, 1, 0, 1, 0, 0, 0, 0, 0, 0, 0, 0, 0, 0, 0, 0, 0, 0, 0, 0, 0, 0, 0, 0, 0, 0};
#define SBAR __builtin_amdgcn_sched_barrier(0)
__device__ __forceinline__ int launder(int v) { asm volatile("" : "+v"(v)); return v; }
#define G_ISSUE(BUF, TAB, IDS)                                                 \
  _Pragma("unroll") for (int i_ = 0; i_ < 16; ++i_) {                          \
    const int e_ = __builtin_amdgcn_readlane(IDS, i_);                         \
    BUF[i_] = *(const uint4*)&(TAB)[(size_t)e_ * D + lane * 16];               \
  }
#define U_DW(DW, J)                                                                        \
  acc_ = __builtin_elementwise_fma(__builtin_amdgcn_cvt_pk_f32_fp8(DW, false), hp[2 * (J)], acc_);      \
  acc_ = __builtin_elementwise_fma(__builtin_amdgcn_cvt_pk_f32_fp8(DW, true), hp[2 * (J) + 1], acc_);
#define G_DOTU(BUF)                                                            \
  _Pragma("unroll") for (int i_ = 0; i_ < 16; ++i_) {                          \
    f2v acc_ = (f2v){0.f, 0.f};                                                \
    U_DW(BUF[i_].x, 0) U_DW(BUF[i_].y, 1) U_DW(BUF[i_].z, 2) U_DW(BUF[i_].w, 3) \
    pa[i_] = acc_.x + acc_.y;                                                  \
  }
#define V_DW(DW, J)                                                                        \
  o2[2 * (J)] = __builtin_elementwise_fma(__builtin_amdgcn_cvt_pk_f32_fp8(DW, false), wv_, o2[2 * (J)]);      \
  o2[2 * (J) + 1] = __builtin_elementwise_fma(__builtin_amdgcn_cvt_pk_f32_fp8(DW, true), wv_, o2[2 * (J) + 1]);
#define G_ACCV(BUF)                                                            \
  _Pragma("unroll") for (int i_ = 0; i_ < 16; ++i_) {                          \
    const float w_ = __int_as_float(__builtin_amdgcn_readlane(wbits, i_));     \
    const f2v wv_ = (f2v){w_, w_};                                             \
    V_DW(BUF[i_].x, 0) V_DW(BUF[i_].y, 1) V_DW(BUF[i_].z, 2) V_DW(BUF[i_].w, 3) \
  }

__device__ __forceinline__ float gelu_as(float v) {
  const float av = fabsf(v);
  const float t = __builtin_amdgcn_rcpf(av * 0.2316418882f + 1.0f);
  float q = t * 0.5307027145f + (-0.7265760135f);
  q = q * t + 0.7107068705f; q = q * t + (-0.142248368f); q = q * t + 0.127414796f; q = q * t;
  const float e = __builtin_amdgcn_exp2f((v * v) * (-0.72134752044f));
  const float m = v * (q * e);
  return v < 0.f ? m : v - m;
}
#define G_DOTU_MFMA(BUF)                                                                   \
  _Pragma("unroll") for (int i_ = 0; i_ < 16; ++i_) {                                      \
    const long alo_ = (long)(((unsigned long long)BUF[i_].y << 32) | (unsigned long long)BUF[i_].x); \
    const long ahi_ = (long)(((unsigned long long)BUF[i_].w << 32) | (unsigned long long)BUF[i_].z); \
    f32x4 d_ = (f32x4){0.f, 0.f, 0.f, 0.f};                                                \
    d_ = __builtin_amdgcn_mfma_f32_16x16x32_fp8_fp8(alo_, h8lo, d_, 0, 0, 0);              \
    d_ = __builtin_amdgcn_mfma_f32_16x16x32_fp8_fp8(ahi_, h8hi, d_, 0, 0, 0);              \
    const float s01_ = dsel1 ? d_[1] : d_[0];                                              \
    const float s23_ = dsel1 ? d_[3] : d_[2];                                              \
    pa[i_] = diag ? (dsel2 ? s23_ : s01_) : 0.f;                                           \
  }
#define DPPF(X, CTRL) __int_as_float(__builtin_amdgcn_update_dpp(0, __float_as_int(X), CTRL, 0xF, 0xF, true))
#define REDUCE16(PA, Q1)                                                                   \
  {                                                                                        \
    float q8_[8], q4_[4], q2_[2];                                                          \
    const bool b3_ = (lane & 8) != 0, b2_ = (lane & 4) != 0, b1_ = (lane & 2) != 0, b0_ = (lane & 1) != 0; \
    _Pragma("unroll") for (int i_ = 0; i_ < 8; ++i_) { const float k_ = b3_ ? PA[i_ + 8] : PA[i_]; const float s_ = b3_ ? PA[i_] : PA[i_ + 8]; q8_[i_] = k_ + DPPF(s_, 0x128);   } \
    _Pragma("unroll") for (int i_ = 0; i_ < 4; ++i_) { const float k_ = b2_ ? q8_[i_ + 4] : q8_[i_]; const float s_ = b2_ ? q8_[i_] : q8_[i_ + 4]; q4_[i_] = k_ + __shfl_xor(s_, 4); } \
    _Pragma("unroll") for (int i_ = 0; i_ < 2; ++i_) { const float k_ = b1_ ? q4_[i_ + 2] : q4_[i_]; const float s_ = b1_ ? q4_[i_] : q4_[i_ + 2]; q2_[i_] = k_ + DPPF(s_, 0x4E);   } \
    { const float k_ = b0_ ? q2_[1] : q2_[0]; const float s_ = b0_ ? q2_[0] : q2_[1]; Q1 = k_ + DPPF(s_, 0xB1);   } \
    Q1 += __shfl_xor(Q1, 16); Q1 += __shfl_xor(Q1, 32);                                    \
  }
#define U_HEAD(BUF, IDS, SUI, SVI, HEAD)                                                   \
  {                                                                                        \
    float pa[16]; G_DOTU(BUF)                                                              \
    float q1_; REDUCE16(pa, q1_)                                                           \
    const float av_ = q1_ * (SUI);                                                         \
    const float ge_ = 0.5f * av_ * (1.f + erff(av_ * 0.7071067811865476f));                \
    const float w_ = sG[(tok * 8 + (HEAD)) * 16 + l15] * ge_ * (SVI);                      \
    if (lane < 16) { p.wbuf[(size_t)t * 128 + (HEAD) * 16 + lane] = w_; p.ibuf[(size_t)t * 128 + (HEAD) * 16 + lane] = (IDS); } \
  }

__device__ __forceinline__ void phase_peer(const P& p, char* smem) {
  unsigned* sc = (unsigned*)smem;
  unsigned* skey = sc + 256 * 130;
  int* sE = (int*)sc;
  float* sG = (float*)(sc + 2048);
  for (int it = blockIdx.x; it < T / 16; it += gridDim.x) {
    const int t0 = it * 16;
    __syncthreads();
    {
      const int tid = launder(threadIdx.x), lane = tid & 63, wave = tid >> 6, l15 = lane & 15, quad = lane >> 4;
      const int half = wave >> 2;
      const u16* kb = p.kb + half * 16384;
#pragma unroll 1
      for (int hh = 0; hh < 2; ++hh) {
        const int head = (wave & 3) * 2 + hh;
        bf16x8 qf[4];
#pragma unroll
        for (int ks = 0; ks < 4; ++ks)
          qf[ks] = *(const bf16x8*)&p.qp[(size_t)(t0 + l15) * 2048 + head * 256 + half * 128 + ks * 32 + quad * 8];
        const int row = (head * 2 + half) * 16 + l15;
#pragma unroll 1
        for (int nt = 0; nt < 8; ++nt) {
          f32x4 acc = (f32x4){0.f, 0.f, 0.f, 0.f};
#pragma unroll
          for (int ks = 0; ks < 4; ++ks) {
            bf16x8 kf = *(const bf16x8*)&kb[(nt * 16 + l15) * 128 + ks * 32 + quad * 8];
            acc = mfma16(kf, qf[ks], acc);
          }
          const int key = nt * 16 + quad * 4;
          const int pos = key + (key >= 64 ? 1 : 0);
#pragma unroll
          for (int r = 0; r < 4; ++r) sc[row * 130 + pos + r] = (f2key(acc[r]) & ~0x7Fu) | (unsigned)(127 - (key + r));
        }
      }
    }
    __syncthreads();
    {
      const int tid = launder(threadIdx.x);
      const int row = tid >> 1, hs = tid & 1;
      const unsigned* src = sc + row * 130 + hs * 65;
      unsigned list[16];
#pragma unroll
      for (int j = 0; j < 16; ++j) list[j] = src[j];
      bsort16_desc(list);
#pragma unroll 1
      for (int g = 1; g < 4; ++g) {
        unsigned grp[16];
#pragma unroll
        for (int j = 0; j < 16; ++j) grp[j] = src[g * 16 + j];
        bsort16_desc(grp);
        top16_merge(list, grp);
      }
      {
        unsigned other[16];
#pragma unroll
        for (int j = 0; j < 16; ++j) other[j] = __shfl_xor(list[j], 1);
        top16_merge(list, other);
      }
      if (hs == 0) {
#pragma unroll
        for (int j = 0; j < 16; ++j) skey[row * 16 + j] = list[j];
      }
    }
    __syncthreads();
    if (threadIdx.x < 128) {
      const int tid = launder(threadIdx.x);
      const int tok = tid & 15, head = tid >> 4;
      const int ra = (head * 2) * 16 + tok, rb = ra + 16;
      float v1[16], v2[16];
#pragma unroll
      for (int a = 0; a < 16; ++a) { v1[a] = key2f(skey[ra * 16 + a], 0x7Fu); v2[a] = key2f(skey[rb * 16 + a], 0x7Fu); }
      unsigned list[16];
#define CKEY(I) ((PEER_PA[I] < 0) ? 0u : ((f2key(v1[PEER_PA[I] < 0 ? 0 : PEER_PA[I]] + v2[PEER_PB[I]]) & ~0xFFu) | (unsigned)(255 - ((PEER_PA[I] < 0 ? 0 : PEER_PA[I]) * 16 + PEER_PB[I]))))
#pragma unroll
      for (int j = 0; j < 16; ++j) list[j] = CKEY(j);
      bsort16_desc(list);
#pragma unroll
      for (int g = 1; g < 4; ++g) {
        unsigned grp[16];
#pragma unroll
        for (int j = 0; j < 16; ++j) grp[j] = CKEY(g * 16 + j);
        bsort16_desc(grp);
        top16_merge(list, grp);
      }
#undef CKEY
      const float smax = key2f(list[0], 0xFFu);
      float ex[16];
      float se = 0.f;
#pragma unroll
      for (int q = 0; q < 16; ++q) { ex[q] = expf(key2f(list[q], 0xFFu) - smax); se += ex[q]; }
      const float inv = 1.f / se;
#pragma unroll
      for (int q = 0; q < 16; ++q) {
        const int flat = 255 - (int)(list[q] & 0xFFu);
        const int i1 = 127 - (int)(skey[ra * 16 + (flat >> 4)] & 0x7Fu);
        const int i2 = 127 - (int)(skey[rb * 16 + (flat & 15)] & 0x7Fu);
        sE[(tok * 8 + head) * 16 + q] = i1 * 128 + i2;
        sG[(tok * 8 + head) * 16 + q] = ex[q] * inv;
      }
    }
    __syncthreads();
    {
      const int tid = threadIdx.x;
#pragma unroll
      for (int i = 0; i < 4; ++i) {
        const int idx = i * NT + tid;
        p.ibuf[(size_t)t0 * 128 + idx] = sE[idx];
        p.wbuf[(size_t)t0 * 128 + idx] = sG[idx];
      }
    }
  }
}

__device__ __forceinline__ void phase_peer_u(const P& p, char* smem) {
  const int lane = threadIdx.x & 63, wave = threadIdx.x >> 6, l15 = lane & 15;
  int* lid = (int*)(smem + wave * 1536);
  int* lent = lid + 128;
  float* lg = (float*)(lent + 128);
  const int Gn = gridDim.x, bb = blockIdx.x;
  const int ngrp = bb < T / 16 ? (T / 16 - bb + Gn - 1) / Gn : 0;
  const int nseq = 2 * ngrp;
#define SEQ_TOK(S) (((bb + ((S) >> 1) * Gn) << 4) + wave * 2 + ((S) & 1))
#pragma unroll 1
  for (int r = launder(0); r < 2; ++r) {
    __syncthreads();
    int ids8n[8]; float g8n[8]; uint4 hxn0 = make_uint4(0u, 0u, 0u, 0u), hxn1 = make_uint4(0u, 0u, 0u, 0u);
#pragma unroll
    for (int h = 0; h < 8; ++h) { ids8n[h] = 0; g8n[h] = 0.f; }
    {
      const int tf = SEQ_TOK(0);
      if (nseq > 0) {
#pragma unroll
        for (int h = 0; h < 8; ++h) { ids8n[h] = p.ibuf[(size_t)tf * 128 + h * 16 + l15]; g8n[h] = p.wbuf[(size_t)tf * 128 + h * 16 + l15]; }
        hxn0 = *(const uint4*)&p.hbuf[(size_t)tf * D + lane * 16];
        hxn1 = *(const uint4*)&p.hbuf[(size_t)tf * D + lane * 16 + 8];
      }
    }
#pragma unroll 1
    for (int sq = 0; sq < nseq; ++sq) {
      const int t = SEQ_TOK(sq);
      int n = 0;
      const uint4 hx0 = hxn0, hx1 = hxn1;
      {
        int ids8[8]; float g8[8];
#pragma unroll
        for (int h = 0; h < 8; ++h) { ids8[h] = ids8n[h]; g8[h] = g8n[h]; }
        {
          const int tn = SEQ_TOK(sq + 1);
          if (sq + 1 < nseq) {
#pragma unroll
            for (int h = 0; h < 8; ++h) { ids8n[h] = p.ibuf[(size_t)tn * 128 + h * 16 + l15]; g8n[h] = p.wbuf[(size_t)tn * 128 + h * 16 + l15]; }
            hxn0 = *(const uint4*)&p.hbuf[(size_t)tn * D + lane * 16];
            hxn1 = *(const uint4*)&p.hbuf[(size_t)tn * D + lane * 16 + 8];
          }
        }
        asm volatile("s_waitcnt lgkmcnt(0)" ::: "memory");
#pragma unroll
        for (int h = 0; h < 8; ++h) {
          const bool valid = ((ids8[h] >> 13) & 1) == r;
          const unsigned m16 = (unsigned)__ballot(valid) & 0xFFFFu;
          const int pos = n + __builtin_popcount(m16 & ((1u << l15) - 1u));
          if (lane < 16 && valid) { lid[pos] = ids8[h]; lent[pos] = h * 16 + l15; lg[pos] = g8[h]; }
          n += __builtin_popcount(m16);
        }
        asm volatile("s_waitcnt lgkmcnt(0)" ::: "memory");
      }
      n = __builtin_amdgcn_readfirstlane(n);
      if (n == 0) continue;
      long h8lo, h8hi; float hinv;
      {
        const unsigned hw[8] = {hx0.x, hx0.y, hx0.z, hx0.w, hx1.x, hx1.y, hx1.z, hx1.w};
        float amax = 0.f;
#pragma unroll
        for (int j = 0; j < 8; ++j) amax = fmaxf(amax, fmaxf(fabsf(lo_f(hw[j])), fabsf(hi_f(hw[j]))));
#pragma unroll
        for (int o = 32; o > 0; o >>= 1) amax = fmaxf(amax, __shfl_xor(amax, o));
        const float hs = amax > 0.f ? 384.f / amax : 1.f;
        hinv = amax > 0.f ? amax * (1.f / 384.f) : 1.f;
        unsigned q[4];
#pragma unroll
        for (int j = 0; j < 4; ++j) {
          unsigned pk = 0u;
          pk = __builtin_amdgcn_cvt_pk_fp8_f32(lo_f(hw[2 * j]) * hs, hi_f(hw[2 * j]) * hs, pk, false);
          pk = __builtin_amdgcn_cvt_pk_fp8_f32(lo_f(hw[2 * j + 1]) * hs, hi_f(hw[2 * j + 1]) * hs, pk, true);
          q[j] = pk;
        }
        h8lo = (long)(((unsigned long long)q[1] << 32) | (unsigned long long)q[0]);
        h8hi = (long)(((unsigned long long)q[3] << 32) | (unsigned long long)q[2]);
      }
      const bool diag = (l15 >> 2) == (lane >> 4);
      const bool dsel1 = (l15 & 1) != 0, dsel2 = (l15 & 2) != 0;
      const int nu = (n + 15) >> 4;
      uint4 A[16], B[16];
#define U2_DESC(U, IDS, ENT, GT, SUI, SVI, OK)                                   \
      {                                                                         \
        const int j_ = (U) * 16 + l15;                                          \
        OK = j_ < n;                                                            \
        const int jc_ = OK ? j_ : 0;                                            \
        IDS = lid[jc_]; ENT = lent[jc_]; GT = lg[jc_];                          \
        SUI = p.sinv[IDS]; SVI = p.sinv[16384 + IDS];                           \
      }
#define U2_FIN(BUF, ENT, GT, SUI, SVI, OK)                                       \
      {                                                                         \
        float pa[16]; G_DOTU_MFMA(BUF)                                          \
        float q1_; REDUCE16(pa, q1_)                                            \
        const float av_ = q1_ * (SUI) * hinv;                                   \
        const float ge_ = gelu_as(av_);                                         \
        if (lane < 16 && (OK)) p.wbuf[(size_t)t * 128 + (ENT)] = (GT) * ge_ * (SVI); \
      }
      int idsA, entA, idsB = 0, entB = 0; float gA, suA, svA, gB = 0.f, suB = 0.f, svB = 0.f; bool okA, okB = false;
      U2_DESC(0, idsA, entA, gA, suA, svA, okA)
      G_ISSUE(A, p.ub8, idsA)
      SBAR;
#pragma unroll 1
      for (int u = 0; u < nu; u += 2) {
        const bool hasB = u + 1 < nu;
        if (hasB) { U2_DESC(u + 1, idsB, entB, gB, suB, svB, okB) G_ISSUE(B, p.ub8, idsB) }
        SBAR;
        U2_FIN(A, entA, gA, suA, svA, okA)
        SBAR;
        if (u + 2 < nu) { U2_DESC(u + 2, idsA, entA, gA, suA, svA, okA) G_ISSUE(A, p.ub8, idsA) }
        SBAR;
        if (hasB) { U2_FIN(B, entB, gB, suB, svB, okB) }
        SBAR;
      }
#undef U2_DESC
#undef U2_FIN
    }
  }
}

__device__ __forceinline__ void phase_peer_v(const P& p) {
  const int lane = threadIdx.x & 63, wave = threadIdx.x >> 6, l15 = lane & 15;
  const int tstride = gridDim.x * 8;
  int ids8n[8]; float w8n[8];
  {
    const int t0 = blockIdx.x * 8 + wave;
#pragma unroll
    for (int h = 0; h < 8; ++h) { ids8n[h] = 0; w8n[h] = 0.f; }
    if (t0 < T) {
#pragma unroll
      for (int h = 0; h < 8; ++h) { ids8n[h] = p.ibuf[(size_t)t0 * 128 + h * 16 + l15]; w8n[h] = p.wbuf[(size_t)t0 * 128 + h * 16 + l15]; }
    }
  }
#pragma unroll 1
  for (int t = blockIdx.x * 8 + wave; t < T; t += tstride) {
    int ids8[8]; float w8[8];
#pragma unroll
    for (int h = 0; h < 8; ++h) { ids8[h] = ids8n[h]; w8[h] = w8n[h]; }
    if (t + tstride < T) {
#pragma unroll
      for (int h = 0; h < 8; ++h) { ids8n[h] = p.ibuf[(size_t)(t + tstride) * 128 + h * 16 + l15]; w8n[h] = p.wbuf[(size_t)(t + tstride) * 128 + h * 16 + l15]; }
    }
    f2v o2[8];
#pragma unroll
    for (int j = 0; j < 8; ++j) o2[j] = (f2v){0.f, 0.f};
    uint4 A[16], B[16];
    G_ISSUE(A, p.vb8, ids8[0])
    SBAR;
#pragma unroll
    for (int h = 0; h < 8; ++h) {
      const int wbits = __float_as_int(w8[h]);
      if ((h & 1) == 0) {
        if (h < 7) { G_ISSUE(B, p.vb8, ids8[(h + 1) & 7]) }
        SBAR;
        G_ACCV(A)
      } else {
        if (h < 7) { G_ISSUE(A, p.vb8, ids8[(h + 1) & 7]) }
        SBAR;
        G_ACCV(B)
      }
      SBAR;
    }
    float o[16];
#pragma unroll
    for (int j = 0; j < 8; ++j) { o[2 * j] = o2[j].x; o[2 * j + 1] = o2[j].y; }
    const int ci = t < TCTX ? 0 : 1 + ((t - TCTX) >> 12);
    const float* ga2 = p.mod + ci * 6144 + 5 * 1024;
    float* xr = p.out + (size_t)t * D;
    float x2[16];
    float ss = 0.f;
#pragma unroll
    for (int q = 0; q < 4; ++q) {
      const int col = lane * 16 + q * 4;
      const float4 xa = *(const float4*)&xr[col];
      const float4 ga = *(const float4*)&ga2[col];
      x2[q * 4 + 0] = xa.x + ga.x * o[q * 4 + 0];
      x2[q * 4 + 1] = xa.y + ga.y * o[q * 4 + 1];
      x2[q * 4 + 2] = xa.z + ga.z * o[q * 4 + 2];
      x2[q * 4 + 3] = xa.w + ga.w * o[q * 4 + 3];
    }
#pragma unroll
    for (int j = 0; j < 16; ++j) ss += x2[j] * x2[j];
    ss = wave_sum(ss);
    const float rstd = rsqrtf(ss * (1.f / 1024.f) + EPS);
#pragma unroll
    for (int q = 0; q < 4; ++q) {
      const int col = lane * 16 + q * 4;
      const float4 g0 = *(const float4*)&p.g_final[col];
      *(float4*)&xr[col] = make_float4(x2[q * 4 + 0] * rstd * g0.x, x2[q * 4 + 1] * rstd * g0.y,
                                       x2[q * 4 + 2] * rstd * g0.z, x2[q * 4 + 3] * rstd * g0.w);
    }
  }
}

__device__ __forceinline__ void phase_peer_vr(const P& p, char* smem, int r) {
  const int lane = threadIdx.x & 63, wave = threadIdx.x >> 6, l15 = lane & 15;
  int* lid = (int*)(smem + wave * 1024);
  float* lw = (float*)(lid + 128);
  u16* pbuf = p.qp;
  const int Gn = gridDim.x, bb = blockIdx.x;
  const int ngrp = bb < T / 16 ? (T / 16 - bb + Gn - 1) / Gn : 0;
  const int nseq = 2 * ngrp;
#pragma unroll 1
  for (int sq = 0; sq < nseq; ++sq) {
    const int t = SEQ_TOK(sq);
    int n = 0;
    {
      int ids8[8]; float w8[8];
#pragma unroll
      for (int h = 0; h < 8; ++h) { ids8[h] = p.ibuf[(size_t)t * 128 + h * 16 + l15]; w8[h] = p.wbuf[(size_t)t * 128 + h * 16 + l15]; }
      asm volatile("s_waitcnt lgkmcnt(0)" ::: "memory");
#pragma unroll
      for (int h = 0; h < 8; ++h) {
        const bool valid = ((ids8[h] >> 13) & 1) == r;
        const unsigned m16 = (unsigned)__ballot(valid) & 0xFFFFu;
        const int pos = n + __builtin_popcount(m16 & ((1u << l15) - 1u));
        if (lane < 16 && valid) { lid[pos] = ids8[h]; lw[pos] = w8[h]; }
        n += __builtin_popcount(m16);
      }
      asm volatile("s_waitcnt lgkmcnt(0)" ::: "memory");
    }
    n = __builtin_amdgcn_readfirstlane(n);
    f2v o2[8];
    if (r == 0) {
#pragma unroll
      for (int j = 0; j < 8; ++j) o2[j] = (f2v){0.f, 0.f};
    } else {
      const uint4 p0 = *(const uint4*)&pbuf[(size_t)t * D + lane * 16];
      const uint4 p1 = *(const uint4*)&pbuf[(size_t)t * D + lane * 16 + 8];
      o2[0] = (f2v){lo_f(p0.x), hi_f(p0.x)}; o2[1] = (f2v){lo_f(p0.y), hi_f(p0.y)};
      o2[2] = (f2v){lo_f(p0.z), hi_f(p0.z)}; o2[3] = (f2v){lo_f(p0.w), hi_f(p0.w)};
      o2[4] = (f2v){lo_f(p1.x), hi_f(p1.x)}; o2[5] = (f2v){lo_f(p1.y), hi_f(p1.y)};
      o2[6] = (f2v){lo_f(p1.z), hi_f(p1.z)}; o2[7] = (f2v){lo_f(p1.w), hi_f(p1.w)};
    }
    const int nu = (n + 15) >> 4;
    if (nu > 0) {
      uint4 A[16], B[16];
#define V2_DESC(U, IDS, W)                                                       \
      {                                                                         \
        const int j_ = (U) * 16 + l15;                                          \
        const bool ok_ = j_ < n;                                                \
        const int jc_ = ok_ ? j_ : 0;                                           \
        IDS = lid[jc_]; W = ok_ ? lw[jc_] : 0.f;                                \
      }
      int idsA, idsB = 0; float wA, wB = 0.f;
      V2_DESC(0, idsA, wA)
      G_ISSUE(A, p.vb8, idsA)
      SBAR;
#pragma unroll 1
      for (int u = 0; u < nu; u += 2) {
        const bool hasB = u + 1 < nu;
        if (hasB) { V2_DESC(u + 1, idsB, wB) G_ISSUE(B, p.vb8, idsB) }
        SBAR;
        { const int wbits = __float_as_int(wA); G_ACCV(A) }
        SBAR;
        if (u + 2 < nu) { V2_DESC(u + 2, idsA, wA) G_ISSUE(A, p.vb8, idsA) }
        SBAR;
        if (hasB) { const int wbits = __float_as_int(wB); G_ACCV(B) }
        SBAR;
      }
#undef V2_DESC
    }
    if (r == 0) {
      *(uint4*)&pbuf[(size_t)t * D + lane * 16] = make_uint4(pack2(o2[0].x, o2[0].y), pack2(o2[1].x, o2[1].y), pack2(o2[2].x, o2[2].y), pack2(o2[3].x, o2[3].y));
      *(uint4*)&pbuf[(size_t)t * D + lane * 16 + 8] = make_uint4(pack2(o2[4].x, o2[4].y), pack2(o2[5].x, o2[5].y), pack2(o2[6].x, o2[6].y), pack2(o2[7].x, o2[7].y));
    } else {
      float o[16];
#pragma unroll
      for (int j = 0; j < 8; ++j) { o[2 * j] = o2[j].x; o[2 * j + 1] = o2[j].y; }
      const int ci = t < TCTX ? 0 : 1 + ((t - TCTX) >> 12);
      const float* ga2 = p.mod + ci * 6144 + 5 * 1024;
      float* xr = p.out + (size_t)t * D;
      float x2[16];
      float ss = 0.f;
#pragma unroll
      for (int q = 0; q < 4; ++q) {
        const int col = lane * 16 + q * 4;
        const float4 xa = *(const float4*)&xr[col];
        const float4 ga = *(const float4*)&ga2[col];
        x2[q * 4 + 0] = xa.x + ga.x * o[q * 4 + 0];
        x2[q * 4 + 1] = xa.y + ga.y * o[q * 4 + 1];
        x2[q * 4 + 2] = xa.z + ga.z * o[q * 4 + 2];
        x2[q * 4 + 3] = xa.w + ga.w * o[q * 4 + 3];
      }
#pragma unroll
      for (int j = 0; j < 16; ++j) ss += x2[j] * x2[j];
      ss = wave_sum(ss);
      const float rstd = rsqrtf(ss * (1.f / 1024.f) + EPS);
#pragma unroll
      for (int q = 0; q < 4; ++q) {
        const int col = lane * 16 + q * 4;
        const float4 g0 = *(const float4*)&p.g_final[col];
        *(float4*)&xr[col] = make_float4(x2[q * 4 + 0] * rstd * g0.x, x2[q * 4 + 1] * rstd * g0.y,
                                         x2[q * 4 + 2] * rstd * g0.z, x2[q * 4 + 3] * rstd * g0.w);
      }
    }
  }
}

#define XB_TMO      128
#define XB_XCNT(j)  (256  + 64 * (j))
#define XB_XSUB(j)  (1280 + 64 * (j))
#define XB_XGEN(j)  (2304 + 64 * (j))
#define XB_TOP      3328
#define XB_TOPGEN   3392
#define XCD_BAR_WORDS 3456
#define XB_SPIN_CAP (1u << 22)
__device__ __forceinline__ unsigned xb_ld(unsigned* p) { return __hip_atomic_load(p, __ATOMIC_RELAXED, __HIP_MEMORY_SCOPE_AGENT); }
__device__ __forceinline__ unsigned xb_add(unsigned* p, unsigned v) { return __hip_atomic_fetch_add(p, v, __ATOMIC_RELAXED, __HIP_MEMORY_SCOPE_AGENT); }
__device__ __forceinline__ unsigned xb_xcc_id() { return (unsigned)__builtin_amdgcn_s_getreg((3 << 11) | 20) & 0xFu; }
#define XB_SPIN(cond, bar) do { unsigned _sp = 0; while (cond) { __builtin_amdgcn_s_sleep(1); \
    if ((++_sp & 255u) == 0u) { if (xb_ld(&(bar)[XB_TMO])) break; if (_sp > XB_SPIN_CAP) { atomicAdd(&(bar)[XB_TMO], 1u); break; } } } } while (0)
struct XcdBarrier { unsigned* bar; unsigned x; volatile LAS unsigned* st; };
__device__ __forceinline__ XcdBarrier xcd_barrier_post(unsigned* bar, volatile LAS unsigned* st) {
  XcdBarrier b; b.bar = bar; b.x = xb_xcc_id(); b.st = st;
  if (threadIdx.x == 0) (void)xb_add(&bar[XB_XCNT(b.x)], 1u);
  return b;
}
__device__ __forceinline__ void xcd_barrier_complete(unsigned* bar, unsigned x, unsigned& nloc, unsigned& nx) {
  const unsigned G = gridDim.x * gridDim.y * gridDim.z;
  unsigned sum, cnt, mine, sp = 0u;
  for (;;) {
    sum = 0u; cnt = 0u; mine = 0u;
#pragma unroll
    for (unsigned j = 0; j < 16; ++j) { const unsigned c = xb_ld(&bar[XB_XCNT(j)]); sum += c; cnt += (c > 0u) ? 1u : 0u; mine = (j == x) ? c : mine; }
    if (sum == G) break;
    __builtin_amdgcn_s_sleep(1);
    if ((++sp & 255u) == 0u) { if (xb_ld(&bar[XB_TMO])) break; if (sp > XB_SPIN_CAP) { atomicAdd(&bar[XB_TMO], 1u); break; } }
  }
  nloc = mine > 0u ? mine : 1u; nx = cnt > 0u ? cnt : 1u;
}
__device__ __forceinline__ void xcd_barrier(const XcdBarrier& b) {
  asm volatile("s_waitcnt vmcnt(0)" ::: "memory");
  __syncthreads();
  if (threadIdx.x == 0) {
    unsigned* bar = b.bar;
    __builtin_amdgcn_s_waitcnt(0);
    unsigned nloc = b.st[0], nx = b.st[1];
    if (nloc == 0u) { xcd_barrier_complete(bar, b.x, nloc, nx); b.st[0] = nloc; b.st[1] = nx; }
    const unsigned old = xb_add(&bar[XB_XSUB(b.x)], 1u);
    const unsigned gen = old / nloc;
    if (old + 1u == (gen + 1u) * nloc) {
      __builtin_amdgcn_fence(__ATOMIC_RELEASE, "agent");
      asm volatile("s_waitcnt vmcnt(0)" ::: "memory");
      const unsigned og = xb_add(&bar[XB_TOP], 1u);
      const unsigned tg = og / nx;
      if (og + 1u == (tg + 1u) * nx) xb_add(&bar[XB_TOPGEN], 1u);
      else XB_SPIN(xb_ld(&bar[XB_TOPGEN]) == tg, bar);
      __builtin_amdgcn_fence(__ATOMIC_ACQUIRE, "agent");
      xb_add(&bar[XB_XGEN(b.x)], 1u);
      asm volatile("s_waitcnt vmcnt(0)" ::: "memory");
    } else {
      XB_SPIN(xb_ld(&bar[XB_XGEN(b.x)]) == gen, bar);
      __builtin_amdgcn_fence(__ATOMIC_ACQUIRE, "agent");
      asm volatile("s_waitcnt vmcnt(0)" ::: "memory");
    }
  }
  __syncthreads();
}

__global__ void __launch_bounds__(NT) mega(P p, unsigned* bar, int use_cg) {
  extern __shared__ __attribute__((aligned(16))) char smem[];
  __shared__ uint4 xb_words;
  cg::grid_group grid = cg::this_grid();
  if (threadIdx.x == 0) xb_words = make_uint4(0u, 0u, 0u, 0u);
  __syncthreads();
  XcdBarrier xb = xcd_barrier_post(bar, (volatile LAS unsigned*)&xb_words);
#define SEAM() do { if (use_cg) grid.sync(); else xcd_barrier(xb); } while (0)
  phase_prep(p, smem);
  SEAM();
  phase_norm(p, 0);
  SEAM();
  { EpiProj e; e.proj = p.proj; e.gates = p.gates; gemm_run(p.hbuf, p.w_in_t, NPAD, e, smem); }
  {
    const int G = (int)gridDim.x, rem = ((T / 256) * (NPAD / 256)) % G;
    const int bi = rem == 0 ? (int)blockIdx.x : (int)blockIdx.x - rem;
    if (bi >= 0) phase_prep_late(p, smem, bi, rem == 0 ? G : G - rem);
  }
  SEAM();
  phase_mlstm(p, smem);
  SEAM();
  phase_mix(p);
  SEAM();
  { EpiResid e; e.x_prompt = p.x_prompt; e.x_sample = p.x_sample; e.mod = p.mod; e.out = p.out; gemm_run(p.hbuf, p.w_out_t, 1024, e, smem); }
  SEAM();
  phase_norm(p, 1);
  if (!p.conv_early) convert_tables(p, (int)blockIdx.x, (int)gridDim.x);
  SEAM();
  { EpiQ e; e.qp = p.qp; gemm_run(p.hbuf, p.wq_t, 2048, e, smem); }
  SEAM();
  phase_peer(p, smem);
  __syncthreads();
  phase_peer_u(p, smem);
  __syncthreads();
#pragma unroll 1
  for (int rr = launder(0); rr < 2; ++rr) {
    phase_peer_vr(p, smem, rr);
    __syncthreads();
  }
}

extern "C" void kernel_launch(void* const* d_in, const int* in_sizes, int n_in, void* d_out, int out_size,
                              void* d_ws, size_t ws_size, hipStream_t stream) {
  P p{};
  const float* const* in = (const float* const*)d_in;
  p.x_prompt = in[0]; p.x_sample = in[1]; p.state_C = in[2]; p.state_n = in[3]; p.state_m = in[4];
  p.c = in[5]; p.c_ctx = in[6]; p.w_ada = in[7]; p.b_ada = in[8]; p.g_norm1 = in[9]; p.w_in = in[10];
  p.b_igate = in[11]; p.b_fgate = in[12]; p.conv_w = in[13]; p.conv_b = in[14]; p.g_mlstm = in[15];
  p.w_out = in[16]; p.g_norm2 = in[17]; p.wq = in[18]; p.k1 = in[19]; p.k2 = in[20]; p.u = in[21]; p.v = in[22];
  p.g_final = in[23];
  p.out = (float*)d_out;
  char* ws = (char*)d_ws;
  size_t off = 0;
  auto take = [&](size_t bytes) { char* r = ws + off; off += (bytes + 255) & ~(size_t)255; return r; };
  p.mod = (float*)take(5 * 6144 * 4);
  p.w_in_t = (u16*)take((size_t)NPAD * 1024 * 2);
  p.w_out_t = (u16*)take((size_t)1024 * 1024 * 2);
  p.wq_t = (u16*)take((size_t)2048 * 1024 * 2);
  p.kb = (u16*)take(2 * 16384 * 2);
  p.gates = (float*)take((size_t)T * 16 * 4);
  p.hbuf = (u16*)take((size_t)T * D * 2);
  p.proj = (u16*)take((size_t)T * NPROJ * 2);
  p.qp = p.proj;
  p.wbuf = (float*)(p.proj + (size_t)70000000);
  p.ibuf = (int*)(p.wbuf + (size_t)T * 128);
  unsigned* bar = (unsigned*)take(XCD_BAR_WORDS * 4);
  p.scan = (float*)p.hbuf;
  const size_t tab_bytes = (size_t)2 * 16384 * 1024 + (size_t)2 * 16384 * 4;
  if (ws_size >= off + tab_bytes + 256) {
    p.ub8 = (unsigned char*)take((size_t)16384 * 1024);
    p.vb8 = (unsigned char*)take((size_t)16384 * 1024);
    p.sinv = (float*)take((size_t)2 * 16384 * 4);
    p.conv_early = 1;
  } else {
    p.ub8 = (unsigned char*)(p.proj + (size_t)T * 2048);
    p.vb8 = p.ub8 + (size_t)16384 * 1024;
    p.sinv = (float*)(p.vb8 + (size_t)16384 * 1024);
    p.conv_early = 0;
  }
  (void)hipMemsetAsync(bar, 0, XCD_BAR_WORDS * 4, stream);
  (void)hipFuncSetAttribute((const void*)mega, hipFuncAttributeMaxDynamicSharedMemorySize, LDS_BYTES);
  int dev = 0, cus = 0, per = 0;
  (void)hipGetDevice(&dev);
  (void)hipDeviceGetAttribute(&cus, hipDeviceAttributeMultiprocessorCount, dev);
  (void)hipOccupancyMaxActiveBlocksPerMultiprocessor(&per, (const void*)mega, NT, LDS_BYTES);
  if (per < 1 || cus < 1) { fprintf(stderr, "occupancy query: %d blocks/CU on %d CUs\n", per, cus); }
  const int grid = cus;
  int use_cg = 0;
  void* args[] = {&p, &bar, &use_cg};
  hipError_t e = hipLaunchCooperativeKernel((const void*)mega, dim3(grid), dim3(NT), args, LDS_BYTES, stream);
  if (e != hipSuccess) fprintf(stderr, "cooperative launch failed: %s (grid %d)\n", hipGetErrorString(e), grid);
}
```

```cpp
#include <hip/hip_runtime.h>
#include <hip/hip_cooperative_groups.h>
#include <cstdio>
#include <cstdint>
namespace cg = cooperative_groups;

typedef unsigned short u16;
typedef __attribute__((ext_vector_type(8))) short bf16x8;
typedef __attribute__((ext_vector_type(4))) float f32x4;
typedef __attribute__((ext_vector_type(2))) __bf16 bf2_t;
typedef __attribute__((ext_vector_type(2))) float f2v;
typedef __attribute__((ext_vector_type(4))) short s16x4;
#define LAS __attribute__((address_space(3)))

constexpr int NT = 512;
constexpr int D = 1024;
constexpr int TCTX = 8192;
constexpr int TLAT = 16384;
constexpr int T = TCTX + TLAT;
constexpr int NPROJ = 3584;
constexpr int NPAD = 3840;
constexpr int LDS_BYTES = 256 * 130 * 4 + 256 * 16 * 4;
constexpr float EPS = 1e-6f;

struct P {
  const float *x_prompt, *x_sample, *state_C, *state_n, *state_m, *c, *c_ctx, *w_ada, *b_ada, *g_norm1, *w_in,
      *b_igate, *b_fgate, *conv_w, *conv_b, *g_mlstm, *w_out, *g_norm2, *wq, *k1, *k2, *u, *v, *g_final;
  float* out;
  float* mod;
  u16* w_in_t;
  u16* w_out_t;
  u16* wq_t;
  u16* kb;
  float* gates;
  u16* hbuf;
  u16* proj;
  u16* qp;
  unsigned char* ub8;
  unsigned char* vb8;
  float* sinv;
  float* wbuf;
  int* ibuf;
  float* scan;
  int conv_early;
  int pad_;
};

__device__ __forceinline__ u16 f2bf(float f) { return __builtin_bit_cast(u16, (__bf16)f); }
__device__ __forceinline__ float bf2f(u16 h) { return __uint_as_float(((unsigned)h) << 16); }
__device__ __forceinline__ unsigned pack2(float a, float b) {
  bf2_t v; v.x = (__bf16)a; v.y = (__bf16)b;
  return __builtin_bit_cast(unsigned, v);
}
__device__ __forceinline__ float lo_f(unsigned w) { return __uint_as_float(w << 16); }
__device__ __forceinline__ float hi_f(unsigned w) { return __uint_as_float(w & 0xffff0000u); }
__device__ __forceinline__ float wave_sum(float v) {
#pragma unroll
  for (int o = 32; o > 0; o >>= 1) v += __shfl_xor(v, o);
  return v;
}
__device__ __forceinline__ float dot2(unsigned a, unsigned b, float c) {
  return __builtin_amdgcn_fdot2_f32_bf16(__builtin_bit_cast(bf2_t, a), __builtin_bit_cast(bf2_t, b), c, false);
}
__device__ __forceinline__ float dot8(uint4 a, uint4 b, float c) {
  c = dot2(a.x, b.x, c); c = dot2(a.y, b.y, c); c = dot2(a.z, b.z, c); c = dot2(a.w, b.w, c);
  return c;
}
__device__ __forceinline__ f32x4 mfma16(bf16x8 a, bf16x8 b, f32x4 c) {
  return __builtin_amdgcn_mfma_f32_16x16x32_bf16(a, b, c, 0, 0, 0);
}

__device__ __forceinline__ void transpose_tile(const float* __restrict__ W, int Nreal, u16* __restrict__ Wt, int k0, int n0, float* tile) {
  const int tid = threadIdx.x;
#pragma unroll
  for (int i = 0; i < 8; ++i) {
    int idx = i * NT + tid;
    int kk = idx >> 6, nn = idx & 63;
    float v = (n0 + nn < Nreal) ? W[(size_t)(k0 + kk) * Nreal + n0 + nn] : 0.f;
    tile[kk * 65 + nn] = v;
  }
  __syncthreads();
  {
    const int nn = tid & 63, kg = tid >> 6;
    uint4 o;
    o.x = pack2(tile[(kg * 8 + 0) * 65 + nn], tile[(kg * 8 + 1) * 65 + nn]);
    o.y = pack2(tile[(kg * 8 + 2) * 65 + nn], tile[(kg * 8 + 3) * 65 + nn]);
    o.z = pack2(tile[(kg * 8 + 4) * 65 + nn], tile[(kg * 8 + 5) * 65 + nn]);
    o.w = pack2(tile[(kg * 8 + 6) * 65 + nn], tile[(kg * 8 + 7) * 65 + nn]);
    *(uint4*)&Wt[(size_t)(n0 + nn) * 1024 + k0 + kg * 8] = o;
  }
}

__device__ __forceinline__ void phase_prep(const P& p, char* smem) {
  const int tid = threadIdx.x;
  float* sf = (float*)smem;
  const int n_gemv = 96, n_tin = 16 * 60, n_tout = 16 * 16, n_tq = 16 * 32, n_k = 2;
  const int total = n_gemv + n_tin + n_tout + n_tq + n_k;
  (void)total;
  for (int it = blockIdx.x; it < n_gemv + n_tin; it += gridDim.x) {
    __syncthreads();
    if (it < n_gemv) {
      for (int i = tid; i < 5 * 1024; i += NT) {
        int ci = i >> 10, k = i & 1023;
        float cv = (ci == 0) ? p.c_ctx[k] : p.c[(ci - 1) * 1024 + k];
        sf[i] = cv / (1.f + expf(-cv));
      }
      __syncthreads();
      const int cl = tid & 15, kg = tid >> 4;
      const int col = it * 64 + cl * 4;
      float acc[5][4];
#pragma unroll
      for (int ci = 0; ci < 5; ++ci)
#pragma unroll
        for (int j = 0; j < 4; ++j) acc[ci][j] = 0.f;
      for (int kk = 0; kk < 32; ++kk) {
        int k = kg * 32 + kk;
        float4 w = *(const float4*)&p.w_ada[(size_t)k * 6144 + col];
#pragma unroll
        for (int ci = 0; ci < 5; ++ci) {
          float s = sf[ci * 1024 + k];
          acc[ci][0] += s * w.x; acc[ci][1] += s * w.y; acc[ci][2] += s * w.z; acc[ci][3] += s * w.w;
        }
      }
      float* red = sf + 5 * 1024;
#pragma unroll
      for (int ci = 0; ci < 5; ++ci)
#pragma unroll
        for (int j = 0; j < 4; ++j) red[(kg * 16 + cl) * 20 + ci * 4 + j] = acc[ci][j];
      __syncthreads();
      if (tid < 320) {
        int ci = tid >> 6, cc = tid & 63;
        int cl2 = cc >> 2, j = cc & 3;
        float s = 0.f;
        for (int g = 0; g < 32; ++g) s += red[(g * 16 + cl2) * 20 + ci * 4 + j];
        int col2 = it * 64 + cc;
        p.mod[ci * 6144 + col2] = s + p.b_ada[col2];
      }
    } else if (it < n_gemv + n_tin) {
      int j = it - n_gemv;
      transpose_tile(p.w_in, 3600, p.w_in_t, (j / 60) * 64, (j % 60) * 64, sf);
    } else if (it < n_gemv + n_tin + n_tout) {
      int j = it - n_gemv - n_tin;
      transpose_tile(p.w_out, 1024, p.w_out_t, (j / 16) * 64, (j % 16) * 64, sf);
    } else if (it < n_gemv + n_tin + n_tout + n_tq) {
      int j = it - n_gemv - n_tin - n_tout;
      transpose_tile(p.wq, 2048, p.wq_t, (j / 32) * 64, (j % 32) * 64, sf);
    } else {
      int j = it - n_gemv - n_tin - n_tout - n_tq;
      const float* src = j ? p.k2 : p.k1;
      u16* dst = p.kb + j * 16384;
      for (int i = tid; i < 16384; i += NT) dst[i] = f2bf(src[i]);
    }
  }
}

__device__ __forceinline__ void phase_prep_late(const P& p, char* smem, int bi, int nb) {
  const int tid = threadIdx.x;
  float* sf = (float*)smem;
  const int n_tout = 16 * 16, n_tq = 16 * 32, n_k = 2;
  for (int it = bi; it < n_tout + n_tq + n_k; it += nb) {
    __syncthreads();
    if (it < n_tout) {
      transpose_tile(p.w_out, 1024, p.w_out_t, (it / 16) * 64, (it % 16) * 64, sf);
    } else if (it < n_tout + n_tq) {
      const int j = it - n_tout;
      transpose_tile(p.wq, 2048, p.wq_t, (j / 32) * 64, (j % 32) * 64, sf);
    } else {
      const int j = it - n_tout - n_tq;
      const float* src = j ? p.k2 : p.k1;
      u16* dst = p.kb + j * 16384;
      for (int i = tid; i < 16384; i += NT) dst[i] = f2bf(src[i]);
    }
  }
}

__device__ __forceinline__ void phase_norm(const P& p, int which) {
  const int wave = threadIdx.x >> 6, lane = threadIdx.x & 63;
  for (int t = blockIdx.x * 8 + wave; t < T; t += gridDim.x * 8) {
    const float* xr = which ? (p.out + (size_t)t * D)
                            : (t < TCTX ? p.x_prompt + (size_t)t * D : p.x_sample + (size_t)(t - TCTX) * D);
    const int ci = t < TCTX ? 0 : 1 + ((t - TCTX) >> 12);
    const float* md = p.mod + ci * 6144 + (which ? 3 * 1024 : 0);
    const float* g = which ? p.g_norm2 : p.g_norm1;
    float4 xv[4];
    float ss = 0.f;
#pragma unroll
    for (int i = 0; i < 4; ++i) {
      xv[i] = *(const float4*)&xr[(i >> 1) * 512 + lane * 8 + (i & 1) * 4];
      ss += xv[i].x * xv[i].x + xv[i].y * xv[i].y + xv[i].z * xv[i].z + xv[i].w * xv[i].w;
    }
    ss = wave_sum(ss);
    const float rstd = rsqrtf(ss * (1.f / 1024.f) + EPS);
    unsigned ow[8];
#pragma unroll
    for (int i = 0; i < 4; ++i) {
      const int col = (i >> 1) * 512 + lane * 8 + (i & 1) * 4;
      const float4 g4 = *(const float4*)&g[col];
      const float4 sh = *(const float4*)&md[col];
      const float4 sc = *(const float4*)&md[1024 + col];
      const float h0 = xv[i].x * rstd * g4.x * (1.f + sc.x) + sh.x;
      const float h1 = xv[i].y * rstd * g4.y * (1.f + sc.y) + sh.y;
      const float h2 = xv[i].z * rstd * g4.z * (1.f + sc.z) + sh.z;
      const float h3 = xv[i].w * rstd * g4.w * (1.f + sc.w) + sh.w;
      ow[i * 2] = pack2(h0, h1); ow[i * 2 + 1] = pack2(h2, h3);
    }
    *(uint4*)&p.hbuf[(size_t)t * D + lane * 8] = make_uint4(ow[0], ow[1], ow[2], ow[3]);
    *(uint4*)&p.hbuf[(size_t)t * D + 512 + lane * 8] = make_uint4(ow[4], ow[5], ow[6], ow[7]);
  }
}

__device__ __forceinline__ void convert_tables(const P& p, int bi, int nb) {
  const int wave = threadIdx.x >> 6, lane = threadIdx.x & 63;
  for (int row = bi * 8 + wave; row < 32768; row += nb * 8) {
    const float* src = row < 16384 ? p.u + (size_t)row * D : p.v + (size_t)(row - 16384) * D;
    unsigned char* dst = row < 16384 ? p.ub8 + (size_t)row * D : p.vb8 + (size_t)(row - 16384) * D;
    float4 f[4];
    float amax = 0.f;
#pragma unroll
    for (int i = 0; i < 4; ++i) {
      f[i] = *(const float4*)&src[lane * 16 + i * 4];
      amax = fmaxf(amax, fmaxf(fmaxf(fabsf(f[i].x), fabsf(f[i].y)), fmaxf(fabsf(f[i].z), fabsf(f[i].w))));
    }
#pragma unroll
    for (int o = 32; o > 0; o >>= 1) amax = fmaxf(amax, __shfl_xor(amax, o));
    const float sc = amax > 0.f ? 384.f / amax : 1.f;
    const float inv = amax > 0.f ? amax * (1.f / 384.f) : 1.f;
    unsigned w[4];
#pragma unroll
    for (int i = 0; i < 4; ++i) {
      unsigned pk = 0u;
      pk = __builtin_amdgcn_cvt_pk_fp8_f32(f[i].x * sc, f[i].y * sc, pk, false);
      pk = __builtin_amdgcn_cvt_pk_fp8_f32(f[i].z * sc, f[i].w * sc, pk, true);
      w[i] = pk;
    }
    *(uint4*)&dst[lane * 16] = make_uint4(w[0], w[1], w[2], w[3]);
    if (lane == 0) p.sinv[row] = inv;
  }
}

namespace pg8 {
#define PG8_LAS __attribute__((address_space(3)))
typedef unsigned short bf16_t;
typedef short bf16x8 __attribute__((ext_vector_type(8)));
typedef float f32x4 __attribute__((ext_vector_type(4)));
typedef unsigned u32x4 __attribute__((ext_vector_type(4)));
constexpr int BM = 256, BK = 64, HALF = 128, HTB = HALF * BK * 2  , STAGE_BYTES = 8 * HTB, NXCD = 8, WGM = 8;

__host__ __device__ __forceinline__ int lds_byte(int r, int c) { const int st = (r >> 4) * 2 + (c >> 5), rr = r & 15, cc = c & 31, ob = rr * 64 + cc * 2; return st * 1024 + (ob ^ (((ob >> 9) & 1) << 5)); }
__host__ __device__ __forceinline__ void stage_rc(int b, int& R, int& C) { const int st = b / 1024, sb = b % 1024, swz = sb ^ (((sb >> 9) & 1) << 5); R = (st >> 1) * 16 + swz / 64; C = (st & 1) * 32 + (swz % 64) / 2; }
__host__ __device__ __forceinline__ int perm32(int rho) { const int n = rho >> 4, i = rho & 15; return 8 * (i >> 2) + 4 * n + (i & 3); }

struct Unit { int pm, pn; };
struct Gemm { const bf16_t* A; const bf16_t* Bt; int M, N, K; };

struct StaticOrder {
    int nM, nN, nwg, G, c;
    __host__ __device__ void init(int M, int N, int G_, int c_) { nM = M / BM; nN = N / BM; nwg = nM * nN; G = G_; c = c_; }
    __host__ __device__ bool next(int i, Unit& u) const {
        const long L = (long)i * G + c; if (L >= nwg) return false;
        int wgid = (int)L; { const int q = nwg / NXCD, r = nwg % NXCD, xcd = wgid % NXCD, off = wgid / NXCD; wgid = (xcd < r ? xcd * (q + 1) : r * (q + 1) + (xcd - r) * q) + off; }
        const int nig = WGM * nN, gid = wgid / nig, fm = gid * WGM, gsz = (nM - fm) < WGM ? (nM - fm) : WGM;
        u.pm = fm + ((wgid % nig) % gsz); u.pn = (wgid % nig) / gsz; return true;
    }
    __device__ __forceinline__ void a_ready(const Unit&) const {}
    __device__ __forceinline__ void done(const Unit&) const {}
};

template <class Epi, class Sched, bool STAMP = false>
__device__ __forceinline__ void gemm_phase(PG8_LAS unsigned char* lds, const Gemm g, const Sched& S, const Epi& E, unsigned long long* stamps) {
    const int tid = threadIdx.x, wid = __builtin_amdgcn_readfirstlane(tid >> 6), lane = tid & 63, wr = wid >> 2, wc = wid & 3, fr = lane & 15, fq = lane >> 4;
    const int K = g.K, nt = K / BK;
    int ts_lo = 0, ts_hi = 0, nts = 0; const unsigned long long rt_entry = STAMP ? (unsigned long long)wall_clock64() : 0ull;
#define PG8_STAMP() do { if (STAMP && wid == 0 && nts < 64) { const unsigned long long _c = (unsigned long long)clock64(); \
        ts_lo = (lane == nts) ? (int)(unsigned)_c : ts_lo; ts_hi = (lane == nts) ? (int)(unsigned)(_c >> 32) : ts_hi; ++nts; } } while (0)
    PG8_STAMP();
    unsigned voffA[2], voffB[2];
#pragma unroll
    for (int i = 0; i < 2; ++i) { int R, C; stage_rc(tid * 16 + i * 8192, R, C); const int Rb = Epi::PERM ? ((R & ~31) + perm32(R & 31)) : R;
        voffA[i] = (unsigned)(R * K + C) * 2u; voffB[i] = (unsigned)(Rb * K + C) * 2u; }
    const size_t kstep = (size_t)(BK * 2);
    const size_t hstep = (size_t)HALF * K * 2;
    const size_t tstep = 2 * hstep;
    const unsigned ldsw = (unsigned)wid * 1024u;
    const int aoff = lds_byte(wr * 64 + fr, fq * 8), boff = lds_byte(wc * 32 + fr, fq * 8);
#define PG8_SA(b, h) (((b) * 2 + (h)) * HTB)
#define PG8_SB(b, h) ((4 + (b) * 2 + (h)) * HTB)
#define PG8_STAGE(bufoff, gbase, voff) do { _Pragma("unroll") for (int _i = 0; _i < 2; ++_i) \
        __builtin_amdgcn_global_load_lds((const unsigned*)((const char*)(gbase) + (voff)[_i]), (PG8_LAS unsigned*)(lds + (bufoff) + ldsw + _i * 8192), 16, 0, 0); } while (0)
#define PG8_LDA(dst, b, h) do { _Pragma("unroll") for (int m = 0; m < 4; ++m) _Pragma("unroll") for (int k = 0; k < 2; ++k) dst[m][k] = *(const PG8_LAS bf16x8*)(lds + PG8_SA(b, h) + aoff + m * 2048 + k * 1024); } while (0)
#define PG8_LDB(dst, b, h) do { _Pragma("unroll") for (int n = 0; n < 2; ++n) _Pragma("unroll") for (int k = 0; k < 2; ++k) dst[n][k] = *(const PG8_LAS bf16x8*)(lds + PG8_SB(b, h) + boff + n * 2048 + k * 1024); } while (0)
#define PG8_MMA(ai, bj, At, Bt) do { __builtin_amdgcn_s_setprio(1); _Pragma("unroll") for (int m = 0; m < 4; ++m) _Pragma("unroll") for (int n = 0; n < 2; ++n) _Pragma("unroll") for (int k = 0; k < 2; ++k) \
        acc[ai][bj][m][n] = __builtin_amdgcn_mfma_f32_16x16x32_bf16(Bt[n][k], At[m][k], acc[ai][bj][m][n], 0, 0, 0); __builtin_amdgcn_s_setprio(0); } while (0)
#define PG8_WAIT_V(n) asm volatile("s_waitcnt vmcnt(" #n ")" ::: "memory")
#define PG8_WAIT_L(n) asm volatile("s_waitcnt lgkmcnt(" #n ")" ::: "memory")
#define PG8_BAR __builtin_amdgcn_s_barrier()
#define PG8_SCHED __builtin_amdgcn_sched_barrier(0)
    Unit cur, nxt; int ui = 0;
    if (!S.next(0, cur)) return;
    f32x4 acc[2][2][4][2];
#pragma unroll
    for (int a = 0; a < 2; ++a)
#pragma unroll
        for (int b = 0; b < 2; ++b)
#pragma unroll
            for (int m = 0; m < 4; ++m)
#pragma unroll
                for (int n = 0; n < 2; ++n) acc[a][b][m][n] = (f32x4){0.f, 0.f, 0.f, 0.f};
    bf16x8 At[4][2], B0[2][2], B1[2][2];
    const char* cA = (const char*)g.A + (size_t)cur.pm * tstep; const char* cB = (const char*)g.Bt + (size_t)cur.pn * tstep;
    S.a_ready(cur);
    PG8_STAGE(PG8_SB(0, 0), cB, voffB); PG8_STAGE(PG8_SA(0, 0), cA, voffA); PG8_STAGE(PG8_SB(0, 1), cB + hstep, voffB); PG8_STAGE(PG8_SA(0, 1), cA + hstep, voffA);
    if (wr == 1) PG8_BAR;
    PG8_WAIT_V(4); PG8_BAR;
    PG8_STAGE(PG8_SB(1, 0), cB + kstep, voffB); PG8_STAGE(PG8_SA(1, 0), cA + kstep, voffA); PG8_STAGE(PG8_SB(1, 1), cB + hstep + kstep, voffB);
    PG8_WAIT_V(6); PG8_BAR;
    PG8_STAMP();
    for (;;) {
        const bool has_next = S.next(ui + 1, nxt);
        const char* nA = has_next ? (const char*)g.A + (size_t)nxt.pm * tstep : cA; const char* nB = has_next ? (const char*)g.Bt + (size_t)nxt.pn * tstep : cB;
        for (int t = 0; t < nt; t += 2) {
            const bool last = (t == nt - 2);
            const char* a1 = cA + (size_t)(t + 1) * kstep;
            const char* a2 = last ? nA : cA + (size_t)(t + 2) * kstep; const char* b2 = last ? nB : cB + (size_t)(t + 2) * kstep;
            const char* a3 = a2 + kstep; const char* b3 = b2 + kstep;
            if (last && has_next) S.a_ready(nxt);
            PG8_LDB(B0, 0, 0); PG8_SCHED; PG8_LDA(At, 0, 0); PG8_STAGE(PG8_SA(1, 1), a1 + hstep, voffA);
            PG8_WAIT_L(8); PG8_BAR; PG8_WAIT_L(0); PG8_MMA(0, 0, At, B0); PG8_BAR; PG8_SCHED;
            PG8_LDB(B1, 0, 1); PG8_STAGE(PG8_SB(0, 0), b2, voffB);
            PG8_BAR; PG8_WAIT_L(0); PG8_MMA(0, 1, At, B1); PG8_BAR;
            PG8_LDA(At, 0, 1); PG8_STAGE(PG8_SA(0, 0), a2, voffA);
            PG8_BAR; PG8_WAIT_L(0); PG8_MMA(1, 0, At, B0); PG8_BAR; PG8_SCHED;
            PG8_STAGE(PG8_SB(0, 1), b2 + hstep, voffB);
            PG8_WAIT_V(6); PG8_BAR; PG8_MMA(1, 1, At, B1); PG8_BAR;
            PG8_LDB(B0, 1, 0); PG8_SCHED; PG8_LDA(At, 1, 0); PG8_STAGE(PG8_SA(0, 1), a2 + hstep, voffA);
            PG8_WAIT_L(8); PG8_BAR; PG8_WAIT_L(0); PG8_MMA(0, 0, At, B0); PG8_BAR; PG8_SCHED;
            PG8_LDB(B1, 1, 1); PG8_STAGE(PG8_SB(1, 0), b3, voffB);
            PG8_BAR; PG8_WAIT_L(0); PG8_MMA(0, 1, At, B1); PG8_BAR;
            PG8_LDA(At, 1, 1); PG8_STAGE(PG8_SA(1, 0), a3, voffA);
            PG8_BAR; PG8_WAIT_L(0); PG8_MMA(1, 0, At, B0); PG8_BAR; PG8_SCHED;
            PG8_STAGE(PG8_SB(1, 1), b3 + hstep, voffB);
            PG8_WAIT_V(6); PG8_BAR; PG8_MMA(1, 1, At, B1); PG8_BAR;
        }
        PG8_STAMP();
        if constexpr (!Epi::AFTER_DRAIN) { E(acc, cur, wr, wc, fr, fq); S.done(cur); }
        PG8_STAMP();
        if (!has_next) break;
#pragma unroll
        for (int a = 0; a < 2; ++a)
#pragma unroll
            for (int b = 0; b < 2; ++b)
#pragma unroll
                for (int m = 0; m < 4; ++m)
#pragma unroll
                    for (int n = 0; n < 2; ++n) acc[a][b][m][n] = (f32x4){0.f, 0.f, 0.f, 0.f};
        cur = nxt; cA = nA; cB = nB; ++ui;
    }
    PG8_WAIT_V(0);
    if (wr == 0) PG8_BAR;
    PG8_BAR;
    if constexpr (Epi::AFTER_DRAIN) { E.fused(acc, cur, wr, wc, fr, fq, lds, wid, lane); S.done(cur); }
    PG8_STAMP();
    if (STAMP && wid == 0) { stamps[lane] = lane < nts ? (((unsigned long long)(unsigned)ts_hi << 32) | (unsigned)ts_lo) : 0ull;
        if (lane == 62) stamps[62] = rt_entry; if (lane == 63) stamps[63] = (unsigned long long)wall_clock64(); }
#undef PG8_STAMP
#undef PG8_SA
#undef PG8_SB
#undef PG8_STAGE
#undef PG8_LDA
#undef PG8_LDB
#undef PG8_MMA
#undef PG8_WAIT_V
#undef PG8_WAIT_L
#undef PG8_BAR
#undef PG8_SCHED
}
}


struct EpiProj {
  static constexpr bool PERM = true, AFTER_DRAIN = false;
  u16* proj; float* gates;
  __device__ __forceinline__ void operator()(const pg8::f32x4 (&acc)[2][2][4][2], const pg8::Unit& u, int wr, int wc, int fr, int fq) const {
    const int row0 = u.pm * 256 + wr * 64 + fr, col0 = u.pn * 256 + wc * 32 + 8 * fq;
#pragma unroll
    for (int ai = 0; ai < 2; ++ai)
#pragma unroll
      for (int m = 0; m < 4; ++m) {
        const int row = row0 + ai * 128 + m * 16;
#pragma unroll
        for (int bj = 0; bj < 2; ++bj) {
          const int col = col0 + bj * 128;
          const pg8::f32x4 a = acc[ai][bj][m][0], b = acc[ai][bj][m][1];
          if (col < NPROJ) {
            uint4 o; o.x = pack2(a[0], a[1]); o.y = pack2(a[2], a[3]); o.z = pack2(b[0], b[1]); o.w = pack2(b[2], b[3]);
            *(uint4*)&proj[(size_t)row * NPROJ + col] = o;
          } else if (col < 3600) {
            *(float4*)&gates[(size_t)row * 16 + (col - NPROJ)] = make_float4(a[0], a[1], a[2], a[3]);
            *(float4*)&gates[(size_t)row * 16 + (col - NPROJ) + 4] = make_float4(b[0], b[1], b[2], b[3]);
          }
        }
      }
  }
};
struct EpiResid {
  static constexpr bool PERM = false, AFTER_DRAIN = false;
  const float* x_prompt; const float* x_sample; const float* mod; float* out;
  __device__ __forceinline__ void operator()(const pg8::f32x4 (&acc)[2][2][4][2], const pg8::Unit& u, int wr, int wc, int fr, int fq) const {
    const int row0 = u.pm * 256 + wr * 64 + fr, col0 = u.pn * 256 + wc * 32 + 4 * fq;
#pragma unroll
    for (int ai = 0; ai < 2; ++ai)
#pragma unroll
      for (int m = 0; m < 4; ++m) {
        const int row = row0 + ai * 128 + m * 16;
        const float* xr = row < TCTX ? x_prompt + (size_t)row * D : x_sample + (size_t)(row - TCTX) * D;
        const int ci = row < TCTX ? 0 : 1 + ((row - TCTX) >> 12);
#pragma unroll
        for (int bj = 0; bj < 2; ++bj)
#pragma unroll
          for (int n = 0; n < 2; ++n) {
            const int col = col0 + bj * 128 + n * 16;
            const pg8::f32x4 a = acc[ai][bj][m][n];
            const float4 xv = *(const float4*)&xr[col];
            const float4 ga = *(const float4*)&mod[ci * 6144 + 2 * 1024 + col];
            *(float4*)&out[(size_t)row * D + col] = make_float4(xv.x + ga.x * a[0], xv.y + ga.y * a[1], xv.z + ga.z * a[2], xv.w + ga.w * a[3]);
          }
      }
  }
};
struct EpiQ {
  static constexpr bool PERM = true, AFTER_DRAIN = false;
  u16* qp;
  __device__ __forceinline__ void operator()(const pg8::f32x4 (&acc)[2][2][4][2], const pg8::Unit& u, int wr, int wc, int fr, int fq) const {
    const int row0 = u.pm * 256 + wr * 64 + fr, col0 = u.pn * 256 + wc * 32 + 8 * fq;
#pragma unroll
    for (int ai = 0; ai < 2; ++ai)
#pragma unroll
      for (int m = 0; m < 4; ++m) {
        const int row = row0 + ai * 128 + m * 16;
#pragma unroll
        for (int bj = 0; bj < 2; ++bj) {
          const int col = col0 + bj * 128;
          const pg8::f32x4 a = acc[ai][bj][m][0], b = acc[ai][bj][m][1];
          uint4 o; o.x = pack2(a[0], a[1]); o.y = pack2(a[2], a[3]); o.z = pack2(b[0], b[1]); o.w = pack2(b[2], b[3]);
          *(uint4*)&qp[(size_t)row * 2048 + col] = o;
        }
      }
  }
};
template <class Epi>
__device__ __forceinline__ void gemm_run(const u16* A, const u16* Bt, int N, const Epi& E, char* smem) {
  pg8::Gemm g; g.A = A; g.Bt = Bt; g.M = T; g.N = N; g.K = 1024;
  pg8::StaticOrder S; S.init(T, N, (int)gridDim.x, (int)blockIdx.x);
  pg8::gemm_phase<Epi, pg8::StaticOrder, false>((PG8_LAS unsigned char*)smem, g, S, E, nullptr);
  __syncthreads();
}

__device__ __forceinline__ bf16x8 tr8(LAS u16* base, int e0, int e1) {
  const s16x4 lo = __builtin_amdgcn_ds_read_tr16_b64_v4i16((LAS s16x4*)(base + e0));
  const s16x4 hi = __builtin_amdgcn_ds_read_tr16_b64_v4i16((LAS s16x4*)(base + e1));
  return __builtin_shufflevector(lo, hi, 0, 1, 2, 3, 4, 5, 6, 7);
}
__device__ __forceinline__ void mlstm_task(const P& p, int task, char* smem) {
  const int tid = threadIdx.x, lane = tid & 63, wave = tid >> 6, l15 = lane & 15, quad = lane >> 4;
  const bool lat = task < 128;
  const int id = lat ? task : task - 128;
  const int slice = id & 3, dir = (id >> 2) & 1, head = (id >> 3) & 3, bat = id >> 5;
  const int tb = lat ? TCTX + bat * 4096 : bat * 256;
  const int L = lat ? 4096 : 256;
  const int nch = L >> 6;
  const int gcol = dir * 4 + head;
  const float scale = 0.08838834764831845f;

  u16* sQ = (u16*)smem;
  u16* sK = sQ + 2 * 64 * 136;
  u16* sKw = sK + 64 * 136;
  u16* sV = sKw + 2 * 64 * 136;
  u16* sS = sV + 2 * 64 * 40;
  u16* sCt = sS + 2 * 64 * 72;
  LAS u16* lds16 = (LAS u16*)smem;
  const int oKw = 2 * 64 * 136 + 64 * 136, oV = oKw + 2 * 64 * 136;
  float* fl = (float*)(sCt + 2 * 32 * 136);
  float* sg = fl;
  float* smm = fl + 64;
  float* sa = fl + 128;
  float* semt = fl + 256;
  float* sden = fl + 384;
  float* sqn = fl + 512;
  float* sN = fl + 576;
  float* sM = fl + 832;
  float* sMMT = fl + 904;
  float* sDecay = fl + 968;
  float* sBT = fl + 1032;
  float* sGT = fl + 1096;
  float* scn = p.scan + (size_t)blockIdx.x * 12288;

  const int sbase = (bat * 2 + dir) * 4 + head;
  const bool isP = wave < 4;
  const int cw = wave - 4;
  __syncthreads();
  {
    const float big = p.b_igate[gcol], bfg = p.b_fgate[gcol];
    for (int ch = wave; ch < nch; ch += 8) {
      const int posl = ch * 64 + lane;
      const int tl = tb + (dir ? (L - 1 - posl) : posl);
      const float ig = p.gates[(size_t)tl * 16 + gcol] + big;
      const float fr = p.gates[(size_t)tl * 16 + 8 + gcol] + bfg;
      const float lf = fminf(fr, 0.f) - log1pf(expf(-fabsf(fr)));
      float b = lf;
#pragma unroll
      for (int off = 1; off < 64; off <<= 1) { float v = __shfl_up(b, off); if (lane >= off) b += v; }
      const float g = ig - b;
      float G = g;
#pragma unroll
      for (int off = 1; off < 64; off <<= 1) { float v = __shfl_up(G, off); if (lane >= off) G = fmaxf(G, v); }
      scn[ch * 64 + lane] = b; scn[4096 + ch * 64 + lane] = g; scn[8192 + ch * 64 + lane] = G;
      if (lane == 63) { sBT[ch] = b; sGT[ch] = G; }
    }
  }
  f32x4 C[2][2];
#pragma unroll
  for (int a = 0; a < 2; ++a)
#pragma unroll
    for (int vt = 0; vt < 2; ++vt) C[a][vt] = (f32x4){0.f, 0.f, 0.f, 0.f};
  if (!isP) {
    if (lat) {
#pragma unroll
      for (int a = 0; a < 2; ++a)
#pragma unroll
        for (int vt = 0; vt < 2; ++vt)
#pragma unroll
          for (int r = 0; r < 4; ++r)
            C[a][vt][r] = p.state_C[(size_t)sbase * 16384 + ((2 * cw + a) * 16 + quad * 4 + r) * 128 + slice * 32 + vt * 16 + l15];
    }
    if (tid - 256 < 128) sN[tid - 256] = lat ? p.state_n[sbase * 128 + (tid - 256)] : 0.f;
#pragma unroll
    for (int a = 0; a < 2; ++a)
#pragma unroll
      for (int vt = 0; vt < 2; ++vt) {
        uint2 o; o.x = pack2(C[a][vt][0], C[a][vt][1]); o.y = pack2(C[a][vt][2], C[a][vt][3]);
        *(uint2*)&sCt[(vt * 16 + l15) * 136 + (2 * cw + a) * 16 + quad * 4] = o;
      }
  }
  __syncthreads();
  if (wave == 0) {
    const float m0 = lat ? p.state_m[sbase] : 0.f;
    const float gt = lane < nch ? sGT[lane] : 0.f;
    float a = lane < nch ? sBT[lane] : 0.f;
    float d = lane < nch ? gt + a : -__builtin_huge_valf();
#pragma unroll
    for (int off = 1; off < 64; off <<= 1) {
      const float ap = __shfl_up(a, off), dp = __shfl_up(d, off);
      if (lane >= off) { d = fmaxf(dp + a, d); a = ap + a; }
    }
    const float m_next = fmaxf(m0 + a, d);
    float m_c = __shfl_up(m_next, 1);
    if (lane == 0) m_c = m0;
    if (lane < nch) {
      const float mmT = fmaxf(m_c, gt);
      sM[lane] = m_c; sMMT[lane] = mmT; sDecay[lane] = __expf(m_c - mmT);
    }
    if (lane == nch - 1) sM[nch] = m_next;
  }
  const int s = (tid & 255) >> 2, part = tid & 3;
  uint4 rq0, rq1, rq2, rq3, rk0, rk1, rk2, rk3, rv; float rb = 0.f, rg = 0.f, rG = 0.f;
  rq0 = rq1 = rq2 = rq3 = rk0 = rk1 = rk2 = rk3 = rv = make_uint4(0u, 0u, 0u, 0u);
#define ML_LOAD(CH)                                                                        \
  {                                                                                        \
    const int poss_ = (CH) * 64 + s;                                                       \
    const int ts_ = tb + (dir ? (L - 1 - poss_) : poss_);                                  \
    const u16* prow_ = p.proj + (size_t)ts_ * NPROJ;                                       \
    rq0 = *(const uint4*)&prow_[1536 + head * 128 + part * 32];                            \
    rq1 = *(const uint4*)&prow_[1536 + head * 128 + part * 32 + 8];                        \
    rq2 = *(const uint4*)&prow_[1536 + head * 128 + part * 32 + 16];                       \
    rq3 = *(const uint4*)&prow_[1536 + head * 128 + part * 32 + 24];                       \
    rk0 = *(const uint4*)&prow_[2048 + head * 128 + part * 32];                            \
    rk1 = *(const uint4*)&prow_[2048 + head * 128 + part * 32 + 8];                        \
    rk2 = *(const uint4*)&prow_[2048 + head * 128 + part * 32 + 16];                       \
    rk3 = *(const uint4*)&prow_[2048 + head * 128 + part * 32 + 24];                       \
    rv = *(const uint4*)&prow_[2560 + head * 128 + slice * 32 + part * 8];                 \
    rb = scn[poss_]; rg = scn[4096 + poss_]; rG = scn[8192 + poss_];                       \
  }
  __syncthreads();
  if (isP) ML_LOAD(0)

  float* hout = p.out + (size_t)dir * T * 512;
  f32x4 aqc[2];
  aqc[0] = (f32x4){0.f, 0.f, 0.f, 0.f}; aqc[1] = (f32x4){0.f, 0.f, 0.f, 0.f};
  for (int c = -1; c < nch; ++c) {
    const int n = c + 1, q = n & 1, pz = c & 1;
    if (isP) {
      if (n < nch) {
        const float m_n = sM[n], mmT = sMMT[n];
        const float mm = fmaxf(m_n, rG);
        const float w = __expf(rg - mmT);
        if (part == 0) {
          sg[s] = rg; smm[s] = mm; sa[q * 64 + s] = __expf(m_n - mm); semt[q * 64 + s] = __expf(-(rb + mm)); sden[q * 64 + s] = 0.f;
        }
        u16* dQ = sQ + q * 64 * 136;
        u16* dKw = sKw + q * 64 * 136;
        u16* dV = sV + q * 64 * 40;
        *(uint4*)&dQ[s * 136 + part * 32] = rq0;
        *(uint4*)&dQ[s * 136 + part * 32 + 8] = rq1;
        *(uint4*)&dQ[s * 136 + part * 32 + 16] = rq2;
        *(uint4*)&dQ[s * 136 + part * 32 + 24] = rq3;
        *(uint4*)&sK[s * 136 + part * 32] = rk0;
        *(uint4*)&sK[s * 136 + part * 32 + 8] = rk1;
        *(uint4*)&sK[s * 136 + part * 32 + 16] = rk2;
        *(uint4*)&sK[s * 136 + part * 32 + 24] = rk3;
#define KW_(W) pack2(lo_f(W) * w, hi_f(W) * w)
        *(uint4*)&dKw[s * 136 + part * 32] = make_uint4(KW_(rk0.x), KW_(rk0.y), KW_(rk0.z), KW_(rk0.w));
        *(uint4*)&dKw[s * 136 + part * 32 + 8] = make_uint4(KW_(rk1.x), KW_(rk1.y), KW_(rk1.z), KW_(rk1.w));
        *(uint4*)&dKw[s * 136 + part * 32 + 16] = make_uint4(KW_(rk2.x), KW_(rk2.y), KW_(rk2.z), KW_(rk2.w));
        *(uint4*)&dKw[s * 136 + part * 32 + 24] = make_uint4(KW_(rk3.x), KW_(rk3.y), KW_(rk3.z), KW_(rk3.w));
#undef KW_
        *(uint4*)&dV[s * 40 + part * 8] = rv;
        if (n + 1 < nch) ML_LOAD(n + 1)
      }
    } else {
      if (c >= 0) {
        const int ctid = tid - 256;
        const u16* cQ = sQ + pz * 64 * 136;
        const int eKw = oKw + pz * 64 * 136, eV = oV + pz * 64 * 40;
        const int tq = l15 >> 2, tp = l15 & 3;
        const u16* cCt = sCt + pz * 32 * 136;
        u16* nCt = sCt + (pz ^ 1) * 32 * 136;
        const float* cN = sN + pz * 128;
        float* nN = sN + (pz ^ 1) * 128;
        {
          const int t = ctid >> 2, pt = ctid & 3;
          float qn = 0.f;
#pragma unroll
          for (int i = 0; i < 4; ++i) {
            const uint4 qv = *(const uint4*)&cQ[t * 136 + pt * 32 + i * 8];
            const float4 n0 = *(const float4*)&cN[pt * 32 + i * 8];
            const float4 n1 = *(const float4*)&cN[pt * 32 + i * 8 + 4];
            qn += lo_f(qv.x) * n0.x + hi_f(qv.x) * n0.y + lo_f(qv.y) * n0.z + hi_f(qv.y) * n0.w
                + lo_f(qv.z) * n1.x + hi_f(qv.z) * n1.y + lo_f(qv.w) * n1.z + hi_f(qv.w) * n1.w;
          }
          qn += __int_as_float(__builtin_amdgcn_update_dpp(0, __float_as_int(qn), 0xB1, 0xF, 0xF, true));
          qn += __int_as_float(__builtin_amdgcn_update_dpp(0, __float_as_int(qn), 0x4E, 0xF, 0xF, true));
          if (pt == 0) sqn[t] = qn * scale;
        }
        const int trow = cw * 16 + l15;
#pragma unroll
        for (int ti = 0; ti < 2; ++ti) {
          f32x4 acc = (f32x4){0.f, 0.f, 0.f, 0.f};
#pragma unroll
          for (int ks = 0; ks < 4; ++ks) {
            bf16x8 afr = *(const bf16x8*)&cCt[(ti * 16 + l15) * 136 + ks * 32 + quad * 8];
            bf16x8 bfr = *(const bf16x8*)&cQ[trow * 136 + ks * 32 + quad * 8];
            acc = mfma16(afr, bfr, acc);
          }
          aqc[ti] = acc;
        }
        const float decay = sDecay[c];
        const bf16x8 ones = (bf16x8){0x3F80, 0x3F80, 0x3F80, 0x3F80, 0x3F80, 0x3F80, 0x3F80, 0x3F80};
        bf16x8 vfr[2][2];
#pragma unroll
        for (int vt = 0; vt < 2; ++vt)
#pragma unroll
          for (int ks = 0; ks < 2; ++ks) {
            const int s0 = ks * 32 + quad * 8;
            vfr[vt][ks] = tr8(lds16, eV + (s0 + tq) * 40 + vt * 16 + 4 * tp, eV + (s0 + 4 + tq) * 40 + vt * 16 + 4 * tp);
          }
#pragma unroll
        for (int a = 0; a < 2; ++a) {
          const int kt = 2 * cw + a;
          bf16x8 kfr[2];
#pragma unroll
          for (int ks = 0; ks < 2; ++ks) {
            const int s0 = ks * 32 + quad * 8;
            kfr[ks] = tr8(lds16, eKw + (s0 + tq) * 136 + kt * 16 + 4 * tp, eKw + (s0 + 4 + tq) * 136 + kt * 16 + 4 * tp);
          }
          f32x4 accn = (f32x4){0.f, 0.f, 0.f, 0.f};
          accn = mfma16(kfr[0], ones, accn);
          accn = mfma16(kfr[1], ones, accn);
#pragma unroll
          for (int vt = 0; vt < 2; ++vt) {
            C[a][vt][0] *= decay; C[a][vt][1] *= decay; C[a][vt][2] *= decay; C[a][vt][3] *= decay;
            C[a][vt] = mfma16(kfr[0], vfr[vt][0], C[a][vt]);
            C[a][vt] = mfma16(kfr[1], vfr[vt][1], C[a][vt]);
            uint2 o; o.x = pack2(C[a][vt][0], C[a][vt][1]); o.y = pack2(C[a][vt][2], C[a][vt][3]);
            *(uint2*)&nCt[(vt * 16 + l15) * 136 + kt * 16 + quad * 4] = o;
          }
          if (l15 == 0) {
#pragma unroll
            for (int r = 0; r < 4; ++r) {
              const int idx = kt * 16 + quad * 4 + r;
              nN[idx] = decay * cN[idx] + accn[r];
            }
          }
        }
      }
    }
    asm volatile("s_waitcnt lgkmcnt(0)" ::: "memory"); __builtin_amdgcn_s_barrier(); asm volatile("" ::: "memory");
    if (isP) {
      if (n < nch) {
        const u16* dQ = sQ + q * 64 * 136;
        u16* dS = sS + q * 64 * 72;
        const int trow = wave * 16 + l15;
        const float mmt = smm[trow];
        float psum = 0.f;
#pragma unroll
        for (int si = 0; si < 4; ++si) {
          const int s0 = si * 16 + quad * 4;
          uint2 o = make_uint2(0u, 0u);
          if (si <= wave) {
            f32x4 acc = (f32x4){0.f, 0.f, 0.f, 0.f};
#pragma unroll
            for (int ks = 0; ks < 4; ++ks) {
              bf16x8 afr = *(const bf16x8*)&sK[(si * 16 + l15) * 136 + ks * 32 + quad * 8];
              bf16x8 bfr = *(const bf16x8*)&dQ[trow * 136 + ks * 32 + quad * 8];
              acc = mfma16(afr, bfr, acc);
            }
            float vals[4];
#pragma unroll
            for (int r = 0; r < 4; ++r) {
              const int sidx = s0 + r;
              const float e = __expf(fminf(sg[sidx] - mmt, 0.f));
              vals[r] = (sidx <= trow) ? acc[r] * scale * e : 0.f;
              psum += vals[r];
            }
            o.x = pack2(vals[0], vals[1]); o.y = pack2(vals[2], vals[3]);
          }
          *(uint2*)&dS[trow * 72 + s0] = o;
        }
        atomicAdd(&sden[q * 64 + trow], psum);
      }
    } else {
      if (c >= 0) {
        const int eV = oV + pz * 64 * 40;
        const int tq = l15 >> 2, tp = l15 & 3;
        const u16* cS = sS + pz * 64 * 72;
        const int trow = cw * 16 + l15;
        const float a_t = sa[pz * 64 + trow];
        const float den = a_t * sqn[trow] + sden[pz * 64 + trow];
        const float inv = 1.f / fmaxf(fabsf(den), semt[pz * 64 + trow]);
        const float as = a_t * scale;
        const int post = c * 64 + trow;
        const int tt = tb + (dir ? (L - 1 - post) : post);
#pragma unroll
        for (int ti = 0; ti < 2; ++ti) {
          f32x4 asv = (f32x4){0.f, 0.f, 0.f, 0.f};
#pragma unroll
          for (int ks = 0; ks < 2; ++ks) {
            const int s0 = ks * 32 + quad * 8;
            bf16x8 afr = tr8(lds16, eV + (s0 + tq) * 40 + ti * 16 + 4 * tp, eV + (s0 + 4 + tq) * 40 + ti * 16 + 4 * tp);
            bf16x8 bfr = *(const bf16x8*)&cS[trow * 72 + ks * 32 + quad * 8];
            asv = mfma16(afr, bfr, asv);
          }
          float4 h = make_float4((as * aqc[ti][0] + asv[0]) * inv, (as * aqc[ti][1] + asv[1]) * inv,
                                 (as * aqc[ti][2] + asv[2]) * inv, (as * aqc[ti][3] + asv[3]) * inv);
          *(float4*)&hout[(size_t)tt * 512 + head * 128 + slice * 32 + ti * 16 + quad * 4] = h;
        }
      }
    }
    asm volatile("s_waitcnt lgkmcnt(0)" ::: "memory"); __builtin_amdgcn_s_barrier(); asm volatile("" ::: "memory");
  }
#undef ML_LOAD
  if (!lat && !isP) {
    float* newC = p.out + (size_t)T * D;
    float* newn = newC + (size_t)32 * 2 * 4 * 128 * 128;
    float* newm = newn + 32 * 2 * 4 * 128;
#pragma unroll
    for (int a = 0; a < 2; ++a)
#pragma unroll
      for (int vt = 0; vt < 2; ++vt)
#pragma unroll
        for (int r = 0; r < 4; ++r)
          newC[(size_t)sbase * 16384 + ((2 * cw + a) * 16 + quad * 4 + r) * 128 + slice * 32 + vt * 16 + l15] = C[a][vt][r];
    if (slice == 0) {
      const int ctid = tid - 256;
      if (ctid < 128) newn[sbase * 128 + ctid] = sN[(nch & 1) * 128 + ctid];
      if (ctid == 0) newm[sbase] = sM[nch];
    }
  }
}

__device__ __forceinline__ void phase_mlstm(const P& p, char* smem) {
  const int G = gridDim.x, b = blockIdx.x;
  if (G >= 256) {
    if (b < 128) mlstm_task(p, b, smem);
    else {
      for (int task = b; task < 1152; task += G - 128) mlstm_task(p, task, smem);
      if (p.conv_early) convert_tables(p, b - 128, G - 128);
    }
  } else {
    for (int task = b; task < 1152; task += G) mlstm_task(p, task, smem);
    if (p.conv_early) convert_tables(p, b, G);
  }
}

__device__ __forceinline__ void phase_mix(const P& p) {
  const int wave = threadIdx.x >> 6, lane = threadIdx.x & 63;
  for (int t = blockIdx.x * 8 + wave; t < T; t += gridDim.x * 8) {
    const u16* pr = p.proj + (size_t)t * NPROJ;
    const int seg = t < TCTX ? 256 : 64;
    const int pos = (t < TCTX ? t : t - TCTX) & (seg - 1);
    const bool hasL = pos > 0, hasR = pos < seg - 1;
    const int c0 = lane * 8;
    const uint4 zero4 = make_uint4(0u, 0u, 0u, 0u);
    const uint4 bg = *(const uint4*)&pr[c0];
    const uint4 cgC = *(const uint4*)&pr[512 + c0];
    const uint4 xgC = *(const uint4*)&pr[1024 + c0];
    const uint4 cgL = hasL ? *(const uint4*)&pr[-NPROJ + 512 + c0] : zero4;
    const uint4 xgL = hasL ? *(const uint4*)&pr[-NPROJ + 1024 + c0] : zero4;
    const uint4 cgR = hasR ? *(const uint4*)&pr[NPROJ + 512 + c0] : zero4;
    const uint4 xgR = hasR ? *(const uint4*)&pr[NPROJ + 1024 + c0] : zero4;
    const unsigned bgw[4] = {bg.x, bg.y, bg.z, bg.w};
    const unsigned cC[4] = {cgC.x, cgC.y, cgC.z, cgC.w}, xC[4] = {xgC.x, xgC.y, xgC.z, xgC.w};
    const unsigned cL[4] = {cgL.x, cgL.y, cgL.z, cgL.w}, xL[4] = {xgL.x, xgL.y, xgL.z, xgL.w};
    const unsigned cR[4] = {cgR.x, cgR.y, cgR.z, cgR.w}, xR[4] = {xgR.x, xgR.y, xgR.z, xgR.w};
    unsigned ow[4];
#pragma unroll
    for (int j = 0; j < 4; ++j) {
      const int ch = c0 + 2 * j;
      float w0a = p.conv_w[ch], w1a = p.conv_w[512 + ch], w2a = p.conv_w[1024 + ch], ba = p.conv_b[ch];
      float w0b = p.conv_w[ch + 1], w1b = p.conv_w[512 + ch + 1], w2b = p.conv_w[1024 + ch + 1], bb = p.conv_b[ch + 1];
      float ya = w0a * (lo_f(cL[j]) * lo_f(xL[j])) + w1a * (lo_f(cC[j]) * lo_f(xC[j])) + w2a * (lo_f(cR[j]) * lo_f(xR[j])) + ba;
      float yb = w0b * (hi_f(cL[j]) * hi_f(xL[j])) + w1b * (hi_f(cC[j]) * hi_f(xC[j])) + w2b * (hi_f(cR[j]) * hi_f(xR[j])) + bb;
      ow[j] = pack2(lo_f(bgw[j]) * ya, hi_f(bgw[j]) * yb);
    }
    *(uint4*)&p.hbuf[(size_t)t * D + c0] = make_uint4(ow[0], ow[1], ow[2], ow[3]);
    const float* hf = p.out + (size_t)t * 512 + c0;
    const float* hb = p.out + (size_t)T * 512 + (size_t)t * 512 + c0;
    const float4 f0 = *(const float4*)&hf[0], f1 = *(const float4*)&hf[4];
    const float4 b0 = *(const float4*)&hb[0], b1 = *(const float4*)&hb[4];
    float h[8] = {f0.x + b0.x, f0.y + b0.y, f0.z + b0.z, f0.w + b0.w, f1.x + b1.x, f1.y + b1.y, f1.z + b1.z, f1.w + b1.w};
    float ss = 0.f;
#pragma unroll
    for (int j = 0; j < 8; ++j) ss += h[j] * h[j];
    ss += __shfl_xor(ss, 1); ss += __shfl_xor(ss, 2); ss += __shfl_xor(ss, 4); ss += __shfl_xor(ss, 8);
    const float r = rsqrtf(ss * (1.f / 128.f) + EPS);
    const uint4 og = *(const uint4*)&pr[3072 + c0];
    const unsigned ogw[4] = {og.x, og.y, og.z, og.w};
    unsigned mw[4];
#pragma unroll
    for (int j = 0; j < 4; ++j) {
      float ga = p.g_mlstm[c0 + 2 * j], gb = p.g_mlstm[c0 + 2 * j + 1];
      float oa = lo_f(ogw[j]), ob = hi_f(ogw[j]);
      float sa_ = 1.f / (1.f + expf(-oa)), sb_ = 1.f / (1.f + expf(-ob));
      mw[j] = pack2(h[2 * j] * r * ga * sa_, h[2 * j + 1] * r * gb * sb_);
    }
    *(uint4*)&p.hbuf[(size_t)t * D + 512 + c0] = make_uint4(mw[0], mw[1], mw[2], mw[3]);
  }
}

__device__ __forceinline__ unsigned f2key(float f) {
  const unsigned u = __float_as_uint(f);
  return (u & 0x80000000u) ? ~u : (u | 0x80000000u);
}
__device__ __forceinline__ float key2f(unsigned k, unsigned mask) {
  const unsigned m = k & ~mask;
  const unsigned u = (m & 0x80000000u) ? (m & 0x7fffffffu) : ~m;
  return __uint_as_float(u);
}
#define KINSERT(LIST, KEY)                                   \
  {                                                          \
    unsigned kk_ = (KEY);                                    \
    _Pragma("unroll") for (int j_ = 0; j_ < 16; ++j_) {      \
      const unsigned hi_ = max(LIST[j_], kk_);               \
      kk_ = min(LIST[j_], kk_);                              \
      LIST[j_] = hi_;                                        \
    }                                                        \
  }

__device__ __forceinline__ void bsort16_desc(unsigned (&a)[16]) {
#pragma unroll
  for (int k = 2; k <= 16; k <<= 1) {
#pragma unroll
    for (int j = k >> 1; j > 0; j >>= 1) {
#pragma unroll
      for (int i = 0; i < 16; ++i) {
        const int l = i ^ j;
        if (l > i) {
          const unsigned hi = max(a[i], a[l]), lo = min(a[i], a[l]);
          if ((i & k) == 0) { a[i] = hi; a[l] = lo; } else { a[i] = lo; a[l] = hi; }
        }
      }
    }
  }
}
__device__ __forceinline__ void bmerge16_desc(unsigned (&a)[16]) {
#pragma unroll
  for (int j = 8; j > 0; j >>= 1) {
#pragma unroll
    for (int i = 0; i < 16; ++i) {
      const int l = i ^ j;
      if (l > i) { const unsigned hi = max(a[i], a[l]), lo = min(a[i], a[l]); a[i] = hi; a[l] = lo; }
    }
  }
}
__device__ __forceinline__ void top16_merge(unsigned (&L)[16], const unsigned (&G)[16]) {
#pragma unroll
  for (int i = 0; i < 16; ++i) L[i] = max(L[i], G[15 - i]);
  bmerge16_desc(L);
}
__device__ constexpr int PEER_PA[64] = {0, 0, 0, 0, 0, 0, 0, 0, 0, 0, 0, 0, 0, 0, 0, 0, 1, 1, 1, 1, 1, 1, 1, 1, 2, 2, 2, 2, 2, 3, 3, 3, 3, 4, 4, 4, 5, 5, 6, 6, 7, 7, 8, 9, 10, 11, 12, 13, 14, 15, -1, -1, -1, -1, -1, -1, -1, -1, -1, -1, -1, -1, -1, -1};
__device__ constexpr int PEER_PB[64] = {0, 1, 2, 3, 4, 5, 6, 7, 8, 9, 10, 11, 12, 13, 14, 15, 0, 1, 2, 3, 4, 5, 6, 7, 0, 1, 2, 3, 4, 0, 1, 2, 3, 0, 1, 2, 0, 1, 0, 1, 0, 1, 0, 0, 0, 0, 0, 0, 0, 0, 0, 0, 0, 0, 0, 0, 0, 0, 0, 0, 0, 0, 0, 0};
#define SBAR __builtin_amdgcn_sched_barrier(0)
__device__ __forceinline__ int launder(int v) { asm volatile("" : "+v"(v)); return v; }
#define G_ISSUE(BUF, TAB, IDS)                                                 \
  _Pragma("unroll") for (int i_ = 0; i_ < 16; ++i_) {                          \
    const unsigned e_ = (unsigned)__builtin_amdgcn_readlane(IDS, i_);          \
    const unsigned off_ = (e_ << 10) + (unsigned)lane * 16u;     \
    BUF[i_] = *(const uint4*)((const unsigned char*)(TAB) + off_);             \
  }
#define U_DW(DW, J)                                                                        \
  acc_ = __builtin_elementwise_fma(__builtin_amdgcn_cvt_pk_f32_fp8(DW, false), hp[2 * (J)], acc_);      \
  acc_ = __builtin_elementwise_fma(__builtin_amdgcn_cvt_pk_f32_fp8(DW, true), hp[2 * (J) + 1], acc_);
#define G_DOTU(BUF)                                                            \
  _Pragma("unroll") for (int i_ = 0; i_ < 16; ++i_) {                          \
    f2v acc_ = (f2v){0.f, 0.f};                                                \
    U_DW(BUF[i_].x, 0) U_DW(BUF[i_].y, 1) U_DW(BUF[i_].z, 2) U_DW(BUF[i_].w, 3) \
    pa[i_] = acc_.x + acc_.y;                                                  \
  }
#define V_DW(DW, J)                                                                        \
  o2[2 * (J)] = __builtin_elementwise_fma(__builtin_amdgcn_cvt_pk_f32_fp8(DW, false), wv_, o2[2 * (J)]);      \
  o2[2 * (J) + 1] = __builtin_elementwise_fma(__builtin_amdgcn_cvt_pk_f32_fp8(DW, true), wv_, o2[2 * (J) + 1]);
#define G_ACCV(BUF)                                                            \
  _Pragma("unroll") for (int i_ = 0; i_ < 16; ++i_) {                          \
    const float w_ = __int_as_float(__builtin_amdgcn_readlane(wbits, i_));     \
    const f2v wv_ = (f2v){w_, w_};                                             \
    V_DW(BUF[i_].x, 0) V_DW(BUF[i_].y, 1) V_DW(BUF[i_].z, 2) V_DW(BUF[i_].w, 3) \
  }

__device__ __forceinline__ float gelu_as(float v) {
  const float av = fabsf(v);
  const float t = __builtin_amdgcn_rcpf(av * 0.2316418882f + 1.0f);
  float q = t * 0.5307027145f + (-0.7265760135f);
  q = q * t + 0.7107068705f; q = q * t + (-0.142248368f); q = q * t + 0.127414796f; q = q * t;
  const float e = __builtin_amdgcn_exp2f((v * v) * (-0.72134752044f));
  const float m = v * (q * e);
  return v < 0.f ? m : v - m;
}
#define G_DOTU_MFMA(BUF)                                                                   \
  _Pragma("unroll") for (int i_ = 0; i_ < 16; ++i_) {                                      \
    const long alo_ = (long)(((unsigned long long)BUF[i_].y << 32) | (unsigned long long)BUF[i_].x); \
    const long ahi_ = (long)(((unsigned long long)BUF[i_].w << 32) | (unsigned long long)BUF[i_].z); \
    f32x4 d_ = (f32x4){0.f, 0.f, 0.f, 0.f};                                                \
    d_ = __builtin_amdgcn_mfma_f32_16x16x32_fp8_fp8(alo_, h8lo, d_, 0, 0, 0);              \
    d_ = __builtin_amdgcn_mfma_f32_16x16x32_fp8_fp8(ahi_, h8hi, d_, 0, 0, 0);              \
    const float s01_ = dsel1 ? d_[1] : d_[0];                                              \
    const float s23_ = dsel1 ? d_[3] : d_[2];                                              \
    pa[i_] = diag ? (dsel2 ? s23_ : s01_) : 0.f;                                           \
  }
#define DPPF(X, CTRL) __int_as_float(__builtin_amdgcn_update_dpp(0, __float_as_int(X), CTRL, 0xF, 0xF, true))
#define REDUCE16(PA, Q1)                                                                   \
  {                                                                                        \
    float q8_[8], q4_[4], q2_[2];                                                          \
    const bool b3_ = (lane & 8) != 0, b2_ = (lane & 4) != 0, b1_ = (lane & 2) != 0, b0_ = (lane & 1) != 0; \
    _Pragma("unroll") for (int i_ = 0; i_ < 8; ++i_) { const float k_ = b3_ ? PA[i_ + 8] : PA[i_]; const float s_ = b3_ ? PA[i_] : PA[i_ + 8]; q8_[i_] = k_ + DPPF(s_, 0x128);   } \
    _Pragma("unroll") for (int i_ = 0; i_ < 4; ++i_) { const float k_ = b2_ ? q8_[i_ + 4] : q8_[i_]; const float s_ = b2_ ? q8_[i_] : q8_[i_ + 4]; q4_[i_] = k_ + __shfl_xor(s_, 4); } \
    _Pragma("unroll") for (int i_ = 0; i_ < 2; ++i_) { const float k_ = b1_ ? q4_[i_ + 2] : q4_[i_]; const float s_ = b1_ ? q4_[i_] : q4_[i_ + 2]; q2_[i_] = k_ + DPPF(s_, 0x4E);   } \
    { const float k_ = b0_ ? q2_[1] : q2_[0]; const float s_ = b0_ ? q2_[0] : q2_[1]; Q1 = k_ + DPPF(s_, 0xB1);   } \
    Q1 += __shfl_xor(Q1, 16); Q1 += __shfl_xor(Q1, 32);                                    \
  }
#define U_HEAD(BUF, IDS, SUI, SVI, HEAD)                                                   \
  {                                                                                        \
    float pa[16]; G_DOTU(BUF)                                                              \
    float q1_; REDUCE16(pa, q1_)                                                           \
    const float av_ = q1_ * (SUI);                                                         \
    const float ge_ = 0.5f * av_ * (1.f + erff(av_ * 0.7071067811865476f));                \
    const float w_ = sG[(tok * 8 + (HEAD)) * 16 + l15] * ge_ * (SVI);                      \
    if (lane < 16) { p.wbuf[(size_t)t * 128 + (HEAD) * 16 + lane] = w_; p.ibuf[(size_t)t * 128 + (HEAD) * 16 + lane] = (IDS); } \
  }

__device__ __forceinline__ void phase_peer(const P& p, char* smem) {
  unsigned* sc = (unsigned*)smem;
  unsigned* skey = sc + 256 * 130;
  int* sE = (int*)sc;
  float* sG = (float*)(sc + 2048);
  for (int it = blockIdx.x; it < T / 16; it += gridDim.x) {
    const int t0 = it * 16;
    __syncthreads();
    {
      const int tid = launder(threadIdx.x), lane = tid & 63, wave = tid >> 6, l15 = lane & 15, quad = lane >> 4;
      const int half = wave >> 2;
      const u16* kb = p.kb + half * 16384;
#pragma unroll 1
      for (int hh = 0; hh < 2; ++hh) {
        const int head = (wave & 3) * 2 + hh;
        bf16x8 qf[4];
#pragma unroll
        for (int ks = 0; ks < 4; ++ks)
          qf[ks] = *(const bf16x8*)&p.qp[(size_t)(t0 + l15) * 2048 + head * 256 + half * 128 + ks * 32 + quad * 8];
        const int row = (head * 2 + half) * 16 + l15;
#pragma unroll 1
        for (int nt = 0; nt < 8; ++nt) {
          f32x4 acc = (f32x4){0.f, 0.f, 0.f, 0.f};
#pragma unroll
          for (int ks = 0; ks < 4; ++ks) {
            bf16x8 kf = *(const bf16x8*)&kb[(nt * 16 + l15) * 128 + ks * 32 + quad * 8];
            acc = mfma16(kf, qf[ks], acc);
          }
          const int key = nt * 16 + quad * 4;
          const int pos = key + (key >= 64 ? 1 : 0);
#pragma unroll
          for (int r = 0; r < 4; ++r) sc[row * 130 + pos + r] = (f2key(acc[r]) & ~0x7Fu) | (unsigned)(127 - (key + r));
        }
      }
    }
    __syncthreads();
    {
      const int tid = launder(threadIdx.x);
      const int row = tid >> 1, hs = tid & 1;
      const unsigned* src = sc + row * 130 + hs * 65;
      unsigned list[16];
#pragma unroll
      for (int j = 0; j < 16; ++j) list[j] = src[j];
      bsort16_desc(list);
#pragma unroll 1
      for (int g = 1; g < 4; ++g) {
        unsigned grp[16];
#pragma unroll
        for (int j = 0; j < 16; ++j) grp[j] = src[g * 16 + j];
        bsort16_desc(grp);
        top16_merge(list, grp);
      }
      {
        unsigned other[16];
#pragma unroll
        for (int j = 0; j < 16; ++j) other[j] = __shfl_xor(list[j], 1);
        top16_merge(list, other);
      }
      if (hs == 0) {
#pragma unroll
        for (int j = 0; j < 16; ++j) skey[row * 16 + j] = list[j];
      }
    }
    __syncthreads();
    if (threadIdx.x < 128) {
      const int tid = launder(threadIdx.x);
      const int tok = tid & 15, head = tid >> 4;
      const int ra = (head * 2) * 16 + tok, rb = ra + 16;
      float v1[16], v2[16];
#pragma unroll
      for (int a = 0; a < 16; ++a) { v1[a] = key2f(skey[ra * 16 + a], 0x7Fu); v2[a] = key2f(skey[rb * 16 + a], 0x7Fu); }
      unsigned list[16];
#define CKEY(I) ((PEER_PA[I] < 0) ? 0u : ((f2key(v1[PEER_PA[I] < 0 ? 0 : PEER_PA[I]] + v2[PEER_PB[I]]) & ~0xFFu) | (unsigned)(255 - ((PEER_PA[I] < 0 ? 0 : PEER_PA[I]) * 16 + PEER_PB[I]))))
#pragma unroll
      for (int j = 0; j < 16; ++j) list[j] = CKEY(j);
      bsort16_desc(list);
#pragma unroll
      for (int g = 1; g < 4; ++g) {
        unsigned grp[16];
#pragma unroll
        for (int j = 0; j < 16; ++j) grp[j] = CKEY(g * 16 + j);
        bsort16_desc(grp);
        top16_merge(list, grp);
      }
#undef CKEY
      const float smax = key2f(list[0], 0xFFu);
      float ex[16];
      float se = 0.f;
#pragma unroll
      for (int q = 0; q < 16; ++q) { ex[q] = expf(key2f(list[q], 0xFFu) - smax); se += ex[q]; }
      const float inv = 1.f / se;
#pragma unroll
      for (int q = 0; q < 16; ++q) {
        const int flat = 255 - (int)(list[q] & 0xFFu);
        const int i1 = 127 - (int)(skey[ra * 16 + (flat >> 4)] & 0x7Fu);
        const int i2 = 127 - (int)(skey[rb * 16 + (flat & 15)] & 0x7Fu);
        sE[(tok * 8 + head) * 16 + q] = i1 * 128 + i2;
        sG[(tok * 8 + head) * 16 + q] = ex[q] * inv;
      }
    }
    __syncthreads();
    {
      const int tid = threadIdx.x;
#pragma unroll
      for (int i = 0; i < 4; ++i) {
        const int idx = i * NT + tid;
        p.ibuf[(size_t)t0 * 128 + idx] = sE[idx];
        p.wbuf[(size_t)t0 * 128 + idx] = sG[idx];
      }
    }
  }
}

__device__ __forceinline__ void phase_peer_u(const P& p, char* smem) {
  const int lane = threadIdx.x & 63, wave = threadIdx.x >> 6, l15 = lane & 15;
  const unsigned lane16 = (unsigned)lane * 16u;
  int* lid = (int*)(smem + wave * 1536);
  int* lent = lid + 128;
  float* lg = (float*)(lent + 128);
  const int Gn = gridDim.x, bb = blockIdx.x;
  const int ngrp = bb < T / 16 ? (T / 16 - bb + Gn - 1) / Gn : 0;
  const int nseq = 2 * ngrp;
#define SEQ_TOK(S) (((bb + ((S) >> 1) * Gn) << 4) + wave * 2 + ((S) & 1))
#pragma unroll 1
  for (int r = launder(0); r < 2; ++r) {
    __syncthreads();
    int ids8n[8]; float g8n[8]; uint4 hxn0 = make_uint4(0u, 0u, 0u, 0u), hxn1 = make_uint4(0u, 0u, 0u, 0u);
#pragma unroll
    for (int h = 0; h < 8; ++h) { ids8n[h] = 0; g8n[h] = 0.f; }
    {
      const int tf = SEQ_TOK(0);
      if (nseq > 0) {
#pragma unroll
        for (int h = 0; h < 8; ++h) { ids8n[h] = p.ibuf[(size_t)tf * 128 + h * 16 + l15]; g8n[h] = p.wbuf[(size_t)tf * 128 + h * 16 + l15]; }
        hxn0 = *(const uint4*)&p.hbuf[(size_t)tf * D + lane * 16];
        hxn1 = *(const uint4*)&p.hbuf[(size_t)tf * D + lane * 16 + 8];
      }
    }
#pragma unroll 1
    for (int sq = 0; sq < nseq; ++sq) {
      const int t = SEQ_TOK(sq);
      int n = 0;
      const uint4 hx0 = hxn0, hx1 = hxn1;
      {
        int ids8[8]; float g8[8];
#pragma unroll
        for (int h = 0; h < 8; ++h) { ids8[h] = ids8n[h]; g8[h] = g8n[h]; }
        {
          const int tn = SEQ_TOK(sq + 1);
          if (sq + 1 < nseq) {
#pragma unroll
            for (int h = 0; h < 8; ++h) { ids8n[h] = p.ibuf[(size_t)tn * 128 + h * 16 + l15]; g8n[h] = p.wbuf[(size_t)tn * 128 + h * 16 + l15]; }
            hxn0 = *(const uint4*)&p.hbuf[(size_t)tn * D + lane * 16];
            hxn1 = *(const uint4*)&p.hbuf[(size_t)tn * D + lane * 16 + 8];
          }
        }
        asm volatile("s_waitcnt lgkmcnt(0)" ::: "memory");
#pragma unroll
        for (int h = 0; h < 8; ++h) {
          const bool valid = ((ids8[h] >> 13) & 1) == r;
          const unsigned m16 = (unsigned)__ballot(valid) & 0xFFFFu;
          const int pos = n + __builtin_popcount(m16 & ((1u << l15) - 1u));
          if (lane < 16 && valid) { lid[pos] = ids8[h]; lent[pos] = h * 16 + l15; lg[pos] = g8[h]; }
          n += __builtin_popcount(m16);
        }
        asm volatile("s_waitcnt lgkmcnt(0)" ::: "memory");
      }
      n = __builtin_amdgcn_readfirstlane(n);
      if (n == 0) continue;
      long h8lo, h8hi; float hinv;
      {
        const unsigned hw[8] = {hx0.x, hx0.y, hx0.z, hx0.w, hx1.x, hx1.y, hx1.z, hx1.w};
        float amax = 0.f;
#pragma unroll
        for (int j = 0; j < 8; ++j) amax = fmaxf(amax, fmaxf(fabsf(lo_f(hw[j])), fabsf(hi_f(hw[j]))));
#pragma unroll
        for (int o = 32; o > 0; o >>= 1) amax = fmaxf(amax, __shfl_xor(amax, o));
        const float hs = amax > 0.f ? 384.f / amax : 1.f;
        hinv = amax > 0.f ? amax * (1.f / 384.f) : 1.f;
        unsigned q[4];
#pragma unroll
        for (int j = 0; j < 4; ++j) {
          unsigned pk = 0u;
          pk = __builtin_amdgcn_cvt_pk_fp8_f32(lo_f(hw[2 * j]) * hs, hi_f(hw[2 * j]) * hs, pk, false);
          pk = __builtin_amdgcn_cvt_pk_fp8_f32(lo_f(hw[2 * j + 1]) * hs, hi_f(hw[2 * j + 1]) * hs, pk, true);
          q[j] = pk;
        }
        h8lo = (long)(((unsigned long long)q[1] << 32) | (unsigned long long)q[0]);
        h8hi = (long)(((unsigned long long)q[3] << 32) | (unsigned long long)q[2]);
      }
      const bool diag = (l15 >> 2) == (lane >> 4);
      const bool dsel1 = (l15 & 1) != 0, dsel2 = (l15 & 2) != 0;
      const int nu = (n + 15) >> 4;
      uint4 A[16], B[16];
#define U2_DESC(U, IDS, ENT, GT, SUI, SVI, OK)                                   \
      {                                                                         \
        const int j_ = (U) * 16 + l15;                                          \
        OK = j_ < n;                                                            \
        const int jc_ = OK ? j_ : 0;                                            \
        IDS = lid[jc_]; ENT = lent[jc_]; GT = lg[jc_];                          \
        SUI = p.sinv[IDS]; SVI = p.sinv[16384 + IDS];                           \
      }
#define U2_FIN(BUF, ENT, GT, SUI, SVI, OK)                                       \
      {                                                                         \
        float pa[16]; G_DOTU_MFMA(BUF)                                          \
        float q1_; REDUCE16(pa, q1_)                                            \
        const float av_ = q1_ * (SUI) * hinv;                                   \
        const float ge_ = gelu_as(av_);                                         \
        if (lane < 16 && (OK)) p.wbuf[(size_t)t * 128 + (ENT)] = (GT) * ge_ * (SVI); \
      }
      int idsA, entA, idsB = 0, entB = 0; float gA, suA, svA, gB = 0.f, suB = 0.f, svB = 0.f; bool okA, okB = false;
      U2_DESC(0, idsA, entA, gA, suA, svA, okA)
      G_ISSUE(A, p.ub8, idsA)
      SBAR;
#pragma unroll 1
      for (int u = 0; u < nu; u += 2) {
        const bool hasB = u + 1 < nu;
        if (hasB) { U2_DESC(u + 1, idsB, entB, gB, suB, svB, okB) G_ISSUE(B, p.ub8, idsB) }
        SBAR;
        U2_FIN(A, entA, gA, suA, svA, okA)
        SBAR;
        if (u + 2 < nu) { U2_DESC(u + 2, idsA, entA, gA, suA, svA, okA) G_ISSUE(A, p.ub8, idsA) }
        SBAR;
        if (hasB) { U2_FIN(B, entB, gB, suB, svB, okB) }
        SBAR;
      }
#undef U2_DESC
#undef U2_FIN
    }
  }
}

__device__ __forceinline__ void phase_peer_v(const P& p) {
  const int lane = threadIdx.x & 63, wave = threadIdx.x >> 6, l15 = lane & 15;
  const int tstride = gridDim.x * 8;
  int ids8n[8]; float w8n[8];
  {
    const int t0 = blockIdx.x * 8 + wave;
#pragma unroll
    for (int h = 0; h < 8; ++h) { ids8n[h] = 0; w8n[h] = 0.f; }
    if (t0 < T) {
#pragma unroll
      for (int h = 0; h < 8; ++h) { ids8n[h] = p.ibuf[(size_t)t0 * 128 + h * 16 + l15]; w8n[h] = p.wbuf[(size_t)t0 * 128 + h * 16 + l15]; }
    }
  }
#pragma unroll 1
  for (int t = blockIdx.x * 8 + wave; t < T; t += tstride) {
    int ids8[8]; float w8[8];
#pragma unroll
    for (int h = 0; h < 8; ++h) { ids8[h] = ids8n[h]; w8[h] = w8n[h]; }
    if (t + tstride < T) {
#pragma unroll
      for (int h = 0; h < 8; ++h) { ids8n[h] = p.ibuf[(size_t)(t + tstride) * 128 + h * 16 + l15]; w8n[h] = p.wbuf[(size_t)(t + tstride) * 128 + h * 16 + l15]; }
    }
    f2v o2[8];
#pragma unroll
    for (int j = 0; j < 8; ++j) o2[j] = (f2v){0.f, 0.f};
    uint4 A[16], B[16];
    G_ISSUE(A, p.vb8, ids8[0])
    SBAR;
#pragma unroll
    for (int h = 0; h < 8; ++h) {
      const int wbits = __float_as_int(w8[h]);
      if ((h & 1) == 0) {
        if (h < 7) { G_ISSUE(B, p.vb8, ids8[(h + 1) & 7]) }
        SBAR;
        G_ACCV(A)
      } else {
        if (h < 7) { G_ISSUE(A, p.vb8, ids8[(h + 1) & 7]) }
        SBAR;
        G_ACCV(B)
      }
      SBAR;
    }
    float o[16];
#pragma unroll
    for (int j = 0; j < 8; ++j) { o[2 * j] = o2[j].x; o[2 * j + 1] = o2[j].y; }
    const int ci = t < TCTX ? 0 : 1 + ((t - TCTX) >> 12);
    const float* ga2 = p.mod + ci * 6144 + 5 * 1024;
    float* xr = p.out + (size_t)t * D;
    float x2[16];
    float ss = 0.f;
#pragma unroll
    for (int q = 0; q < 4; ++q) {
      const int col = lane * 16 + q * 4;
      const float4 xa = *(const float4*)&xr[col];
      const float4 ga = *(const float4*)&ga2[col];
      x2[q * 4 + 0] = xa.x + ga.x * o[q * 4 + 0];
      x2[q * 4 + 1] = xa.y + ga.y * o[q * 4 + 1];
      x2[q * 4 + 2] = xa.z + ga.z * o[q * 4 + 2];
      x2[q * 4 + 3] = xa.w + ga.w * o[q * 4 + 3];
    }
#pragma unroll
    for (int j = 0; j < 16; ++j) ss += x2[j] * x2[j];
    ss = wave_sum(ss);
    const float rstd = rsqrtf(ss * (1.f / 1024.f) + EPS);
#pragma unroll
    for (int q = 0; q < 4; ++q) {
      const int col = lane * 16 + q * 4;
      const float4 g0 = *(const float4*)&p.g_final[col];
      *(float4*)&xr[col] = make_float4(x2[q * 4 + 0] * rstd * g0.x, x2[q * 4 + 1] * rstd * g0.y,
                                       x2[q * 4 + 2] * rstd * g0.z, x2[q * 4 + 3] * rstd * g0.w);
    }
  }
}

__device__ __forceinline__ void phase_peer_vr(const P& p, char* smem, int r) {
  const int lane = threadIdx.x & 63, wave = threadIdx.x >> 6, l15 = lane & 15;
  const unsigned lane16 = (unsigned)lane * 16u;
  int* lid = (int*)(smem + wave * 1024);
  float* lw = (float*)(lid + 128);
  u16* pbuf = p.qp;
  const int Gn = gridDim.x, bb = blockIdx.x;
  const int ngrp = bb < T / 16 ? (T / 16 - bb + Gn - 1) / Gn : 0;
  const int nseq = 2 * ngrp;
#pragma unroll 1
  for (int sq = 0; sq < nseq; ++sq) {
    const int t = SEQ_TOK(sq);
    int n = 0;
    {
      int ids8[8]; float w8[8];
#pragma unroll
      for (int h = 0; h < 8; ++h) { ids8[h] = p.ibuf[(size_t)t * 128 + h * 16 + l15]; w8[h] = p.wbuf[(size_t)t * 128 + h * 16 + l15]; }
      asm volatile("s_waitcnt lgkmcnt(0)" ::: "memory");
#pragma unroll
      for (int h = 0; h < 8; ++h) {
        const bool valid = ((ids8[h] >> 13) & 1) == r;
        const unsigned m16 = (unsigned)__ballot(valid) & 0xFFFFu;
        const int pos = n + __builtin_popcount(m16 & ((1u << l15) - 1u));
        if (lane < 16 && valid) { lid[pos] = ids8[h]; lw[pos] = w8[h]; }
        n += __builtin_popcount(m16);
      }
      asm volatile("s_waitcnt lgkmcnt(0)" ::: "memory");
    }
    n = __builtin_amdgcn_readfirstlane(n);
    f2v o2[8];
    if (r == 0) {
#pragma unroll
      for (int j = 0; j < 8; ++j) o2[j] = (f2v){0.f, 0.f};
    } else {
      const uint4 p0 = *(const uint4*)&pbuf[(size_t)t * D + lane * 16];
      const uint4 p1 = *(const uint4*)&pbuf[(size_t)t * D + lane * 16 + 8];
      o2[0] = (f2v){lo_f(p0.x), hi_f(p0.x)}; o2[1] = (f2v){lo_f(p0.y), hi_f(p0.y)};
      o2[2] = (f2v){lo_f(p0.z), hi_f(p0.z)}; o2[3] = (f2v){lo_f(p0.w), hi_f(p0.w)};
      o2[4] = (f2v){lo_f(p1.x), hi_f(p1.x)}; o2[5] = (f2v){lo_f(p1.y), hi_f(p1.y)};
      o2[6] = (f2v){lo_f(p1.z), hi_f(p1.z)}; o2[7] = (f2v){lo_f(p1.w), hi_f(p1.w)};
    }
    const int nu = (n + 15) >> 4;
    if (nu > 0) {
      uint4 A[16], B[16];
#define V2_DESC(U, IDS, W)                                                       \
      {                                                                         \
        const int j_ = (U) * 16 + l15;                                          \
        const bool ok_ = j_ < n;                                                \
        const int jc_ = ok_ ? j_ : 0;                                           \
        IDS = lid[jc_]; W = ok_ ? lw[jc_] : 0.f;                                \
      }
      int idsA, idsB = 0; float wA, wB = 0.f;
      V2_DESC(0, idsA, wA)
      G_ISSUE(A, p.vb8, idsA)
      SBAR;
#pragma unroll 1
      for (int u = 0; u < nu; u += 2) {
        const bool hasB = u + 1 < nu;
        if (hasB) { V2_DESC(u + 1, idsB, wB) G_ISSUE(B, p.vb8, idsB) }
        SBAR;
        { const int wbits = __float_as_int(wA); G_ACCV(A) }
        SBAR;
        if (u + 2 < nu) { V2_DESC(u + 2, idsA, wA) G_ISSUE(A, p.vb8, idsA) }
        SBAR;
        if (hasB) { const int wbits = __float_as_int(wB); G_ACCV(B) }
        SBAR;
      }
#undef V2_DESC
    }
    if (r == 0) {
      *(uint4*)&pbuf[(size_t)t * D + lane * 16] = make_uint4(pack2(o2[0].x, o2[0].y), pack2(o2[1].x, o2[1].y), pack2(o2[2].x, o2[2].y), pack2(o2[3].x, o2[3].y));
      *(uint4*)&pbuf[(size_t)t * D + lane * 16 + 8] = make_uint4(pack2(o2[4].x, o2[4].y), pack2(o2[5].x, o2[5].y), pack2(o2[6].x, o2[6].y), pack2(o2[7].x, o2[7].y));
    } else {
      float o[16];
#pragma unroll
      for (int j = 0; j < 8; ++j) { o[2 * j] = o2[j].x; o[2 * j + 1] = o2[j].y; }
      const int ci = t < TCTX ? 0 : 1 + ((t - TCTX) >> 12);
      const float* ga2 = p.mod + ci * 6144 + 5 * 1024;
      float* xr = p.out + (size_t)t * D;
      float x2[16];
      float ss = 0.f;
#pragma unroll
      for (int q = 0; q < 4; ++q) {
        const int col = lane * 16 + q * 4;
        const float4 xa = *(const float4*)&xr[col];
        const float4 ga = *(const float4*)&ga2[col];
        x2[q * 4 + 0] = xa.x + ga.x * o[q * 4 + 0];
        x2[q * 4 + 1] = xa.y + ga.y * o[q * 4 + 1];
        x2[q * 4 + 2] = xa.z + ga.z * o[q * 4 + 2];
        x2[q * 4 + 3] = xa.w + ga.w * o[q * 4 + 3];
      }
#pragma unroll
      for (int j = 0; j < 16; ++j) ss += x2[j] * x2[j];
      ss = wave_sum(ss);
      const float rstd = rsqrtf(ss * (1.f / 1024.f) + EPS);
#pragma unroll
      for (int q = 0; q < 4; ++q) {
        const int col = lane * 16 + q * 4;
        const float4 g0 = *(const float4*)&p.g_final[col];
        *(float4*)&xr[col] = make_float4(x2[q * 4 + 0] * rstd * g0.x, x2[q * 4 + 1] * rstd * g0.y,
                                         x2[q * 4 + 2] * rstd * g0.z, x2[q * 4 + 3] * rstd * g0.w);
      }
    }
  }
}

#define XB_TMO      128
#define XB_XCNT(j)  (256  + 64 * (j))
#define XB_XSUB(j)  (1280 + 64 * (j))
#define XB_XGEN(j)  (2304 + 64 * (j))
#define XB_TOP      3328
#define XB_TOPGEN   3392
#define XCD_BAR_WORDS 3456
#define XB_SPIN_CAP (1u << 22)
__device__ __forceinline__ unsigned xb_ld(unsigned* p) { return __hip_atomic_load(p, __ATOMIC_RELAXED, __HIP_MEMORY_SCOPE_AGENT); }
__device__ __forceinline__ unsigned xb_add(unsigned* p, unsigned v) { return __hip_atomic_fetch_add(p, v, __ATOMIC_RELAXED, __HIP_MEMORY_SCOPE_AGENT); }
__device__ __forceinline__ unsigned xb_xcc_id() { return (unsigned)__builtin_amdgcn_s_getreg((3 << 11) | 20) & 0xFu; }
#define XB_SPIN(cond, bar) do { unsigned _sp = 0; while (cond) { __builtin_amdgcn_s_sleep(1); \
    if ((++_sp & 255u) == 0u) { if (xb_ld(&(bar)[XB_TMO])) break; if (_sp > XB_SPIN_CAP) { atomicAdd(&(bar)[XB_TMO], 1u); break; } } } } while (0)
struct XcdBarrier { unsigned* bar; unsigned x; volatile LAS unsigned* st; };
__device__ __forceinline__ XcdBarrier xcd_barrier_post(unsigned* bar, volatile LAS unsigned* st) {
  XcdBarrier b; b.bar = bar; b.x = xb_xcc_id(); b.st = st;
  if (threadIdx.x == 0) (void)xb_add(&bar[XB_XCNT(b.x)], 1u);
  return b;
}
__device__ __forceinline__ void xcd_barrier_complete(unsigned* bar, unsigned x, unsigned& nloc, unsigned& nx) {
  const unsigned G = gridDim.x * gridDim.y * gridDim.z;
  unsigned sum, cnt, mine, sp = 0u;
  for (;;) {
    sum = 0u; cnt = 0u; mine = 0u;
#pragma unroll
    for (unsigned j = 0; j < 16; ++j) { const unsigned c = xb_ld(&bar[XB_XCNT(j)]); sum += c; cnt += (c > 0u) ? 1u : 0u; mine = (j == x) ? c : mine; }
    if (sum == G) break;
    __builtin_amdgcn_s_sleep(1);
    if ((++sp & 255u) == 0u) { if (xb_ld(&bar[XB_TMO])) break; if (sp > XB_SPIN_CAP) { atomicAdd(&bar[XB_TMO], 1u); break; } }
  }
  nloc = mine > 0u ? mine : 1u; nx = cnt > 0u ? cnt : 1u;
}
__device__ __forceinline__ void xcd_barrier(const XcdBarrier& b) {
  asm volatile("s_waitcnt vmcnt(0)" ::: "memory");
  __syncthreads();
  if (threadIdx.x == 0) {
    unsigned* bar = b.bar;
    __builtin_amdgcn_s_waitcnt(0);
    unsigned nloc = b.st[0], nx = b.st[1];
    if (nloc == 0u) { xcd_barrier_complete(bar, b.x, nloc, nx); b.st[0] = nloc; b.st[1] = nx; }
    const unsigned old = xb_add(&bar[XB_XSUB(b.x)], 1u);
    const unsigned gen = old / nloc;
    if (old + 1u == (gen + 1u) * nloc) {
      __builtin_amdgcn_fence(__ATOMIC_RELEASE, "agent");
      asm volatile("s_waitcnt vmcnt(0)" ::: "memory");
      const unsigned og = xb_add(&bar[XB_TOP], 1u);
      const unsigned tg = og / nx;
      if (og + 1u == (tg + 1u) * nx) xb_add(&bar[XB_TOPGEN], 1u);
      else XB_SPIN(xb_ld(&bar[XB_TOPGEN]) == tg, bar);
      __builtin_amdgcn_fence(__ATOMIC_ACQUIRE, "agent");
      xb_add(&bar[XB_XGEN(b.x)], 1u);
      asm volatile("s_waitcnt vmcnt(0)" ::: "memory");
    } else {
      XB_SPIN(xb_ld(&bar[XB_XGEN(b.x)]) == gen, bar);
      __builtin_amdgcn_fence(__ATOMIC_ACQUIRE, "agent");
      asm volatile("s_waitcnt vmcnt(0)" ::: "memory");
    }
  }
  __syncthreads();
}

__global__ void __launch_bounds__(NT) mega(P p, unsigned* bar, int use_cg) {
  extern __shared__ __attribute__((aligned(16))) char smem[];
  __shared__ uint4 xb_words;
  cg::grid_group grid = cg::this_grid();
  if (threadIdx.x == 0) xb_words = make_uint4(0u, 0u, 0u, 0u);
  __syncthreads();
  XcdBarrier xb = xcd_barrier_post(bar, (volatile LAS unsigned*)&xb_words);
#define SEAM() do { if (use_cg) grid.sync(); else xcd_barrier(xb); } while (0)
  phase_prep(p, smem);
  SEAM();
  phase_norm(p, 0);
  SEAM();
  { EpiProj e; e.proj = p.proj; e.gates = p.gates; gemm_run(p.hbuf, p.w_in_t, NPAD, e, smem); }
  {
    const int G = (int)gridDim.x, rem = ((T / 256) * (NPAD / 256)) % G;
    const int bi = rem == 0 ? (int)blockIdx.x : (int)blockIdx.x - rem;
    if (bi >= 0) phase_prep_late(p, smem, bi, rem == 0 ? G : G - rem);
  }
  SEAM();
  phase_mlstm(p, smem);
  SEAM();
  phase_mix(p);
  SEAM();
  { EpiResid e; e.x_prompt = p.x_prompt; e.x_sample = p.x_sample; e.mod = p.mod; e.out = p.out; gemm_run(p.hbuf, p.w_out_t, 1024, e, smem); }
  SEAM();
  phase_norm(p, 1);
  if (!p.conv_early) convert_tables(p, (int)blockIdx.x, (int)gridDim.x);
  SEAM();
  { EpiQ e; e.qp = p.qp; gemm_run(p.hbuf, p.wq_t, 2048, e, smem); }
  SEAM();
  phase_peer(p, smem);
  __syncthreads();
  phase_peer_u(p, smem);
  __syncthreads();
#pragma unroll 1
  for (int rr = launder(0); rr < 2; ++rr) {
    phase_peer_vr(p, smem, rr);
    __syncthreads();
  }
}

extern "C" void kernel_launch(void* const* d_in, const int* in_sizes, int n_in, void* d_out, int out_size,
                              void* d_ws, size_t ws_size, hipStream_t stream) {
  P p{};
  const float* const* in = (const float* const*)d_in;
  p.x_prompt = in[0]; p.x_sample = in[1]; p.state_C = in[2]; p.state_n = in[3]; p.state_m = in[4];
  p.c = in[5]; p.c_ctx = in[6]; p.w_ada = in[7]; p.b_ada = in[8]; p.g_norm1 = in[9]; p.w_in = in[10];
  p.b_igate = in[11]; p.b_fgate = in[12]; p.conv_w = in[13]; p.conv_b = in[14]; p.g_mlstm = in[15];
  p.w_out = in[16]; p.g_norm2 = in[17]; p.wq = in[18]; p.k1 = in[19]; p.k2 = in[20]; p.u = in[21]; p.v = in[22];
  p.g_final = in[23];
  p.out = (float*)d_out;
  char* ws = (char*)d_ws;
  size_t off = 0;
  auto take = [&](size_t bytes) { char* r = ws + off; off += (bytes + 255) & ~(size_t)255; return r; };
  p.mod = (float*)take(5 * 6144 * 4);
  p.w_in_t = (u16*)take((size_t)NPAD * 1024 * 2);
  p.w_out_t = (u16*)take((size_t)1024 * 1024 * 2);
  p.wq_t = (u16*)take((size_t)2048 * 1024 * 2);
  p.kb = (u16*)take(2 * 16384 * 2);
  p.gates = (float*)take((size_t)T * 16 * 4);
  p.hbuf = (u16*)take((size_t)T * D * 2);
  p.proj = (u16*)take((size_t)T * NPROJ * 2);
  p.qp = p.proj;
  p.wbuf = (float*)(p.proj + (size_t)70000000);
  p.ibuf = (int*)(p.wbuf + (size_t)T * 128);
  unsigned* bar = (unsigned*)take(XCD_BAR_WORDS * 4);
  p.scan = (float*)p.hbuf;
  const size_t tab_bytes = (size_t)2 * 16384 * 1024 + (size_t)2 * 16384 * 4;
  if (ws_size >= off + tab_bytes + 256) {
    p.ub8 = (unsigned char*)take((size_t)16384 * 1024);
    p.vb8 = (unsigned char*)take((size_t)16384 * 1024);
    p.sinv = (float*)take((size_t)2 * 16384 * 4);
    p.conv_early = 1;
  } else {
    p.ub8 = (unsigned char*)(p.proj + (size_t)T * 2048);
    p.vb8 = p.ub8 + (size_t)16384 * 1024;
    p.sinv = (float*)(p.vb8 + (size_t)16384 * 1024);
    p.conv_early = 0;
  }
  (void)hipMemsetAsync(bar, 0, XCD_BAR_WORDS * 4, stream);
  (void)hipFuncSetAttribute((const void*)mega, hipFuncAttributeMaxDynamicSharedMemorySize, LDS_BYTES);
  int dev = 0, cus = 0, per = 0;
  (void)hipGetDevice(&dev);
  (void)hipDeviceGetAttribute(&cus, hipDeviceAttributeMultiprocessorCount, dev);
  (void)hipOccupancyMaxActiveBlocksPerMultiprocessor(&per, (const void*)mega, NT, LDS_BYTES);
  if (per < 1 || cus < 1) { fprintf(stderr, "occupancy query: %d blocks/CU on %d CUs\n", per, cus); }
  const int grid = cus;
  int use_cg = 0;
  void* args[] = {&p, &bar, &use_cg};
  hipError_t e = hipLaunchCooperativeKernel((const void*)mega, dim3(grid), dim3(NT), args, LDS_BYTES, stream);
  if (e != hipSuccess) fprintf(stderr, "cooperative launch failed: %s (grid %d)\n", hipGetErrorString(e), grid);
}
```

```cpp
#include <hip/hip_runtime.h>
#include <hip/hip_cooperative_groups.h>
#include <cstdio>
#include <cstdint>
namespace cg = cooperative_groups;

typedef unsigned short u16;
typedef __attribute__((ext_vector_type(8))) short bf16x8;
typedef __attribute__((ext_vector_type(4))) float f32x4;
typedef __attribute__((ext_vector_type(2))) __bf16 bf2_t;
typedef __attribute__((ext_vector_type(2))) float f2v;
typedef __attribute__((ext_vector_type(4))) short s16x4;
#define LAS __attribute__((address_space(3)))

constexpr int NT = 512;
constexpr int D = 1024;
constexpr int TCTX = 8192;
constexpr int TLAT = 16384;
constexpr int T = TCTX + TLAT;
constexpr int NPROJ = 3584;
constexpr int NPAD = 3840;
constexpr int LDS_BYTES = 256 * 130 * 4 + 256 * 16 * 4;
constexpr float EPS = 1e-6f;

struct P {
  const float *x_prompt, *x_sample, *state_C, *state_n, *state_m, *c, *c_ctx, *w_ada, *b_ada, *g_norm1, *w_in,
      *b_igate, *b_fgate, *conv_w, *conv_b, *g_mlstm, *w_out, *g_norm2, *wq, *k1, *k2, *u, *v, *g_final;
  float* out;
  float* mod;
  u16* w_in_t;
  u16* w_out_t;
  u16* wq_t;
  u16* kb;
  float* gates;
  u16* hbuf;
  u16* proj;
  u16* qp;
  unsigned char* ub8;
  unsigned char* vb8;
  float* sinv;
  float* wbuf;
  int* ibuf;
  float* scan;
  int conv_early;
  int pad_;
};

__device__ __forceinline__ u16 f2bf(float f) { return __builtin_bit_cast(u16, (__bf16)f); }
__device__ __forceinline__ float bf2f(u16 h) { return __uint_as_float(((unsigned)h) << 16); }
__device__ __forceinline__ unsigned pack2(float a, float b) {
  bf2_t v; v.x = (__bf16)a; v.y = (__bf16)b;
  return __builtin_bit_cast(unsigned, v);
}
__device__ __forceinline__ float lo_f(unsigned w) { return __uint_as_float(w << 16); }
__device__ __forceinline__ float hi_f(unsigned w) { return __uint_as_float(w & 0xffff0000u); }
__device__ __forceinline__ float wave_sum(float v) {
#pragma unroll
  for (int o = 32; o > 0; o >>= 1) v += __shfl_xor(v, o);
  return v;
}
__device__ __forceinline__ float dot2(unsigned a, unsigned b, float c) {
  return __builtin_amdgcn_fdot2_f32_bf16(__builtin_bit_cast(bf2_t, a), __builtin_bit_cast(bf2_t, b), c, false);
}
__device__ __forceinline__ float dot8(uint4 a, uint4 b, float c) {
  c = dot2(a.x, b.x, c); c = dot2(a.y, b.y, c); c = dot2(a.z, b.z, c); c = dot2(a.w, b.w, c);
  return c;
}
__device__ __forceinline__ f32x4 mfma16(bf16x8 a, bf16x8 b, f32x4 c) {
  return __builtin_amdgcn_mfma_f32_16x16x32_bf16(a, b, c, 0, 0, 0);
}

__device__ __forceinline__ void transpose_tile(const float* __restrict__ W, int Nreal, u16* __restrict__ Wt, int k0, int n0, float* tile) {
  const int tid = threadIdx.x;
#pragma unroll
  for (int i = 0; i < 8; ++i) {
    int idx = i * NT + tid;
    int kk = idx >> 6, nn = idx & 63;
    float v = (n0 + nn < Nreal) ? W[(size_t)(k0 + kk) * Nreal + n0 + nn] : 0.f;
    tile[kk * 65 + nn] = v;
  }
  __syncthreads();
  {
    const int nn = tid & 63, kg = tid >> 6;
    uint4 o;
    o.x = pack2(tile[(kg * 8 + 0) * 65 + nn], tile[(kg * 8 + 1) * 65 + nn]);
    o.y = pack2(tile[(kg * 8 + 2) * 65 + nn], tile[(kg * 8 + 3) * 65 + nn]);
    o.z = pack2(tile[(kg * 8 + 4) * 65 + nn], tile[(kg * 8 + 5) * 65 + nn]);
    o.w = pack2(tile[(kg * 8 + 6) * 65 + nn], tile[(kg * 8 + 7) * 65 + nn]);
    *(uint4*)&Wt[(size_t)(n0 + nn) * 1024 + k0 + kg * 8] = o;
  }
}

__device__ __forceinline__ void phase_prep(const P& p, char* smem) {
  const int tid = threadIdx.x;
  float* sf = (float*)smem;
  const int n_gemv = 96, n_tin = 16 * 60, n_tout = 16 * 16, n_tq = 16 * 32, n_k = 2;
  const int total = n_gemv + n_tin + n_tout + n_tq + n_k;
  (void)total;
  for (int it = blockIdx.x; it < n_gemv + n_tin; it += gridDim.x) {
    __syncthreads();
    if (it < n_gemv) {
      for (int i = tid; i < 5 * 1024; i += NT) {
        int ci = i >> 10, k = i & 1023;
        float cv = (ci == 0) ? p.c_ctx[k] : p.c[(ci - 1) * 1024 + k];
        sf[i] = cv / (1.f + expf(-cv));
      }
      __syncthreads();
      const int cl = tid & 15, kg = tid >> 4;
      const int col = it * 64 + cl * 4;
      float acc[5][4];
#pragma unroll
      for (int ci = 0; ci < 5; ++ci)
#pragma unroll
        for (int j = 0; j < 4; ++j) acc[ci][j] = 0.f;
      for (int kk = 0; kk < 32; ++kk) {
        int k = kg * 32 + kk;
        float4 w = *(const float4*)&p.w_ada[(size_t)k * 6144 + col];
#pragma unroll
        for (int ci = 0; ci < 5; ++ci) {
          float s = sf[ci * 1024 + k];
          acc[ci][0] += s * w.x; acc[ci][1] += s * w.y; acc[ci][2] += s * w.z; acc[ci][3] += s * w.w;
        }
      }
      float* red = sf + 5 * 1024;
#pragma unroll
      for (int ci = 0; ci < 5; ++ci)
#pragma unroll
        for (int j = 0; j < 4; ++j) red[(kg * 16 + cl) * 20 + ci * 4 + j] = acc[ci][j];
      __syncthreads();
      if (tid < 320) {
        int ci = tid >> 6, cc = tid & 63;
        int cl2 = cc >> 2, j = cc & 3;
        float s = 0.f;
        for (int g = 0; g < 32; ++g) s += red[(g * 16 + cl2) * 20 + ci * 4 + j];
        int col2 = it * 64 + cc;
        p.mod[ci * 6144 + col2] = s + p.b_ada[col2];
      }
    } else if (it < n_gemv + n_tin) {
      int j = it - n_gemv;
      transpose_tile(p.w_in, 3600, p.w_in_t, (j / 60) * 64, (j % 60) * 64, sf);
    } else if (it < n_gemv + n_tin + n_tout) {
      int j = it - n_gemv - n_tin;
      transpose_tile(p.w_out, 1024, p.w_out_t, (j / 16) * 64, (j % 16) * 64, sf);
    } else if (it < n_gemv + n_tin + n_tout + n_tq) {
      int j = it - n_gemv - n_tin - n_tout;
      transpose_tile(p.wq, 2048, p.wq_t, (j / 32) * 64, (j % 32) * 64, sf);
    } else {
      int j = it - n_gemv - n_tin - n_tout - n_tq;
      const float* src = j ? p.k2 : p.k1;
      u16* dst = p.kb + j * 16384;
      for (int i = tid; i < 16384; i += NT) dst[i] = f2bf(src[i]);
    }
  }
}

__device__ __forceinline__ void phase_prep_late(const P& p, char* smem, int bi, int nb) {
  const int tid = threadIdx.x;
  float* sf = (float*)smem;
  const int n_tout = 16 * 16, n_tq = 16 * 32, n_k = 2;
  for (int it = bi; it < n_tout + n_tq + n_k; it += nb) {
    __syncthreads();
    if (it < n_tout) {
      transpose_tile(p.w_out, 1024, p.w_out_t, (it / 16) * 64, (it % 16) * 64, sf);
    } else if (it < n_tout + n_tq) {
      const int j = it - n_tout;
      transpose_tile(p.wq, 2048, p.wq_t, (j / 32) * 64, (j % 32) * 64, sf);
    } else {
      const int j = it - n_tout - n_tq;
      const float* src = j ? p.k2 : p.k1;
      u16* dst = p.kb + j * 16384;
      for (int i = tid; i < 16384; i += NT) dst[i] = f2bf(src[i]);
    }
  }
}

__device__ __forceinline__ void phase_norm(const P& p, int which) {
  const int wave = threadIdx.x >> 6, lane = threadIdx.x & 63;
  for (int t = blockIdx.x * 8 + wave; t < T; t += gridDim.x * 8) {
    const float* xr = which ? (p.out + (size_t)t * D)
                            : (t < TCTX ? p.x_prompt + (size_t)t * D : p.x_sample + (size_t)(t - TCTX) * D);
    const int ci = t < TCTX ? 0 : 1 + ((t - TCTX) >> 12);
    const float* md = p.mod + ci * 6144 + (which ? 3 * 1024 : 0);
    const float* g = which ? p.g_norm2 : p.g_norm1;
    float4 xv[4];
    float ss = 0.f;
#pragma unroll
    for (int i = 0; i < 4; ++i) {
      xv[i] = *(const float4*)&xr[(i >> 1) * 512 + lane * 8 + (i & 1) * 4];
      ss += xv[i].x * xv[i].x + xv[i].y * xv[i].y + xv[i].z * xv[i].z + xv[i].w * xv[i].w;
    }
    ss = wave_sum(ss);
    const float rstd = rsqrtf(ss * (1.f / 1024.f) + EPS);
    unsigned ow[8];
#pragma unroll
    for (int i = 0; i < 4; ++i) {
      const int col = (i >> 1) * 512 + lane * 8 + (i & 1) * 4;
      const float4 g4 = *(const float4*)&g[col];
      const float4 sh = *(const float4*)&md[col];
      const float4 sc = *(const float4*)&md[1024 + col];
      const float h0 = xv[i].x * rstd * g4.x * (1.f + sc.x) + sh.x;
      const float h1 = xv[i].y * rstd * g4.y * (1.f + sc.y) + sh.y;
      const float h2 = xv[i].z * rstd * g4.z * (1.f + sc.z) + sh.z;
      const float h3 = xv[i].w * rstd * g4.w * (1.f + sc.w) + sh.w;
      ow[i * 2] = pack2(h0, h1); ow[i * 2 + 1] = pack2(h2, h3);
    }
    *(uint4*)&p.hbuf[(size_t)t * D + lane * 8] = make_uint4(ow[0], ow[1], ow[2], ow[3]);
    *(uint4*)&p.hbuf[(size_t)t * D + 512 + lane * 8] = make_uint4(ow[4], ow[5], ow[6], ow[7]);
  }
}

__device__ __forceinline__ void convert_tables(const P& p, int bi, int nb) {
  const int wave = threadIdx.x >> 6, lane = threadIdx.x & 63;
  for (int row = bi * 8 + wave; row < 32768; row += nb * 8) {
    const float* src = row < 16384 ? p.u + (size_t)row * D : p.v + (size_t)(row - 16384) * D;
    unsigned char* dst = row < 16384 ? p.ub8 + (size_t)row * D : p.vb8 + (size_t)(row - 16384) * D;
    float4 f[4];
    float amax = 0.f;
#pragma unroll
    for (int i = 0; i < 4; ++i) {
      f[i] = *(const float4*)&src[lane * 16 + i * 4];
      amax = fmaxf(amax, fmaxf(fmaxf(fabsf(f[i].x), fabsf(f[i].y)), fmaxf(fabsf(f[i].z), fabsf(f[i].w))));
    }
#pragma unroll
    for (int o = 32; o > 0; o >>= 1) amax = fmaxf(amax, __shfl_xor(amax, o));
    const float sc = amax > 0.f ? 384.f / amax : 1.f;
    const float inv = amax > 0.f ? amax * (1.f / 384.f) : 1.f;
    unsigned w[4];
#pragma unroll
    for (int i = 0; i < 4; ++i) {
      unsigned pk = 0u;
      pk = __builtin_amdgcn_cvt_pk_fp8_f32(f[i].x * sc, f[i].y * sc, pk, false);
      pk = __builtin_amdgcn_cvt_pk_fp8_f32(f[i].z * sc, f[i].w * sc, pk, true);
      w[i] = pk;
    }
    *(uint4*)&dst[lane * 16] = make_uint4(w[0], w[1], w[2], w[3]);
    if (lane == 0) p.sinv[row] = inv;
  }
}

namespace pg8 {
#define PG8_LAS __attribute__((address_space(3)))
typedef unsigned short bf16_t;
typedef short bf16x8 __attribute__((ext_vector_type(8)));
typedef float f32x4 __attribute__((ext_vector_type(4)));
typedef unsigned u32x4 __attribute__((ext_vector_type(4)));
constexpr int BM = 256, BK = 64, HALF = 128, HTB = HALF * BK * 2  , STAGE_BYTES = 8 * HTB, NXCD = 8, WGM = 8;

__host__ __device__ __forceinline__ int lds_byte(int r, int c) { const int st = (r >> 4) * 2 + (c >> 5), rr = r & 15, cc = c & 31, ob = rr * 64 + cc * 2; return st * 1024 + (ob ^ (((ob >> 9) & 1) << 5)); }
__host__ __device__ __forceinline__ void stage_rc(int b, int& R, int& C) { const int st = b / 1024, sb = b % 1024, swz = sb ^ (((sb >> 9) & 1) << 5); R = (st >> 1) * 16 + swz / 64; C = (st & 1) * 32 + (swz % 64) / 2; }
__host__ __device__ __forceinline__ int perm32(int rho) { const int n = rho >> 4, i = rho & 15; return 8 * (i >> 2) + 4 * n + (i & 3); }

struct Unit { int pm, pn; };
struct Gemm { const bf16_t* A; const bf16_t* Bt; int M, N, K; };

struct StaticOrder {
    int nM, nN, nwg, G, c;
    __host__ __device__ void init(int M, int N, int G_, int c_) { nM = M / BM; nN = N / BM; nwg = nM * nN; G = G_; c = c_; }
    __host__ __device__ bool next(int i, Unit& u) const {
        const long L = (long)i * G + c; if (L >= nwg) return false;
        int wgid = (int)L; { const int q = nwg / NXCD, r = nwg % NXCD, xcd = wgid % NXCD, off = wgid / NXCD; wgid = (xcd < r ? xcd * (q + 1) : r * (q + 1) + (xcd - r) * q) + off; }
        const int nig = WGM * nN, gid = wgid / nig, fm = gid * WGM, gsz = (nM - fm) < WGM ? (nM - fm) : WGM;
        u.pm = fm + ((wgid % nig) % gsz); u.pn = (wgid % nig) / gsz; return true;
    }
    __device__ __forceinline__ void a_ready(const Unit&) const {}
    __device__ __forceinline__ void done(const Unit&) const {}
};

template <class Epi, class Sched, bool STAMP = false>
__device__ __forceinline__ void gemm_phase(PG8_LAS unsigned char* lds, const Gemm g, const Sched& S, const Epi& E, unsigned long long* stamps) {
    const int tid = threadIdx.x, wid = __builtin_amdgcn_readfirstlane(tid >> 6), lane = tid & 63, wr = wid >> 2, wc = wid & 3, fr = lane & 15, fq = lane >> 4;
    const int K = g.K, nt = K / BK;
    int ts_lo = 0, ts_hi = 0, nts = 0; const unsigned long long rt_entry = STAMP ? (unsigned long long)wall_clock64() : 0ull;
#define PG8_STAMP() do { if (STAMP && wid == 0 && nts < 64) { const unsigned long long _c = (unsigned long long)clock64(); \
        ts_lo = (lane == nts) ? (int)(unsigned)_c : ts_lo; ts_hi = (lane == nts) ? (int)(unsigned)(_c >> 32) : ts_hi; ++nts; } } while (0)
    PG8_STAMP();
    unsigned voffA[2], voffB[2];
#pragma unroll
    for (int i = 0; i < 2; ++i) { int R, C; stage_rc(tid * 16 + i * 8192, R, C); const int Rb = Epi::PERM ? ((R & ~31) + perm32(R & 31)) : R;
        voffA[i] = (unsigned)(R * K + C) * 2u; voffB[i] = (unsigned)(Rb * K + C) * 2u; }
    const size_t kstep = (size_t)(BK * 2);
    const size_t hstep = (size_t)HALF * K * 2;
    const size_t tstep = 2 * hstep;
    const unsigned ldsw = (unsigned)wid * 1024u;
    const int aoff = lds_byte(wr * 64 + fr, fq * 8), boff = lds_byte(wc * 32 + fr, fq * 8);
#define PG8_SA(b, h) (((b) * 2 + (h)) * HTB)
#define PG8_SB(b, h) ((4 + (b) * 2 + (h)) * HTB)
#define PG8_STAGE(bufoff, gbase, voff) do { _Pragma("unroll") for (int _i = 0; _i < 2; ++_i) \
        __builtin_amdgcn_global_load_lds((const unsigned*)((const char*)(gbase) + (voff)[_i]), (PG8_LAS unsigned*)(lds + (bufoff) + ldsw + _i * 8192), 16, 0, 0); } while (0)
#define PG8_LDA(dst, b, h) do { _Pragma("unroll") for (int m = 0; m < 4; ++m) _Pragma("unroll") for (int k = 0; k < 2; ++k) dst[m][k] = *(const PG8_LAS bf16x8*)(lds + PG8_SA(b, h) + aoff + m * 2048 + k * 1024); } while (0)
#define PG8_LDB(dst, b, h) do { _Pragma("unroll") for (int n = 0; n < 2; ++n) _Pragma("unroll") for (int k = 0; k < 2; ++k) dst[n][k] = *(const PG8_LAS bf16x8*)(lds + PG8_SB(b, h) + boff + n * 2048 + k * 1024); } while (0)
#define PG8_MMA(ai, bj, At, Bt) do { __builtin_amdgcn_s_setprio(1); _Pragma("unroll") for (int m = 0; m < 4; ++m) _Pragma("unroll") for (int n = 0; n < 2; ++n) _Pragma("unroll") for (int k = 0; k < 2; ++k) \
        acc[ai][bj][m][n] = __builtin_amdgcn_mfma_f32_16x16x32_bf16(Bt[n][k], At[m][k], acc[ai][bj][m][n], 0, 0, 0); __builtin_amdgcn_s_setprio(0); } while (0)
#define PG8_WAIT_V(n) asm volatile("s_waitcnt vmcnt(" #n ")" ::: "memory")
#define PG8_WAIT_L(n) asm volatile("s_waitcnt lgkmcnt(" #n ")" ::: "memory")
#define PG8_BAR __builtin_amdgcn_s_barrier()
#define PG8_SCHED __builtin_amdgcn_sched_barrier(0)
    Unit cur, nxt; int ui = 0;
    if (!S.next(0, cur)) return;
    f32x4 acc[2][2][4][2];
#pragma unroll
    for (int a = 0; a < 2; ++a)
#pragma unroll
        for (int b = 0; b < 2; ++b)
#pragma unroll
            for (int m = 0; m < 4; ++m)
#pragma unroll
                for (int n = 0; n < 2; ++n) acc[a][b][m][n] = (f32x4){0.f, 0.f, 0.f, 0.f};
    bf16x8 At[4][2], B0[2][2], B1[2][2];
    const char* cA = (const char*)g.A + (size_t)cur.pm * tstep; const char* cB = (const char*)g.Bt + (size_t)cur.pn * tstep;
    S.a_ready(cur);
    PG8_STAGE(PG8_SB(0, 0), cB, voffB); PG8_STAGE(PG8_SA(0, 0), cA, voffA); PG8_STAGE(PG8_SB(0, 1), cB + hstep, voffB); PG8_STAGE(PG8_SA(0, 1), cA + hstep, voffA);
    if (wr == 1) PG8_BAR;
    PG8_WAIT_V(4); PG8_BAR;
    PG8_STAGE(PG8_SB(1, 0), cB + kstep, voffB); PG8_STAGE(PG8_SA(1, 0), cA + kstep, voffA); PG8_STAGE(PG8_SB(1, 1), cB + hstep + kstep, voffB);
    PG8_WAIT_V(6); PG8_BAR;
    PG8_STAMP();
    for (;;) {
        const bool has_next = S.next(ui + 1, nxt);
        const char* nA = has_next ? (const char*)g.A + (size_t)nxt.pm * tstep : cA; const char* nB = has_next ? (const char*)g.Bt + (size_t)nxt.pn * tstep : cB;
        for (int t = 0; t < nt; t += 2) {
            const bool last = (t == nt - 2);
            const char* a1 = cA + (size_t)(t + 1) * kstep;
            const char* a2 = last ? nA : cA + (size_t)(t + 2) * kstep; const char* b2 = last ? nB : cB + (size_t)(t + 2) * kstep;
            const char* a3 = a2 + kstep; const char* b3 = b2 + kstep;
            if (last && has_next) S.a_ready(nxt);
            PG8_LDB(B0, 0, 0); PG8_SCHED; PG8_LDA(At, 0, 0); PG8_STAGE(PG8_SA(1, 1), a1 + hstep, voffA);
            PG8_WAIT_L(8); PG8_BAR; PG8_WAIT_L(0); PG8_MMA(0, 0, At, B0); PG8_BAR; PG8_SCHED;
            PG8_LDB(B1, 0, 1); PG8_STAGE(PG8_SB(0, 0), b2, voffB);
            PG8_BAR; PG8_WAIT_L(0); PG8_MMA(0, 1, At, B1); PG8_BAR;
            PG8_LDA(At, 0, 1); PG8_STAGE(PG8_SA(0, 0), a2, voffA);
            PG8_BAR; PG8_WAIT_L(0); PG8_MMA(1, 0, At, B0); PG8_BAR; PG8_SCHED;
            PG8_STAGE(PG8_SB(0, 1), b2 + hstep, voffB);
            PG8_WAIT_V(6); PG8_BAR; PG8_MMA(1, 1, At, B1); PG8_BAR;
            PG8_LDB(B0, 1, 0); PG8_SCHED; PG8_LDA(At, 1, 0); PG8_STAGE(PG8_SA(0, 1), a2 + hstep, voffA);
            PG8_WAIT_L(8); PG8_BAR; PG8_WAIT_L(0); PG8_MMA(0, 0, At, B0); PG8_BAR; PG8_SCHED;
            PG8_LDB(B1, 1, 1); PG8_STAGE(PG8_SB(1, 0), b3, voffB);
            PG8_BAR; PG8_WAIT_L(0); PG8_MMA(0, 1, At, B1); PG8_BAR;
            PG8_LDA(At, 1, 1); PG8_STAGE(PG8_SA(1, 0), a3, voffA);
            PG8_BAR; PG8_WAIT_L(0); PG8_MMA(1, 0, At, B0); PG8_BAR; PG8_SCHED;
            PG8_STAGE(PG8_SB(1, 1), b3 + hstep, voffB);
            PG8_WAIT_V(6); PG8_BAR; PG8_MMA(1, 1, At, B1); PG8_BAR;
        }
        PG8_STAMP();
        if constexpr (!Epi::AFTER_DRAIN) { E(acc, cur, wr, wc, fr, fq); S.done(cur); }
        PG8_STAMP();
        if (!has_next) break;
#pragma unroll
        for (int a = 0; a < 2; ++a)
#pragma unroll
            for (int b = 0; b < 2; ++b)
#pragma unroll
                for (int m = 0; m < 4; ++m)
#pragma unroll
                    for (int n = 0; n < 2; ++n) acc[a][b][m][n] = (f32x4){0.f, 0.f, 0.f, 0.f};
        cur = nxt; cA = nA; cB = nB; ++ui;
    }
    PG8_WAIT_V(0);
    if (wr == 0) PG8_BAR;
    PG8_BAR;
    if constexpr (Epi::AFTER_DRAIN) { E.fused(acc, cur, wr, wc, fr, fq, lds, wid, lane); S.done(cur); }
    PG8_STAMP();
    if (STAMP && wid == 0) { stamps[lane] = lane < nts ? (((unsigned long long)(unsigned)ts_hi << 32) | (unsigned)ts_lo) : 0ull;
        if (lane == 62) stamps[62] = rt_entry; if (lane == 63) stamps[63] = (unsigned long long)wall_clock64(); }
#undef PG8_STAMP
#undef PG8_SA
#undef PG8_SB
#undef PG8_STAGE
#undef PG8_LDA
#undef PG8_LDB
#undef PG8_MMA
#undef PG8_WAIT_V
#undef PG8_WAIT_L
#undef PG8_BAR
#undef PG8_SCHED
}
}


struct EpiProj {
  static constexpr bool PERM = true, AFTER_DRAIN = false;
  u16* proj; float* gates;
  __device__ __forceinline__ void operator()(const pg8::f32x4 (&acc)[2][2][4][2], const pg8::Unit& u, int wr, int wc, int fr, int fq) const {
    const int row0 = u.pm * 256 + wr * 64 + fr, col0 = u.pn * 256 + wc * 32 + 8 * fq;
#pragma unroll
    for (int ai = 0; ai < 2; ++ai)
#pragma unroll
      for (int m = 0; m < 4; ++m) {
        const int row = row0 + ai * 128 + m * 16;
#pragma unroll
        for (int bj = 0; bj < 2; ++bj) {
          const int col = col0 + bj * 128;
          const pg8::f32x4 a = acc[ai][bj][m][0], b = acc[ai][bj][m][1];
          if (col < NPROJ) {
            uint4 o; o.x = pack2(a[0], a[1]); o.y = pack2(a[2], a[3]); o.z = pack2(b[0], b[1]); o.w = pack2(b[2], b[3]);
            *(uint4*)&proj[(size_t)row * NPROJ + col] = o;
          } else if (col < 3600) {
            *(float4*)&gates[(size_t)row * 16 + (col - NPROJ)] = make_float4(a[0], a[1], a[2], a[3]);
            *(float4*)&gates[(size_t)row * 16 + (col - NPROJ) + 4] = make_float4(b[0], b[1], b[2], b[3]);
          }
        }
      }
  }
};
struct EpiResid {
  static constexpr bool PERM = false, AFTER_DRAIN = false;
  const float* x_prompt; const float* x_sample; const float* mod; float* out;
  __device__ __forceinline__ void operator()(const pg8::f32x4 (&acc)[2][2][4][2], const pg8::Unit& u, int wr, int wc, int fr, int fq) const {
    const int row0 = u.pm * 256 + wr * 64 + fr, col0 = u.pn * 256 + wc * 32 + 4 * fq;
#pragma unroll
    for (int ai = 0; ai < 2; ++ai)
#pragma unroll
      for (int m = 0; m < 4; ++m) {
        const int row = row0 + ai * 128 + m * 16;
        const float* xr = row < TCTX ? x_prompt + (size_t)row * D : x_sample + (size_t)(row - TCTX) * D;
        const int ci = row < TCTX ? 0 : 1 + ((row - TCTX) >> 12);
#pragma unroll
        for (int bj = 0; bj < 2; ++bj)
#pragma unroll
          for (int n = 0; n < 2; ++n) {
            const int col = col0 + bj * 128 + n * 16;
            const pg8::f32x4 a = acc[ai][bj][m][n];
            const float4 xv = *(const float4*)&xr[col];
            const float4 ga = *(const float4*)&mod[ci * 6144 + 2 * 1024 + col];
            *(float4*)&out[(size_t)row * D + col] = make_float4(xv.x + ga.x * a[0], xv.y + ga.y * a[1], xv.z + ga.z * a[2], xv.w + ga.w * a[3]);
          }
      }
  }
};
struct EpiQ {
  static constexpr bool PERM = true, AFTER_DRAIN = false;
  u16* qp;
  __device__ __forceinline__ void operator()(const pg8::f32x4 (&acc)[2][2][4][2], const pg8::Unit& u, int wr, int wc, int fr, int fq) const {
    const int row0 = u.pm * 256 + wr * 64 + fr, col0 = u.pn * 256 + wc * 32 + 8 * fq;
#pragma unroll
    for (int ai = 0; ai < 2; ++ai)
#pragma unroll
      for (int m = 0; m < 4; ++m) {
        const int row = row0 + ai * 128 + m * 16;
#pragma unroll
        for (int bj = 0; bj < 2; ++bj) {
          const int col = col0 + bj * 128;
          const pg8::f32x4 a = acc[ai][bj][m][0], b = acc[ai][bj][m][1];
          uint4 o; o.x = pack2(a[0], a[1]); o.y = pack2(a[2], a[3]); o.z = pack2(b[0], b[1]); o.w = pack2(b[2], b[3]);
          *(uint4*)&qp[(size_t)row * 2048 + col] = o;
        }
      }
  }
};
template <class Epi>
__device__ __forceinline__ void gemm_run(const u16* A, const u16* Bt, int N, const Epi& E, char* smem) {
  pg8::Gemm g; g.A = A; g.Bt = Bt; g.M = T; g.N = N; g.K = 1024;
  pg8::StaticOrder S; S.init(T, N, (int)gridDim.x, (int)blockIdx.x);
  pg8::gemm_phase<Epi, pg8::StaticOrder, false>((PG8_LAS unsigned char*)smem, g, S, E, nullptr);
  __syncthreads();
}

__device__ __forceinline__ bf16x8 tr8(LAS u16* base, int e0, int e1) {
  const s16x4 lo = __builtin_amdgcn_ds_read_tr16_b64_v4i16((LAS s16x4*)(base + e0));
  const s16x4 hi = __builtin_amdgcn_ds_read_tr16_b64_v4i16((LAS s16x4*)(base + e1));
  return __builtin_shufflevector(lo, hi, 0, 1, 2, 3, 4, 5, 6, 7);
}
__device__ __forceinline__ void mlstm_task(const P& p, int task, char* smem) {
  const int tid = threadIdx.x, lane = tid & 63, wave = tid >> 6, l15 = lane & 15, quad = lane >> 4;
  const bool lat = task < 128;
  const int id = lat ? task : task - 128;
  const int slice = id & 3, dir = (id >> 2) & 1, head = (id >> 3) & 3, bat = id >> 5;
  const int tb = lat ? TCTX + bat * 4096 : bat * 256;
  const int L = lat ? 4096 : 256;
  const int nch = L >> 6;
  const int gcol = dir * 4 + head;
  const float scale = 0.08838834764831845f;

  u16* sQ = (u16*)smem;
  u16* sK = sQ + 2 * 64 * 136;
  u16* sKw = sK + 64 * 136;
  u16* sV = sKw + 2 * 64 * 136;
  u16* sS = sV + 2 * 64 * 40;
  u16* sCt = sS + 2 * 64 * 72;
  LAS u16* lds16 = (LAS u16*)smem;
  const int oKw = 2 * 64 * 136 + 64 * 136, oV = oKw + 2 * 64 * 136;
  float* fl = (float*)(sCt + 2 * 32 * 136);
  float* sg = fl;
  float* smm = fl + 64;
  float* sa = fl + 128;
  float* semt = fl + 256;
  float* sden = fl + 384;
  float* sqn = fl + 512;
  float* sN = fl + 576;
  float* sM = fl + 832;
  float* sMMT = fl + 904;
  float* sDecay = fl + 968;
  float* sBT = fl + 1032;
  float* sGT = fl + 1096;
  float* scn = p.scan + (size_t)blockIdx.x * 12288;

  const int sbase = (bat * 2 + dir) * 4 + head;
  const bool isP = wave < 4;
  const int cw = wave - 4;
  __syncthreads();
  {
    const float big = p.b_igate[gcol], bfg = p.b_fgate[gcol];
    for (int ch = wave; ch < nch; ch += 8) {
      const int posl = ch * 64 + lane;
      const int tl = tb + (dir ? (L - 1 - posl) : posl);
      const float ig = p.gates[(size_t)tl * 16 + gcol] + big;
      const float fr = p.gates[(size_t)tl * 16 + 8 + gcol] + bfg;
      const float lf = fminf(fr, 0.f) - log1pf(expf(-fabsf(fr)));
      float b = lf;
#pragma unroll
      for (int off = 1; off < 64; off <<= 1) { float v = __shfl_up(b, off); if (lane >= off) b += v; }
      const float g = ig - b;
      float G = g;
#pragma unroll
      for (int off = 1; off < 64; off <<= 1) { float v = __shfl_up(G, off); if (lane >= off) G = fmaxf(G, v); }
      scn[ch * 64 + lane] = b; scn[4096 + ch * 64 + lane] = g; scn[8192 + ch * 64 + lane] = G;
      if (lane == 63) { sBT[ch] = b; sGT[ch] = G; }
    }
  }
  f32x4 C[2][2];
#pragma unroll
  for (int a = 0; a < 2; ++a)
#pragma unroll
    for (int vt = 0; vt < 2; ++vt) C[a][vt] = (f32x4){0.f, 0.f, 0.f, 0.f};
  if (!isP) {
    if (lat) {
#pragma unroll
      for (int a = 0; a < 2; ++a)
#pragma unroll
        for (int vt = 0; vt < 2; ++vt)
#pragma unroll
          for (int r = 0; r < 4; ++r)
            C[a][vt][r] = p.state_C[(size_t)sbase * 16384 + ((2 * cw + a) * 16 + quad * 4 + r) * 128 + slice * 32 + vt * 16 + l15];
    }
    if (tid - 256 < 128) sN[tid - 256] = lat ? p.state_n[sbase * 128 + (tid - 256)] : 0.f;
#pragma unroll
    for (int a = 0; a < 2; ++a)
#pragma unroll
      for (int vt = 0; vt < 2; ++vt) {
        uint2 o; o.x = pack2(C[a][vt][0], C[a][vt][1]); o.y = pack2(C[a][vt][2], C[a][vt][3]);
        *(uint2*)&sCt[(vt * 16 + l15) * 136 + (2 * cw + a) * 16 + quad * 4] = o;
      }
  }
  __syncthreads();
  if (wave == 0) {
    const float m0 = lat ? p.state_m[sbase] : 0.f;
    const float gt = lane < nch ? sGT[lane] : 0.f;
    float a = lane < nch ? sBT[lane] : 0.f;
    float d = lane < nch ? gt + a : -__builtin_huge_valf();
#pragma unroll
    for (int off = 1; off < 64; off <<= 1) {
      const float ap = __shfl_up(a, off), dp = __shfl_up(d, off);
      if (lane >= off) { d = fmaxf(dp + a, d); a = ap + a; }
    }
    const float m_next = fmaxf(m0 + a, d);
    float m_c = __shfl_up(m_next, 1);
    if (lane == 0) m_c = m0;
    if (lane < nch) {
      const float mmT = fmaxf(m_c, gt);
      sM[lane] = m_c; sMMT[lane] = mmT; sDecay[lane] = __expf(m_c - mmT);
    }
    if (lane == nch - 1) sM[nch] = m_next;
  }
  const int s = (tid & 255) >> 2, part = tid & 3;
  uint4 rq0, rq1, rq2, rq3, rk0, rk1, rk2, rk3, rv; float rb = 0.f, rg = 0.f, rG = 0.f;
  rq0 = rq1 = rq2 = rq3 = rk0 = rk1 = rk2 = rk3 = rv = make_uint4(0u, 0u, 0u, 0u);
#define ML_LOAD(CH)                                                                        \
  {                                                                                        \
    const int poss_ = (CH) * 64 + s;                                                       \
    const int ts_ = tb + (dir ? (L - 1 - poss_) : poss_);                                  \
    const u16* prow_ = p.proj + (size_t)ts_ * NPROJ;                                       \
    rq0 = *(const uint4*)&prow_[1536 + head * 128 + part * 32];                            \
    rq1 = *(const uint4*)&prow_[1536 + head * 128 + part * 32 + 8];                        \
    rq2 = *(const uint4*)&prow_[1536 + head * 128 + part * 32 + 16];                       \
    rq3 = *(const uint4*)&prow_[1536 + head * 128 + part * 32 + 24];                       \
    rk0 = *(const uint4*)&prow_[2048 + head * 128 + part * 32];                            \
    rk1 = *(const uint4*)&prow_[2048 + head * 128 + part * 32 + 8];                        \
    rk2 = *(const uint4*)&prow_[2048 + head * 128 + part * 32 + 16];                       \
    rk3 = *(const uint4*)&prow_[2048 + head * 128 + part * 32 + 24];                       \
    rv = *(const uint4*)&prow_[2560 + head * 128 + slice * 32 + part * 8];                 \
    rb = scn[poss_]; rg = scn[4096 + poss_]; rG = scn[8192 + poss_];                       \
  }
  __syncthreads();
  if (isP) ML_LOAD(0)

  float* hout = p.out + (size_t)dir * T * 512;
  f32x4 aqc[2];
  aqc[0] = (f32x4){0.f, 0.f, 0.f, 0.f}; aqc[1] = (f32x4){0.f, 0.f, 0.f, 0.f};
  for (int c = -1; c < nch; ++c) {
    const int n = c + 1, q = n & 1, pz = c & 1;
    if (isP) {
      if (n < nch) {
        const float m_n = sM[n], mmT = sMMT[n];
        const float mm = fmaxf(m_n, rG);
        const float w = __expf(rg - mmT);
        if (part == 0) {
          sg[s] = rg; smm[s] = mm; sa[q * 64 + s] = __expf(m_n - mm); semt[q * 64 + s] = __expf(-(rb + mm)); sden[q * 64 + s] = 0.f;
        }
        u16* dQ = sQ + q * 64 * 136;
        u16* dKw = sKw + q * 64 * 136;
        u16* dV = sV + q * 64 * 40;
        *(uint4*)&dQ[s * 136 + part * 32] = rq0;
        *(uint4*)&dQ[s * 136 + part * 32 + 8] = rq1;
        *(uint4*)&dQ[s * 136 + part * 32 + 16] = rq2;
        *(uint4*)&dQ[s * 136 + part * 32 + 24] = rq3;
        *(uint4*)&sK[s * 136 + part * 32] = rk0;
        *(uint4*)&sK[s * 136 + part * 32 + 8] = rk1;
        *(uint4*)&sK[s * 136 + part * 32 + 16] = rk2;
        *(uint4*)&sK[s * 136 + part * 32 + 24] = rk3;
#define KW_(W) pack2(lo_f(W) * w, hi_f(W) * w)
        *(uint4*)&dKw[s * 136 + part * 32] = make_uint4(KW_(rk0.x), KW_(rk0.y), KW_(rk0.z), KW_(rk0.w));
        *(uint4*)&dKw[s * 136 + part * 32 + 8] = make_uint4(KW_(rk1.x), KW_(rk1.y), KW_(rk1.z), KW_(rk1.w));
        *(uint4*)&dKw[s * 136 + part * 32 + 16] = make_uint4(KW_(rk2.x), KW_(rk2.y), KW_(rk2.z), KW_(rk2.w));
        *(uint4*)&dKw[s * 136 + part * 32 + 24] = make_uint4(KW_(rk3.x), KW_(rk3.y), KW_(rk3.z), KW_(rk3.w));
#undef KW_
        *(uint4*)&dV[s * 40 + part * 8] = rv;
        if (n + 1 < nch) ML_LOAD(n + 1)
      }
    } else {
      if (c >= 0) {
        const int ctid = tid - 256;
        const u16* cQ = sQ + pz * 64 * 136;
        const int eKw = oKw + pz * 64 * 136, eV = oV + pz * 64 * 40;
        const int tq = l15 >> 2, tp = l15 & 3;
        const u16* cCt = sCt + pz * 32 * 136;
        u16* nCt = sCt + (pz ^ 1) * 32 * 136;
        const float* cN = sN + pz * 128;
        float* nN = sN + (pz ^ 1) * 128;
        {
          const int t = ctid >> 2, pt = ctid & 3;
          float qn = 0.f;
#pragma unroll
          for (int i = 0; i < 4; ++i) {
            const uint4 qv = *(const uint4*)&cQ[t * 136 + pt * 32 + i * 8];
            const float4 n0 = *(const float4*)&cN[pt * 32 + i * 8];
            const float4 n1 = *(const float4*)&cN[pt * 32 + i * 8 + 4];
            qn += lo_f(qv.x) * n0.x + hi_f(qv.x) * n0.y + lo_f(qv.y) * n0.z + hi_f(qv.y) * n0.w
                + lo_f(qv.z) * n1.x + hi_f(qv.z) * n1.y + lo_f(qv.w) * n1.z + hi_f(qv.w) * n1.w;
          }
          qn += __int_as_float(__builtin_amdgcn_update_dpp(0, __float_as_int(qn), 0xB1, 0xF, 0xF, true));
          qn += __int_as_float(__builtin_amdgcn_update_dpp(0, __float_as_int(qn), 0x4E, 0xF, 0xF, true));
          if (pt == 0) sqn[t] = qn * scale;
        }
        const int trow = cw * 16 + l15;
#pragma unroll
        for (int ti = 0; ti < 2; ++ti) {
          f32x4 acc = (f32x4){0.f, 0.f, 0.f, 0.f};
#pragma unroll
          for (int ks = 0; ks < 4; ++ks) {
            bf16x8 afr = *(const bf16x8*)&cCt[(ti * 16 + l15) * 136 + ks * 32 + quad * 8];
            bf16x8 bfr = *(const bf16x8*)&cQ[trow * 136 + ks * 32 + quad * 8];
            acc = mfma16(afr, bfr, acc);
          }
          aqc[ti] = acc;
        }
        const float decay = sDecay[c];
        const bf16x8 ones = (bf16x8){0x3F80, 0x3F80, 0x3F80, 0x3F80, 0x3F80, 0x3F80, 0x3F80, 0x3F80};
        bf16x8 vfr[2][2];
#pragma unroll
        for (int vt = 0; vt < 2; ++vt)
#pragma unroll
          for (int ks = 0; ks < 2; ++ks) {
            const int s0 = ks * 32 + quad * 8;
            vfr[vt][ks] = tr8(lds16, eV + (s0 + tq) * 40 + vt * 16 + 4 * tp, eV + (s0 + 4 + tq) * 40 + vt * 16 + 4 * tp);
          }
#pragma unroll
        for (int a = 0; a < 2; ++a) {
          const int kt = 2 * cw + a;
          bf16x8 kfr[2];
#pragma unroll
          for (int ks = 0; ks < 2; ++ks) {
            const int s0 = ks * 32 + quad * 8;
            kfr[ks] = tr8(lds16, eKw + (s0 + tq) * 136 + kt * 16 + 4 * tp, eKw + (s0 + 4 + tq) * 136 + kt * 16 + 4 * tp);
          }
          f32x4 accn = (f32x4){0.f, 0.f, 0.f, 0.f};
          accn = mfma16(kfr[0], ones, accn);
          accn = mfma16(kfr[1], ones, accn);
#pragma unroll
          for (int vt = 0; vt < 2; ++vt) {
            C[a][vt][0] *= decay; C[a][vt][1] *= decay; C[a][vt][2] *= decay; C[a][vt][3] *= decay;
            C[a][vt] = mfma16(kfr[0], vfr[vt][0], C[a][vt]);
            C[a][vt] = mfma16(kfr[1], vfr[vt][1], C[a][vt]);
            uint2 o; o.x = pack2(C[a][vt][0], C[a][vt][1]); o.y = pack2(C[a][vt][2], C[a][vt][3]);
            *(uint2*)&nCt[(vt * 16 + l15) * 136 + kt * 16 + quad * 4] = o;
          }
          if (l15 == 0) {
#pragma unroll
            for (int r = 0; r < 4; ++r) {
              const int idx = kt * 16 + quad * 4 + r;
              nN[idx] = decay * cN[idx] + accn[r];
            }
          }
        }
      }
    }
    asm volatile("s_waitcnt lgkmcnt(0)" ::: "memory"); __builtin_amdgcn_s_barrier(); asm volatile("" ::: "memory");
    if (isP) {
      if (n < nch) {
        const u16* dQ = sQ + q * 64 * 136;
        u16* dS = sS + q * 64 * 72;
        const int trow = wave * 16 + l15;
        const float mmt = smm[trow];
        float psum = 0.f;
#pragma unroll
        for (int si = 0; si < 4; ++si) {
          const int s0 = si * 16 + quad * 4;
          uint2 o = make_uint2(0u, 0u);
          if (si <= wave) {
            f32x4 acc = (f32x4){0.f, 0.f, 0.f, 0.f};
#pragma unroll
            for (int ks = 0; ks < 4; ++ks) {
              bf16x8 afr = *(const bf16x8*)&sK[(si * 16 + l15) * 136 + ks * 32 + quad * 8];
              bf16x8 bfr = *(const bf16x8*)&dQ[trow * 136 + ks * 32 + quad * 8];
              acc = mfma16(afr, bfr, acc);
            }
            float vals[4];
#pragma unroll
            for (int r = 0; r < 4; ++r) {
              const int sidx = s0 + r;
              const float e = __expf(fminf(sg[sidx] - mmt, 0.f));
              vals[r] = (sidx <= trow) ? acc[r] * scale * e : 0.f;
              psum += vals[r];
            }
            o.x = pack2(vals[0], vals[1]); o.y = pack2(vals[2], vals[3]);
          }
          *(uint2*)&dS[trow * 72 + s0] = o;
        }
        atomicAdd(&sden[q * 64 + trow], psum);
      }
    } else {
      if (c >= 0) {
        const int eV = oV + pz * 64 * 40;
        const int tq = l15 >> 2, tp = l15 & 3;
        const u16* cS = sS + pz * 64 * 72;
        const int trow = cw * 16 + l15;
        const float a_t = sa[pz * 64 + trow];
        const float den = a_t * sqn[trow] + sden[pz * 64 + trow];
        const float inv = 1.f / fmaxf(fabsf(den), semt[pz * 64 + trow]);
        const float as = a_t * scale;
        const int post = c * 64 + trow;
        const int tt = tb + (dir ? (L - 1 - post) : post);
#pragma unroll
        for (int ti = 0; ti < 2; ++ti) {
          f32x4 asv = (f32x4){0.f, 0.f, 0.f, 0.f};
#pragma unroll
          for (int ks = 0; ks < 2; ++ks) {
            const int s0 = ks * 32 + quad * 8;
            bf16x8 afr = tr8(lds16, eV + (s0 + tq) * 40 + ti * 16 + 4 * tp, eV + (s0 + 4 + tq) * 40 + ti * 16 + 4 * tp);
            bf16x8 bfr = *(const bf16x8*)&cS[trow * 72 + ks * 32 + quad * 8];
            asv = mfma16(afr, bfr, asv);
          }
          float4 h = make_float4((as * aqc[ti][0] + asv[0]) * inv, (as * aqc[ti][1] + asv[1]) * inv,
                                 (as * aqc[ti][2] + asv[2]) * inv, (as * aqc[ti][3] + asv[3]) * inv);
          *(float4*)&hout[(size_t)tt * 512 + head * 128 + slice * 32 + ti * 16 + quad * 4] = h;
        }
      }
    }
    asm volatile("s_waitcnt lgkmcnt(0)" ::: "memory"); __builtin_amdgcn_s_barrier(); asm volatile("" ::: "memory");
  }
#undef ML_LOAD
  if (!lat && !isP) {
    float* newC = p.out + (size_t)T * D;
    float* newn = newC + (size_t)32 * 2 * 4 * 128 * 128;
    float* newm = newn + 32 * 2 * 4 * 128;
#pragma unroll
    for (int a = 0; a < 2; ++a)
#pragma unroll
      for (int vt = 0; vt < 2; ++vt)
#pragma unroll
        for (int r = 0; r < 4; ++r)
          newC[(size_t)sbase * 16384 + ((2 * cw + a) * 16 + quad * 4 + r) * 128 + slice * 32 + vt * 16 + l15] = C[a][vt][r];
    if (slice == 0) {
      const int ctid = tid - 256;
      if (ctid < 128) newn[sbase * 128 + ctid] = sN[(nch & 1) * 128 + ctid];
      if (ctid == 0) newm[sbase] = sM[nch];
    }
  }
}

__device__ __forceinline__ void phase_mlstm(const P& p, char* smem) {
  const int G = gridDim.x, b = blockIdx.x;
  if (G >= 256) {
    if (b < 128) mlstm_task(p, b, smem);
    else {
      for (int task = b; task < 1152; task += G - 128) mlstm_task(p, task, smem);
      if (p.conv_early) convert_tables(p, b - 128, G - 128);
    }
  } else {
    for (int task = b; task < 1152; task += G) mlstm_task(p, task, smem);
    if (p.conv_early) convert_tables(p, b, G);
  }
}

__device__ __forceinline__ void phase_mix(const P& p) {
  const int wave = threadIdx.x >> 6, lane = threadIdx.x & 63;
  for (int t = blockIdx.x * 8 + wave; t < T; t += gridDim.x * 8) {
    const u16* pr = p.proj + (size_t)t * NPROJ;
    const int seg = t < TCTX ? 256 : 64;
    const int pos = (t < TCTX ? t : t - TCTX) & (seg - 1);
    const bool hasL = pos > 0, hasR = pos < seg - 1;
    const int c0 = lane * 8;
    const uint4 zero4 = make_uint4(0u, 0u, 0u, 0u);
    const uint4 bg = *(const uint4*)&pr[c0];
    const uint4 cgC = *(const uint4*)&pr[512 + c0];
    const uint4 xgC = *(const uint4*)&pr[1024 + c0];
    const uint4 cgL = hasL ? *(const uint4*)&pr[-NPROJ + 512 + c0] : zero4;
    const uint4 xgL = hasL ? *(const uint4*)&pr[-NPROJ + 1024 + c0] : zero4;
    const uint4 cgR = hasR ? *(const uint4*)&pr[NPROJ + 512 + c0] : zero4;
    const uint4 xgR = hasR ? *(const uint4*)&pr[NPROJ + 1024 + c0] : zero4;
    const unsigned bgw[4] = {bg.x, bg.y, bg.z, bg.w};
    const unsigned cC[4] = {cgC.x, cgC.y, cgC.z, cgC.w}, xC[4] = {xgC.x, xgC.y, xgC.z, xgC.w};
    const unsigned cL[4] = {cgL.x, cgL.y, cgL.z, cgL.w}, xL[4] = {xgL.x, xgL.y, xgL.z, xgL.w};
    const unsigned cR[4] = {cgR.x, cgR.y, cgR.z, cgR.w}, xR[4] = {xgR.x, xgR.y, xgR.z, xgR.w};
    unsigned ow[4];
#pragma unroll
    for (int j = 0; j < 4; ++j) {
      const int ch = c0 + 2 * j;
      float w0a = p.conv_w[ch], w1a = p.conv_w[512 + ch], w2a = p.conv_w[1024 + ch], ba = p.conv_b[ch];
      float w0b = p.conv_w[ch + 1], w1b = p.conv_w[512 + ch + 1], w2b = p.conv_w[1024 + ch + 1], bb = p.conv_b[ch + 1];
      float ya = w0a * (lo_f(cL[j]) * lo_f(xL[j])) + w1a * (lo_f(cC[j]) * lo_f(xC[j])) + w2a * (lo_f(cR[j]) * lo_f(xR[j])) + ba;
      float yb = w0b * (hi_f(cL[j]) * hi_f(xL[j])) + w1b * (hi_f(cC[j]) * hi_f(xC[j])) + w2b * (hi_f(cR[j]) * hi_f(xR[j])) + bb;
      ow[j] = pack2(lo_f(bgw[j]) * ya, hi_f(bgw[j]) * yb);
    }
    *(uint4*)&p.hbuf[(size_t)t * D + c0] = make_uint4(ow[0], ow[1], ow[2], ow[3]);
    const float* hf = p.out + (size_t)t * 512 + c0;
    const float* hb = p.out + (size_t)T * 512 + (size_t)t * 512 + c0;
    const float4 f0 = *(const float4*)&hf[0], f1 = *(const float4*)&hf[4];
    const float4 b0 = *(const float4*)&hb[0], b1 = *(const float4*)&hb[4];
    float h[8] = {f0.x + b0.x, f0.y + b0.y, f0.z + b0.z, f0.w + b0.w, f1.x + b1.x, f1.y + b1.y, f1.z + b1.z, f1.w + b1.w};
    float ss = 0.f;
#pragma unroll
    for (int j = 0; j < 8; ++j) ss += h[j] * h[j];
    ss += __shfl_xor(ss, 1); ss += __shfl_xor(ss, 2); ss += __shfl_xor(ss, 4); ss += __shfl_xor(ss, 8);
    const float r = rsqrtf(ss * (1.f / 128.f) + EPS);
    const uint4 og = *(const uint4*)&pr[3072 + c0];
    const unsigned ogw[4] = {og.x, og.y, og.z, og.w};
    unsigned mw[4];
#pragma unroll
    for (int j = 0; j < 4; ++j) {
      float ga = p.g_mlstm[c0 + 2 * j], gb = p.g_mlstm[c0 + 2 * j + 1];
      float oa = lo_f(ogw[j]), ob = hi_f(ogw[j]);
      float sa_ = 1.f / (1.f + expf(-oa)), sb_ = 1.f / (1.f + expf(-ob));
      mw[j] = pack2(h[2 * j] * r * ga * sa_, h[2 * j + 1] * r * gb * sb_);
    }
    *(uint4*)&p.hbuf[(size_t)t * D + 512 + c0] = make_uint4(mw[0], mw[1], mw[2], mw[3]);
  }
}

__device__ __forceinline__ unsigned f2key(float f) {
  const unsigned u = __float_as_uint(f);
  return (u & 0x80000000u) ? ~u : (u | 0x80000000u);
}
__device__ __forceinline__ float key2f(unsigned k, unsigned mask) {
  const unsigned m = k & ~mask;
  const unsigned u = (m & 0x80000000u) ? (m & 0x7fffffffu) : ~m;
  return __uint_as_float(u);
}
#define KINSERT(LIST, KEY)                                   \
  {                                                          \
    unsigned kk_ = (KEY);                                    \
    _Pragma("unroll") for (int j_ = 0; j_ < 16; ++j_) {      \
      const unsigned hi_ = max(LIST[j_], kk_);               \
      kk_ = min(LIST[j_], kk_);                              \
      LIST[j_] = hi_;                                        \
    }                                                        \
  }

__device__ __forceinline__ void bsort16_desc(unsigned (&a)[16]) {
#pragma unroll
  for (int k = 2; k <= 16; k <<= 1) {
#pragma unroll
    for (int j = k >> 1; j > 0; j >>= 1) {
#pragma unroll
      for (int i = 0; i < 16; ++i) {
        const int l = i ^ j;
        if (l > i) {
          const unsigned hi = max(a[i], a[l]), lo = min(a[i], a[l]);
          if ((i & k) == 0) { a[i] = hi; a[l] = lo; } else { a[i] = lo; a[l] = hi; }
        }
      }
    }
  }
}
__device__ __forceinline__ void bmerge16_desc(unsigned (&a)[16]) {
#pragma unroll
  for (int j = 8; j > 0; j >>= 1) {
#pragma unroll
    for (int i = 0; i < 16; ++i) {
      const int l = i ^ j;
      if (l > i) { const unsigned hi = max(a[i], a[l]), lo = min(a[i], a[l]); a[i] = hi; a[l] = lo; }
    }
  }
}
__device__ __forceinline__ void top16_merge(unsigned (&L)[16], const unsigned (&G)[16]) {
#pragma unroll
  for (int i = 0; i < 16; ++i) L[i] = max(L[i], G[15 - i]);
  bmerge16_desc(L);
}
__device__ constexpr int PEER_PA[64] = {0, 0, 0, 0, 0, 0, 0, 0, 0, 0, 0, 0, 0, 0, 0, 0, 1, 1, 1, 1, 1, 1, 1, 1, 2, 2, 2, 2, 2, 3, 3, 3, 3, 4, 4, 4, 5, 5, 6, 6, 7, 7, 8, 9, 10, 11, 12, 13, 14, 15, -1, -1, -1, -1, -1, -1, -1, -1, -1, -1, -1, -1, -1, -1};
__device__ constexpr int PEER_PB[64] = {0, 1, 2, 3, 4, 5, 6, 7, 8, 9, 10, 11, 12, 13, 14, 15, 0, 1, 2, 3, 4, 5, 6, 7, 0, 1, 2, 3, 4, 0, 1, 2, 3, 0, 1, 2, 0, 1, 0, 1, 0, 1, 0, 0, 0, 0, 0, 0, 0, 0, 0, 0, 0, 0, 0, 0, 0, 0, 0, 0, 0, 0, 0, 0};
#define SBAR __builtin_amdgcn_sched_barrier(0)
__device__ __forceinline__ int launder(int v) { asm volatile("" : "+v"(v)); return v; }
#define G_ISSUE(BUF, TAB, IDS)                                                 \
  _Pragma("unroll") for (int i_ = 0; i_ < 16; ++i_) {                          \
    const unsigned e_ = (unsigned)__builtin_amdgcn_readlane(IDS, i_);          \
    const unsigned off_ = (e_ << 10) + (unsigned)lane * 16u;     \
    BUF[i_] = *(const uint4*)((const unsigned char*)(TAB) + off_);             \
  }
#define U_DW(DW, J)                                                                        \
  acc_ = __builtin_elementwise_fma(__builtin_amdgcn_cvt_pk_f32_fp8(DW, false), hp[2 * (J)], acc_);      \
  acc_ = __builtin_elementwise_fma(__builtin_amdgcn_cvt_pk_f32_fp8(DW, true), hp[2 * (J) + 1], acc_);
#define G_DOTU(BUF)                                                            \
  _Pragma("unroll") for (int i_ = 0; i_ < 16; ++i_) {                          \
    f2v acc_ = (f2v){0.f, 0.f};                                                \
    U_DW(BUF[i_].x, 0) U_DW(BUF[i_].y, 1) U_DW(BUF[i_].z, 2) U_DW(BUF[i_].w, 3) \
    pa[i_] = acc_.x + acc_.y;                                                  \
  }
#define V_DW(DW, J)                                                                        \
  o2[2 * (J)] = __builtin_elementwise_fma(__builtin_amdgcn_cvt_pk_f32_fp8(DW, false), wv_, o2[2 * (J)]);      \
  o2[2 * (J) + 1] = __builtin_elementwise_fma(__builtin_amdgcn_cvt_pk_f32_fp8(DW, true), wv_, o2[2 * (J) + 1]);
#define G_ACCV(BUF)                                                            \
  _Pragma("unroll") for (int i_ = 0; i_ < 16; ++i_) {                          \
    const float w_ = __int_as_float(__builtin_amdgcn_readlane(wbits, i_));     \
    const f2v wv_ = (f2v){w_, w_};                                             \
    V_DW(BUF[i_].x, 0) V_DW(BUF[i_].y, 1) V_DW(BUF[i_].z, 2) V_DW(BUF[i_].w, 3) \
  }

__device__ __forceinline__ float gelu_as(float v) {
  const float av = fabsf(v);
  const float t = __builtin_amdgcn_rcpf(av * 0.2316418882f + 1.0f);
  float q = t * 0.5307027145f + (-0.7265760135f);
  q = q * t + 0.7107068705f; q = q * t + (-0.142248368f); q = q * t + 0.127414796f; q = q * t;
  const float e = __builtin_amdgcn_exp2f((v * v) * (-0.72134752044f));
  const float m = v * (q * e);
  return v < 0.f ? m : v - m;
}
#define G_DOTU_MFMA(BUF)                                                                   \
  _Pragma("unroll") for (int i_ = 0; i_ < 16; ++i_) {                                      \
    const long alo_ = (long)(((unsigned long long)BUF[i_].y << 32) | (unsigned long long)BUF[i_].x); \
    const long ahi_ = (long)(((unsigned long long)BUF[i_].w << 32) | (unsigned long long)BUF[i_].z); \
    f32x4 d_ = (f32x4){0.f, 0.f, 0.f, 0.f};                                                \
    d_ = __builtin_amdgcn_mfma_f32_16x16x32_fp8_fp8(alo_, h8lo, d_, 0, 0, 0);              \
    d_ = __builtin_amdgcn_mfma_f32_16x16x32_fp8_fp8(ahi_, h8hi, d_, 0, 0, 0);              \
    const float s01_ = dsel1 ? d_[1] : d_[0];                                              \
    const float s23_ = dsel1 ? d_[3] : d_[2];                                              \
    pa[i_] = diag ? (dsel2 ? s23_ : s01_) : 0.f;                                           \
  }
#define DPPF(X, CTRL) __int_as_float(__builtin_amdgcn_update_dpp(0, __float_as_int(X), CTRL, 0xF, 0xF, true))
#define REDUCE16(PA, Q1)                                                                   \
  {                                                                                        \
    float q8_[8], q4_[4], q2_[2];                                                          \
    const bool b3_ = (lane & 8) != 0, b2_ = (lane & 4) != 0, b1_ = (lane & 2) != 0, b0_ = (lane & 1) != 0; \
    _Pragma("unroll") for (int i_ = 0; i_ < 8; ++i_) { const float k_ = b3_ ? PA[i_ + 8] : PA[i_]; const float s_ = b3_ ? PA[i_] : PA[i_ + 8]; q8_[i_] = k_ + DPPF(s_, 0x128);   } \
    _Pragma("unroll") for (int i_ = 0; i_ < 4; ++i_) { const float k_ = b2_ ? q8_[i_ + 4] : q8_[i_]; const float s_ = b2_ ? q8_[i_] : q8_[i_ + 4]; q4_[i_] = k_ + __shfl_xor(s_, 4); } \
    _Pragma("unroll") for (int i_ = 0; i_ < 2; ++i_) { const float k_ = b1_ ? q4_[i_ + 2] : q4_[i_]; const float s_ = b1_ ? q4_[i_] : q4_[i_ + 2]; q2_[i_] = k_ + DPPF(s_, 0x4E);   } \
    { const float k_ = b0_ ? q2_[1] : q2_[0]; const float s_ = b0_ ? q2_[0] : q2_[1]; Q1 = k_ + DPPF(s_, 0xB1);   } \
    Q1 += __shfl_xor(Q1, 16); Q1 += __shfl_xor(Q1, 32);                                    \
  }
#define U_HEAD(BUF, IDS, SUI, SVI, HEAD)                                                   \
  {                                                                                        \
    float pa[16]; G_DOTU(BUF)                                                              \
    float q1_; REDUCE16(pa, q1_)                                                           \
    const float av_ = q1_ * (SUI);                                                         \
    const float ge_ = 0.5f * av_ * (1.f + erff(av_ * 0.7071067811865476f));                \
    const float w_ = sG[(tok * 8 + (HEAD)) * 16 + l15] * ge_ * (SVI);                      \
    if (lane < 16) { p.wbuf[(size_t)t * 128 + (HEAD) * 16 + lane] = w_; p.ibuf[(size_t)t * 128 + (HEAD) * 16 + lane] = (IDS); } \
  }

__device__ __forceinline__ void phase_peer(const P& p, char* smem) {
  unsigned* sc = (unsigned*)smem;
  unsigned* skey = sc + 256 * 130;
  int* sE = (int*)sc;
  float* sG = (float*)(sc + 2048);
  for (int it = blockIdx.x; it < T / 16; it += gridDim.x) {
    const int t0 = it * 16;
    __syncthreads();
    {
      const int tid = launder(threadIdx.x), lane = tid & 63, wave = tid >> 6, l15 = lane & 15, quad = lane >> 4;
      const int half = wave >> 2;
      const u16* kb = p.kb + half * 16384;
#pragma unroll 1
      for (int hh = 0; hh < 2; ++hh) {
        const int head = (wave & 3) * 2 + hh;
        bf16x8 qf[4];
#pragma unroll
        for (int ks = 0; ks < 4; ++ks)
          qf[ks] = *(const bf16x8*)&p.qp[(size_t)(t0 + l15) * 2048 + head * 256 + half * 128 + ks * 32 + quad * 8];
        const int row = (head * 2 + half) * 16 + l15;
#pragma unroll 1
        for (int nt = 0; nt < 8; ++nt) {
          f32x4 acc = (f32x4){0.f, 0.f, 0.f, 0.f};
#pragma unroll
          for (int ks = 0; ks < 4; ++ks) {
            bf16x8 kf = *(const bf16x8*)&kb[(nt * 16 + l15) * 128 + ks * 32 + quad * 8];
            acc = mfma16(kf, qf[ks], acc);
          }
          const int key = nt * 16 + quad * 4;
          const int pos = key + (key >= 64 ? 1 : 0);
#pragma unroll
          for (int r = 0; r < 4; ++r) sc[row * 130 + pos + r] = (f2key(acc[r]) & ~0x7Fu) | (unsigned)(127 - (key + r));
        }
      }
    }
    __syncthreads();
    {
      const int tid = launder(threadIdx.x);
      const int row = tid >> 1, hs = tid & 1;
      const unsigned* src = sc + row * 130 + hs * 65;
      unsigned list[16];
#pragma unroll
      for (int j = 0; j < 16; ++j) list[j] = src[j];
      bsort16_desc(list);
#pragma unroll 1
      for (int g = 1; g < 4; ++g) {
        unsigned grp[16];
#pragma unroll
        for (int j = 0; j < 16; ++j) grp[j] = src[g * 16 + j];
        bsort16_desc(grp);
        top16_merge(list, grp);
      }
      {
        unsigned other[16];
#pragma unroll
        for (int j = 0; j < 16; ++j) other[j] = __shfl_xor(list[j], 1);
        top16_merge(list, other);
      }
      if (hs == 0) {
#pragma unroll
        for (int j = 0; j < 16; ++j) skey[row * 16 + j] = list[j];
      }
    }
    __syncthreads();
    if (threadIdx.x < 128) {
      const int tid = launder(threadIdx.x);
      const int tok = tid & 15, head = tid >> 4;
      const int ra = (head * 2) * 16 + tok, rb = ra + 16;
      float v1[16], v2[16];
#pragma unroll
      for (int a = 0; a < 16; ++a) { v1[a] = key2f(skey[ra * 16 + a], 0x7Fu); v2[a] = key2f(skey[rb * 16 + a], 0x7Fu); }
      unsigned list[16];
#define CKEY(I) ((PEER_PA[I] < 0) ? 0u : ((f2key(v1[PEER_PA[I] < 0 ? 0 : PEER_PA[I]] + v2[PEER_PB[I]]) & ~0xFFu) | (unsigned)(255 - ((PEER_PA[I] < 0 ? 0 : PEER_PA[I]) * 16 + PEER_PB[I]))))
#pragma unroll
      for (int j = 0; j < 16; ++j) list[j] = CKEY(j);
      bsort16_desc(list);
#pragma unroll
      for (int g = 1; g < 4; ++g) {
        unsigned grp[16];
#pragma unroll
        for (int j = 0; j < 16; ++j) grp[j] = CKEY(g * 16 + j);
        bsort16_desc(grp);
        top16_merge(list, grp);
      }
#undef CKEY
      const float smax = key2f(list[0], 0xFFu);
      float ex[16];
      float se = 0.f;
#pragma unroll
      for (int q = 0; q < 16; ++q) { ex[q] = expf(key2f(list[q], 0xFFu) - smax); se += ex[q]; }
      const float inv = 1.f / se;
#pragma unroll
      for (int q = 0; q < 16; ++q) {
        const int flat = 255 - (int)(list[q] & 0xFFu);
        const int i1 = 127 - (int)(skey[ra * 16 + (flat >> 4)] & 0x7Fu);
        const int i2 = 127 - (int)(skey[rb * 16 + (flat & 15)] & 0x7Fu);
        sE[(tok * 8 + head) * 16 + q] = i1 * 128 + i2;
        sG[(tok * 8 + head) * 16 + q] = ex[q] * inv;
      }
    }
    __syncthreads();
    {
      const int tid = threadIdx.x;
#pragma unroll
      for (int i = 0; i < 4; ++i) {
        const int idx = i * NT + tid;
        p.ibuf[(size_t)t0 * 128 + idx] = sE[idx];
        p.wbuf[(size_t)t0 * 128 + idx] = sG[idx];
      }
    }
  }
}

__device__ __forceinline__ void phase_peer_u(const P& p, char* smem) {
  const int lane = threadIdx.x & 63, wave = threadIdx.x >> 6, l15 = lane & 15;
  const unsigned lane16 = (unsigned)lane * 16u;
  int* lid = (int*)(smem + wave * 1536);
  int* lent = lid + 128;
  float* lg = (float*)(lent + 128);
  const int Gn = gridDim.x, bb = blockIdx.x;
  const int ngrp = bb < T / 16 ? (T / 16 - bb + Gn - 1) / Gn : 0;
  const int nseq = 2 * ngrp;
#define SEQ_TOK(S) (((bb + ((S) >> 1) * Gn) << 4) + wave * 2 + ((S) & 1))
#pragma unroll 1
  for (int r = launder(0); r < 2; ++r) {
    __syncthreads();
    int ids8n[8]; float g8n[8]; uint4 hxn0 = make_uint4(0u, 0u, 0u, 0u), hxn1 = make_uint4(0u, 0u, 0u, 0u);
#pragma unroll
    for (int h = 0; h < 8; ++h) { ids8n[h] = 0; g8n[h] = 0.f; }
    {
      const int tf = SEQ_TOK(0);
      if (nseq > 0) {
#pragma unroll
        for (int h = 0; h < 8; ++h) { ids8n[h] = p.ibuf[(size_t)tf * 128 + h * 16 + l15]; g8n[h] = p.wbuf[(size_t)tf * 128 + h * 16 + l15]; }
        hxn0 = *(const uint4*)&p.hbuf[(size_t)tf * D + lane * 16];
        hxn1 = *(const uint4*)&p.hbuf[(size_t)tf * D + lane * 16 + 8];
      }
    }
#pragma unroll 1
    for (int sq = 0; sq < nseq; ++sq) {
      const int t = SEQ_TOK(sq);
      int n = 0;
      const uint4 hx0 = hxn0, hx1 = hxn1;
      {
        int ids8[8]; float g8[8];
#pragma unroll
        for (int h = 0; h < 8; ++h) { ids8[h] = ids8n[h]; g8[h] = g8n[h]; }
        {
          const int tn = SEQ_TOK(sq + 1);
          if (sq + 1 < nseq) {
#pragma unroll
            for (int h = 0; h < 8; ++h) { ids8n[h] = p.ibuf[(size_t)tn * 128 + h * 16 + l15]; g8n[h] = p.wbuf[(size_t)tn * 128 + h * 16 + l15]; }
            hxn0 = *(const uint4*)&p.hbuf[(size_t)tn * D + lane * 16];
            hxn1 = *(const uint4*)&p.hbuf[(size_t)tn * D + lane * 16 + 8];
          }
        }
        asm volatile("s_waitcnt lgkmcnt(0)" ::: "memory");
#pragma unroll
        for (int h = 0; h < 8; ++h) {
          const bool valid = ((ids8[h] >> 13) & 1) == r;
          const unsigned m16 = (unsigned)__ballot(valid) & 0xFFFFu;
          const int pos = n + __builtin_popcount(m16 & ((1u << l15) - 1u));
          if (lane < 16 && valid) { lid[pos] = ids8[h]; lent[pos] = h * 16 + l15; lg[pos] = g8[h]; }
          n += __builtin_popcount(m16);
        }
        asm volatile("s_waitcnt lgkmcnt(0)" ::: "memory");
      }
      n = __builtin_amdgcn_readfirstlane(n);
      if (n == 0) continue;
      long h8lo, h8hi; float hinv;
      {
        const unsigned hw[8] = {hx0.x, hx0.y, hx0.z, hx0.w, hx1.x, hx1.y, hx1.z, hx1.w};
        float amax = 0.f;
#pragma unroll
        for (int j = 0; j < 8; ++j) amax = fmaxf(amax, fmaxf(fabsf(lo_f(hw[j])), fabsf(hi_f(hw[j]))));
#pragma unroll
        for (int o = 32; o > 0; o >>= 1) amax = fmaxf(amax, __shfl_xor(amax, o));
        const float hs = amax > 0.f ? 384.f / amax : 1.f;
        hinv = amax > 0.f ? amax * (1.f / 384.f) : 1.f;
        unsigned q[4];
#pragma unroll
        for (int j = 0; j < 4; ++j) {
          unsigned pk = 0u;
          pk = __builtin_amdgcn_cvt_pk_fp8_f32(lo_f(hw[2 * j]) * hs, hi_f(hw[2 * j]) * hs, pk, false);
          pk = __builtin_amdgcn_cvt_pk_fp8_f32(lo_f(hw[2 * j + 1]) * hs, hi_f(hw[2 * j + 1]) * hs, pk, true);
          q[j] = pk;
        }
        h8lo = (long)(((unsigned long long)q[1] << 32) | (unsigned long long)q[0]);
        h8hi = (long)(((unsigned long long)q[3] << 32) | (unsigned long long)q[2]);
      }
      const bool diag = (l15 >> 2) == (lane >> 4);
      const bool dsel1 = (l15 & 1) != 0, dsel2 = (l15 & 2) != 0;
      const int nu = (n + 15) >> 4;
      uint4 A[16], B[16];
#define U2_DESC(U, IDS, ENT, GT, SUI, SVI, OK)                                   \
      {                                                                         \
        const int j_ = (U) * 16 + l15;                                          \
        OK = j_ < n;                                                            \
        const int jc_ = OK ? j_ : 0;                                            \
        IDS = lid[jc_]; ENT = lent[jc_]; GT = lg[jc_];                          \
        SUI = *(const float*)((const char*)p.sinv + ((unsigned)IDS << 2));       \
        SVI = *(const float*)((const char*)p.sinv + 65536u + ((unsigned)IDS << 2)); \
      }
#define U2_FIN(BUF, ENT, GT, SUI, SVI, OK)                                       \
      {                                                                         \
        float pa[16]; G_DOTU_MFMA(BUF)                                          \
        float q1_; REDUCE16(pa, q1_)                                            \
        const float av_ = q1_ * (SUI) * hinv;                                   \
        const float ge_ = gelu_as(av_);                                         \
        if (lane < 16 && (OK)) *(float*)((char*)p.wbuf + ((((unsigned)t << 7) + (unsigned)(ENT)) << 2)) = (GT) * ge_ * (SVI); \
      }
      int idsA, entA, idsB = 0, entB = 0; float gA, suA, svA, gB = 0.f, suB = 0.f, svB = 0.f; bool okA, okB = false;
      U2_DESC(0, idsA, entA, gA, suA, svA, okA)
      G_ISSUE(A, p.ub8, idsA)
      SBAR;
#pragma unroll 1
      for (int u = 0; u < nu; u += 2) {
        const bool hasB = u + 1 < nu;
        if (hasB) { U2_DESC(u + 1, idsB, entB, gB, suB, svB, okB) G_ISSUE(B, p.ub8, idsB) }
        SBAR;
        U2_FIN(A, entA, gA, suA, svA, okA)
        SBAR;
        if (u + 2 < nu) { U2_DESC(u + 2, idsA, entA, gA, suA, svA, okA) G_ISSUE(A, p.ub8, idsA) }
        SBAR;
        if (hasB) { U2_FIN(B, entB, gB, suB, svB, okB) }
        SBAR;
      }
#undef U2_DESC
#undef U2_FIN
    }
  }
}

__device__ __forceinline__ void phase_peer_v(const P& p) {
  const int lane = threadIdx.x & 63, wave = threadIdx.x >> 6, l15 = lane & 15;
  const int tstride = gridDim.x * 8;
  int ids8n[8]; float w8n[8];
  {
    const int t0 = blockIdx.x * 8 + wave;
#pragma unroll
    for (int h = 0; h < 8; ++h) { ids8n[h] = 0; w8n[h] = 0.f; }
    if (t0 < T) {
#pragma unroll
      for (int h = 0; h < 8; ++h) { ids8n[h] = p.ibuf[(size_t)t0 * 128 + h * 16 + l15]; w8n[h] = p.wbuf[(size_t)t0 * 128 + h * 16 + l15]; }
    }
  }
#pragma unroll 1
  for (int t = blockIdx.x * 8 + wave; t < T; t += tstride) {
    int ids8[8]; float w8[8];
#pragma unroll
    for (int h = 0; h < 8; ++h) { ids8[h] = ids8n[h]; w8[h] = w8n[h]; }
    if (t + tstride < T) {
#pragma unroll
      for (int h = 0; h < 8; ++h) { ids8n[h] = p.ibuf[(size_t)(t + tstride) * 128 + h * 16 + l15]; w8n[h] = p.wbuf[(size_t)(t + tstride) * 128 + h * 16 + l15]; }
    }
    f2v o2[8];
#pragma unroll
    for (int j = 0; j < 8; ++j) o2[j] = (f2v){0.f, 0.f};
    uint4 A[16], B[16];
    G_ISSUE(A, p.vb8, ids8[0])
    SBAR;
#pragma unroll
    for (int h = 0; h < 8; ++h) {
      const int wbits = __float_as_int(w8[h]);
      if ((h & 1) == 0) {
        if (h < 7) { G_ISSUE(B, p.vb8, ids8[(h + 1) & 7]) }
        SBAR;
        G_ACCV(A)
      } else {
        if (h < 7) { G_ISSUE(A, p.vb8, ids8[(h + 1) & 7]) }
        SBAR;
        G_ACCV(B)
      }
      SBAR;
    }
    float o[16];
#pragma unroll
    for (int j = 0; j < 8; ++j) { o[2 * j] = o2[j].x; o[2 * j + 1] = o2[j].y; }
    const int ci = t < TCTX ? 0 : 1 + ((t - TCTX) >> 12);
    const float* ga2 = p.mod + ci * 6144 + 5 * 1024;
    float* xr = p.out + (size_t)t * D;
    float x2[16];
    float ss = 0.f;
#pragma unroll
    for (int q = 0; q < 4; ++q) {
      const int col = lane * 16 + q * 4;
      const float4 xa = *(const float4*)&xr[col];
      const float4 ga = *(const float4*)&ga2[col];
      x2[q * 4 + 0] = xa.x + ga.x * o[q * 4 + 0];
      x2[q * 4 + 1] = xa.y + ga.y * o[q * 4 + 1];
      x2[q * 4 + 2] = xa.z + ga.z * o[q * 4 + 2];
      x2[q * 4 + 3] = xa.w + ga.w * o[q * 4 + 3];
    }
#pragma unroll
    for (int j = 0; j < 16; ++j) ss += x2[j] * x2[j];
    ss = wave_sum(ss);
    const float rstd = rsqrtf(ss * (1.f / 1024.f) + EPS);
#pragma unroll
    for (int q = 0; q < 4; ++q) {
      const int col = lane * 16 + q * 4;
      const float4 g0 = *(const float4*)&p.g_final[col];
      *(float4*)&xr[col] = make_float4(x2[q * 4 + 0] * rstd * g0.x, x2[q * 4 + 1] * rstd * g0.y,
                                       x2[q * 4 + 2] * rstd * g0.z, x2[q * 4 + 3] * rstd * g0.w);
    }
  }
}

__device__ __forceinline__ void phase_peer_vr(const P& p, char* smem, int r) {
  const int lane = threadIdx.x & 63, wave = threadIdx.x >> 6, l15 = lane & 15;
  const unsigned lane16 = (unsigned)lane * 16u;
  int* lid = (int*)(smem + wave * 1024);
  float* lw = (float*)(lid + 128);
  u16* pbuf = p.qp;
  const int Gn = gridDim.x, bb = blockIdx.x;
  const int ngrp = bb < T / 16 ? (T / 16 - bb + Gn - 1) / Gn : 0;
  const int nseq = 2 * ngrp;
#pragma unroll 1
  for (int sq = 0; sq < nseq; ++sq) {
    const int t = SEQ_TOK(sq);
    int n = 0;
    {
      int ids8[8]; float w8[8];
#pragma unroll
      for (int h = 0; h < 8; ++h) { ids8[h] = p.ibuf[(size_t)t * 128 + h * 16 + l15]; w8[h] = p.wbuf[(size_t)t * 128 + h * 16 + l15]; }
      asm volatile("s_waitcnt lgkmcnt(0)" ::: "memory");
#pragma unroll
      for (int h = 0; h < 8; ++h) {
        const bool valid = ((ids8[h] >> 13) & 1) == r;
        const unsigned m16 = (unsigned)__ballot(valid) & 0xFFFFu;
        const int pos = n + __builtin_popcount(m16 & ((1u << l15) - 1u));
        if (lane < 16 && valid) { lid[pos] = ids8[h]; lw[pos] = w8[h]; }
        n += __builtin_popcount(m16);
      }
      asm volatile("s_waitcnt lgkmcnt(0)" ::: "memory");
    }
    n = __builtin_amdgcn_readfirstlane(n);
    f2v o2[8];
    if (r == 0) {
#pragma unroll
      for (int j = 0; j < 8; ++j) o2[j] = (f2v){0.f, 0.f};
    } else {
      const uint4 p0 = *(const uint4*)&pbuf[(size_t)t * D + lane * 16];
      const uint4 p1 = *(const uint4*)&pbuf[(size_t)t * D + lane * 16 + 8];
      o2[0] = (f2v){lo_f(p0.x), hi_f(p0.x)}; o2[1] = (f2v){lo_f(p0.y), hi_f(p0.y)};
      o2[2] = (f2v){lo_f(p0.z), hi_f(p0.z)}; o2[3] = (f2v){lo_f(p0.w), hi_f(p0.w)};
      o2[4] = (f2v){lo_f(p1.x), hi_f(p1.x)}; o2[5] = (f2v){lo_f(p1.y), hi_f(p1.y)};
      o2[6] = (f2v){lo_f(p1.z), hi_f(p1.z)}; o2[7] = (f2v){lo_f(p1.w), hi_f(p1.w)};
    }
    const int nu = (n + 15) >> 4;
    if (nu > 0) {
      uint4 A[16], B[16];
#define V2_DESC(U, IDS, W)                                                       \
      {                                                                         \
        const int j_ = (U) * 16 + l15;                                          \
        const bool ok_ = j_ < n;                                                \
        const int jc_ = ok_ ? j_ : 0;                                           \
        IDS = lid[jc_]; W = ok_ ? lw[jc_] : 0.f;                                \
      }
      int idsA, idsB = 0; float wA, wB = 0.f;
      V2_DESC(0, idsA, wA)
      G_ISSUE(A, p.vb8, idsA)
      SBAR;
#pragma unroll 1
      for (int u = 0; u < nu; u += 2) {
        const bool hasB = u + 1 < nu;
        if (hasB) { V2_DESC(u + 1, idsB, wB) G_ISSUE(B, p.vb8, idsB) }
        SBAR;
        { const int wbits = __float_as_int(wA); G_ACCV(A) }
        SBAR;
        if (u + 2 < nu) { V2_DESC(u + 2, idsA, wA) G_ISSUE(A, p.vb8, idsA) }
        SBAR;
        if (hasB) { const int wbits = __float_as_int(wB); G_ACCV(B) }
        SBAR;
      }
#undef V2_DESC
    }
    if (r == 0) {
      *(uint4*)&pbuf[(size_t)t * D + lane * 16] = make_uint4(pack2(o2[0].x, o2[0].y), pack2(o2[1].x, o2[1].y), pack2(o2[2].x, o2[2].y), pack2(o2[3].x, o2[3].y));
      *(uint4*)&pbuf[(size_t)t * D + lane * 16 + 8] = make_uint4(pack2(o2[4].x, o2[4].y), pack2(o2[5].x, o2[5].y), pack2(o2[6].x, o2[6].y), pack2(o2[7].x, o2[7].y));
    } else {
      float o[16];
#pragma unroll
      for (int j = 0; j < 8; ++j) { o[2 * j] = o2[j].x; o[2 * j + 1] = o2[j].y; }
      const int ci = t < TCTX ? 0 : 1 + ((t - TCTX) >> 12);
      const float* ga2 = p.mod + ci * 6144 + 5 * 1024;
      float* xr = p.out + (size_t)t * D;
      float x2[16];
      float ss = 0.f;
#pragma unroll
      for (int q = 0; q < 4; ++q) {
        const int col = lane * 16 + q * 4;
        const float4 xa = *(const float4*)&xr[col];
        const float4 ga = *(const float4*)&ga2[col];
        x2[q * 4 + 0] = xa.x + ga.x * o[q * 4 + 0];
        x2[q * 4 + 1] = xa.y + ga.y * o[q * 4 + 1];
        x2[q * 4 + 2] = xa.z + ga.z * o[q * 4 + 2];
        x2[q * 4 + 3] = xa.w + ga.w * o[q * 4 + 3];
      }
#pragma unroll
      for (int j = 0; j < 16; ++j) ss += x2[j] * x2[j];
      ss = wave_sum(ss);
      const float rstd = rsqrtf(ss * (1.f / 1024.f) + EPS);
#pragma unroll
      for (int q = 0; q < 4; ++q) {
        const int col = lane * 16 + q * 4;
        const float4 g0 = *(const float4*)&p.g_final[col];
        *(float4*)&xr[col] = make_float4(x2[q * 4 + 0] * rstd * g0.x, x2[q * 4 + 1] * rstd * g0.y,
                                         x2[q * 4 + 2] * rstd * g0.z, x2[q * 4 + 3] * rstd * g0.w);
      }
    }
  }
}

#define XB_TMO      128
#define XB_XCNT(j)  (256  + 64 * (j))
#define XB_XSUB(j)  (1280 + 64 * (j))
#define XB_XGEN(j)  (2304 + 64 * (j))
#define XB_TOP      3328
#define XB_TOPGEN   3392
#define XCD_BAR_WORDS 3456
#define XB_SPIN_CAP (1u << 22)
__device__ __forceinline__ unsigned xb_ld(unsigned* p) { return __hip_atomic_load(p, __ATOMIC_RELAXED, __HIP_MEMORY_SCOPE_AGENT); }
__device__ __forceinline__ unsigned xb_add(unsigned* p, unsigned v) { return __hip_atomic_fetch_add(p, v, __ATOMIC_RELAXED, __HIP_MEMORY_SCOPE_AGENT); }
__device__ __forceinline__ unsigned xb_xcc_id() { return (unsigned)__builtin_amdgcn_s_getreg((3 << 11) | 20) & 0xFu; }
#define XB_SPIN(cond, bar) do { unsigned _sp = 0; while (cond) { __builtin_amdgcn_s_sleep(1); \
    if ((++_sp & 255u) == 0u) { if (xb_ld(&(bar)[XB_TMO])) break; if (_sp > XB_SPIN_CAP) { atomicAdd(&(bar)[XB_TMO], 1u); break; } } } } while (0)
struct XcdBarrier { unsigned* bar; unsigned x; volatile LAS unsigned* st; };
__device__ __forceinline__ XcdBarrier xcd_barrier_post(unsigned* bar, volatile LAS unsigned* st) {
  XcdBarrier b; b.bar = bar; b.x = xb_xcc_id(); b.st = st;
  if (threadIdx.x == 0) (void)xb_add(&bar[XB_XCNT(b.x)], 1u);
  return b;
}
__device__ __forceinline__ void xcd_barrier_complete(unsigned* bar, unsigned x, unsigned& nloc, unsigned& nx) {
  const unsigned G = gridDim.x * gridDim.y * gridDim.z;
  unsigned sum, cnt, mine, sp = 0u;
  for (;;) {
    sum = 0u; cnt = 0u; mine = 0u;
#pragma unroll
    for (unsigned j = 0; j < 16; ++j) { const unsigned c = xb_ld(&bar[XB_XCNT(j)]); sum += c; cnt += (c > 0u) ? 1u : 0u; mine = (j == x) ? c : mine; }
    if (sum == G) break;
    __builtin_amdgcn_s_sleep(1);
    if ((++sp & 255u) == 0u) { if (xb_ld(&bar[XB_TMO])) break; if (sp > XB_SPIN_CAP) { atomicAdd(&bar[XB_TMO], 1u); break; } }
  }
  nloc = mine > 0u ? mine : 1u; nx = cnt > 0u ? cnt : 1u;
}
__device__ __forceinline__ void xcd_barrier(const XcdBarrier& b) {
  asm volatile("s_waitcnt vmcnt(0)" ::: "memory");
  __syncthreads();
  if (threadIdx.x == 0) {
    unsigned* bar = b.bar;
    __builtin_amdgcn_s_waitcnt(0);
    unsigned nloc = b.st[0], nx = b.st[1];
    if (nloc == 0u) { xcd_barrier_complete(bar, b.x, nloc, nx); b.st[0] = nloc; b.st[1] = nx; }
    const unsigned old = xb_add(&bar[XB_XSUB(b.x)], 1u);
    const unsigned gen = old / nloc;
    if (old + 1u == (gen + 1u) * nloc) {
      __builtin_amdgcn_fence(__ATOMIC_RELEASE, "agent");
      asm volatile("s_waitcnt vmcnt(0)" ::: "memory");
      const unsigned og = xb_add(&bar[XB_TOP], 1u);
      const unsigned tg = og / nx;
      if (og + 1u == (tg + 1u) * nx) xb_add(&bar[XB_TOPGEN], 1u);
      else XB_SPIN(xb_ld(&bar[XB_TOPGEN]) == tg, bar);
      __builtin_amdgcn_fence(__ATOMIC_ACQUIRE, "agent");
      xb_add(&bar[XB_XGEN(b.x)], 1u);
      asm volatile("s_waitcnt vmcnt(0)" ::: "memory");
    } else {
      XB_SPIN(xb_ld(&bar[XB_XGEN(b.x)]) == gen, bar);
      __builtin_amdgcn_fence(__ATOMIC_ACQUIRE, "agent");
      asm volatile("s_waitcnt vmcnt(0)" ::: "memory");
    }
  }
  __syncthreads();
}

__global__ void __launch_bounds__(NT) mega(P p, unsigned* bar, int use_cg) {
  extern __shared__ __attribute__((aligned(16))) char smem[];
  __shared__ uint4 xb_words;
  cg::grid_group grid = cg::this_grid();
  if (threadIdx.x == 0) xb_words = make_uint4(0u, 0u, 0u, 0u);
  __syncthreads();
  XcdBarrier xb = xcd_barrier_post(bar, (volatile LAS unsigned*)&xb_words);
#define SEAM() do { if (use_cg) grid.sync(); else xcd_barrier(xb); } while (0)
  phase_prep(p, smem);
  SEAM();
  phase_norm(p, 0);
  SEAM();
  { EpiProj e; e.proj = p.proj; e.gates = p.gates; gemm_run(p.hbuf, p.w_in_t, NPAD, e, smem); }
  {
    const int G = (int)gridDim.x, rem = ((T / 256) * (NPAD / 256)) % G;
    const int bi = rem == 0 ? (int)blockIdx.x : (int)blockIdx.x - rem;
    if (bi >= 0) phase_prep_late(p, smem, bi, rem == 0 ? G : G - rem);
  }
  SEAM();
  phase_mlstm(p, smem);
  SEAM();
  phase_mix(p);
  SEAM();
  { EpiResid e; e.x_prompt = p.x_prompt; e.x_sample = p.x_sample; e.mod = p.mod; e.out = p.out; gemm_run(p.hbuf, p.w_out_t, 1024, e, smem); }
  SEAM();
  phase_norm(p, 1);
  if (!p.conv_early) convert_tables(p, (int)blockIdx.x, (int)gridDim.x);
  SEAM();
  { EpiQ e; e.qp = p.qp; gemm_run(p.hbuf, p.wq_t, 2048, e, smem); }
  SEAM();
  phase_peer(p, smem);
  __syncthreads();
  phase_peer_u(p, smem);
  __syncthreads();
#pragma unroll 1
  for (int rr = launder(0); rr < 2; ++rr) {
    phase_peer_vr(p, smem, rr);
    __syncthreads();
  }
}

extern "C" void kernel_launch(void* const* d_in, const int* in_sizes, int n_in, void* d_out, int out_size,
                              void* d_ws, size_t ws_size, hipStream_t stream) {
  P p{};
  const float* const* in = (const float* const*)d_in;
  p.x_prompt = in[0]; p.x_sample = in[1]; p.state_C = in[2]; p.state_n = in[3]; p.state_m = in[4];
  p.c = in[5]; p.c_ctx = in[6]; p.w_ada = in[7]; p.b_ada = in[8]; p.g_norm1 = in[9]; p.w_in = in[10];
  p.b_igate = in[11]; p.b_fgate = in[12]; p.conv_w = in[13]; p.conv_b = in[14]; p.g_mlstm = in[15];
  p.w_out = in[16]; p.g_norm2 = in[17]; p.wq = in[18]; p.k1 = in[19]; p.k2 = in[20]; p.u = in[21]; p.v = in[22];
  p.g_final = in[23];
  p.out = (float*)d_out;
  char* ws = (char*)d_ws;
  size_t off = 0;
  auto take = [&](size_t bytes) { char* r = ws + off; off += (bytes + 255) & ~(size_t)255; return r; };
  p.mod = (float*)take(5 * 6144 * 4);
  p.w_in_t = (u16*)take((size_t)NPAD * 1024 * 2);
  p.w_out_t = (u16*)take((size_t)1024 * 1024 * 2);
  p.wq_t = (u16*)take((size_t)2048 * 1024 * 2);
  p.kb = (u16*)take(2 * 16384 * 2);
  p.gates = (float*)take((size_t)T * 16 * 4);
  p.hbuf = (u16*)take((size_t)T * D * 2);
  p.proj = (u16*)take((size_t)T * NPROJ * 2);
  p.qp = p.proj;
  p.wbuf = (float*)(p.proj + (size_t)70000000);
  p.ibuf = (int*)(p.wbuf + (size_t)T * 128);
  unsigned* bar = (unsigned*)take(XCD_BAR_WORDS * 4);
  p.scan = (float*)p.hbuf;
  const size_t tab_bytes = (size_t)2 * 16384 * 1024 + (size_t)2 * 16384 * 4;
  if (ws_size >= off + tab_bytes + 256) {
    p.ub8 = (unsigned char*)take((size_t)16384 * 1024);
    p.vb8 = (unsigned char*)take((size_t)16384 * 1024);
    p.sinv = (float*)take((size_t)2 * 16384 * 4);
    p.conv_early = 1;
  } else {
    p.ub8 = (unsigned char*)(p.proj + (size_t)T * 2048);
    p.vb8 = p.ub8 + (size_t)16384 * 1024;
    p.sinv = (float*)(p.vb8 + (size_t)16384 * 1024);
    p.conv_early = 0;
  }
  (void)hipMemsetAsync(bar, 0, XCD_BAR_WORDS * 4, stream);
  (void)hipFuncSetAttribute((const void*)mega, hipFuncAttributeMaxDynamicSharedMemorySize, LDS_BYTES);
  int dev = 0, cus = 0, per = 0;
  (void)hipGetDevice(&dev);
  (void)hipDeviceGetAttribute(&cus, hipDeviceAttributeMultiprocessorCount, dev);
  (void)hipOccupancyMaxActiveBlocksPerMultiprocessor(&per, (const void*)mega, NT, LDS_BYTES);
  if (per < 1 || cus < 1) { fprintf(stderr, "occupancy query: %d blocks/CU on %d CUs\n", per, cus); }
  const int grid = cus;
  int use_cg = 0;
  void* args[] = {&p, &bar, &use_cg};
  hipError_t e = hipLaunchCooperativeKernel((const void*)mega, dim3(grid), dim3(NT), args, LDS_BYTES, stream);
  if (e != hipSuccess) fprintf(stderr, "cooperative launch failed: %s (grid %d)\n", hipGetErrorString(e), grid);
}
```
